# Optimizing an MI355X kernel written in HIP

```python
import math
import jax, jax.numpy as jnp
from jax import lax
import numpy as np

D_MODEL = 1024
BATCH = 2
SEQ = 16384
DEPTH = 1

EPS = 1e-6
CONV_WIDTH = D_MODEL
CONV_TAPS = 31
DIFF_HEADS = 8
DIFF_HEAD_DIM = 64
DIFF_V_DIM = 2 * DIFF_HEAD_DIM
QK_WIDTH = DIFF_HEADS * 2 * DIFF_HEAD_DIM
ATTN_WIDTH = DIFF_HEADS * DIFF_V_DIM
ROPE_THETA = 500000.0
ROPE_DIM = DIFF_HEAD_DIM // 4
Q_BLOCK = 128
IN_SIZES = (CONV_WIDTH, CONV_WIDTH, QK_WIDTH, QK_WIDTH, ATTN_WIDTH, D_MODEL, D_MODEL)
IN_WIDTH = 2 * CONV_WIDTH + 2 * QK_WIDTH + ATTN_WIDTH + 2 * D_MODEL
N_EXPERTS = 64
N_GROUPS = 8
TOPK_GROUPS = 4
TOP_K = 8
EXPERT_DIM = 256
SHARED_DIM = 256
ROUTED_SCALE = 2.5
MOE_CHUNK = 128

kernel_name = 'hybrid_conv_diffattn_moe_block'


def rms_norm(x, g):
    x32 = x.astype(jnp.float32)
    y = x32 * lax.rsqrt(jnp.mean(x32 * x32, axis=-1, keepdims=True) + EPS)
    return y.astype(x.dtype) * g


def layer_norm(x, g, b):
    x32 = x.astype(jnp.float32)
    mu = jnp.mean(x32, axis=-1, keepdims=True)
    xc = x32 - mu
    y = xc * lax.rsqrt(jnp.mean(xc * xc, axis=-1, keepdims=True) + EPS)
    return y.astype(x.dtype) * g + b


def rope(x, cos, sin):
    half = ROPE_DIM // 2
    x1, x2, xp = x[..., :half], x[..., half:ROPE_DIM], x[..., ROPE_DIM:]
    return jnp.concatenate([x1 * cos - x2 * sin, x2 * cos + x1 * sin, xp], axis=-1)


def conformer_conv(a, b, w_dw, b_dw, ln_g, ln_b, w_pw2, b_pw2):
    u = a * jax.nn.sigmoid(b)
    u = lax.conv_general_dilated(
        u, w_dw[:, None, :], window_strides=(1,), padding=[(CONV_TAPS - 1, 0)],
        dimension_numbers=('NWC', 'WIO', 'NWC'), feature_group_count=CONV_WIDTH) + b_dw
    u = jax.nn.silu(layer_norm(u, ln_g, ln_b))
    return u @ w_pw2 + b_pw2


def diff_attention(q, k, v, cos, sin, q_g, k_g, lq1, lk1, lq2, lk2, subln_g, lambda_init):
    B, S, _ = q.shape
    H, d = DIFF_HEADS, DIFF_HEAD_DIM
    q = q.reshape(B, S, H, 2, d).transpose(0, 2, 3, 1, 4)
    k = k.reshape(B, S, H, 2, d).transpose(0, 2, 3, 1, 4)
    v = v.reshape(B, S, H, DIFF_V_DIM).transpose(0, 2, 1, 3)
    q = rope(rms_norm(q, q_g), cos, sin)
    k = rope(rms_norm(k, k_g), cos, sin)
    f32 = jnp.float32
    lam = (jnp.exp(jnp.sum(lq1.astype(f32) * lk1.astype(f32)))
           - jnp.exp(jnp.sum(lq2.astype(f32) * lk2.astype(f32))) + lambda_init)
    nb = S // Q_BLOCK
    q_blocks = jnp.moveaxis(q.reshape(B, H, 2, nb, Q_BLOCK, d), 3, 0)
    starts = jnp.arange(nb, dtype=jnp.int32) * Q_BLOCK
    k_idx = jnp.arange(S, dtype=jnp.int32)
    scale = d ** -0.5

    def block(args):
        qb, start = args
        s = jnp.einsum('bhmqd,bhmkd->bhmqk', qb, k).astype(f32) * scale
        causal = k_idx[None, :] <= (start + jnp.arange(Q_BLOCK, dtype=jnp.int32))[:, None]
        p = jax.nn.softmax(jnp.where(causal, s, -jnp.inf), axis=-1)
        a = p[:, :, 0] - lam * p[:, :, 1]
        return jnp.einsum('bhqk,bhkv->bhqv', a.astype(v.dtype), v)

    o = lax.map(block, (q_blocks, starts))
    o = jnp.moveaxis(o, 0, 2).reshape(B, H, S, DIFF_V_DIM)
    o = rms_norm(o, subln_g) * (1.0 - lambda_init)
    return o.transpose(0, 2, 1, 3).reshape(B, S, ATTN_WIDTH)


def moe_ffn(h, w_router, router_bias, w_gu, w_down, w_sh_gu, w_sh_down):
    B, S, D = h.shape
    f32 = jnp.float32
    t = h.reshape(B * S, D)
    scores = jax.nn.sigmoid((t @ w_router).astype(f32))
    choice = scores + router_bias.astype(f32)
    per_group = N_EXPERTS // N_GROUPS
    group_score = lax.top_k(choice.reshape(-1, N_GROUPS, per_group), 2)[0].sum(-1)
    _, gidx = lax.top_k(group_score, TOPK_GROUPS)
    gmask = jax.nn.one_hot(gidx, N_GROUPS, dtype=f32).sum(-2)
    emask = jnp.repeat(gmask, per_group, axis=-1) > 0
    _, eidx = lax.top_k(jnp.where(emask, choice, -jnp.inf), TOP_K)
    w = jnp.take_along_axis(scores, eidx, axis=-1)
    w = w / jnp.sum(w, axis=-1, keepdims=True) * ROUTED_SCALE
    gates = jnp.einsum('tk,tke->te', w, jax.nn.one_hot(eidx, N_EXPERTS, dtype=f32)).astype(h.dtype)
    nc = t.shape[0] // MOE_CHUNK

    def chunk(args):
        tc, gc = args
        g, u = jnp.split(jnp.einsum('td,edf->tef', tc, w_gu), 2, axis=-1)
        return jnp.einsum('tef,efd->td', jax.nn.silu(g) * u * gc[..., None], w_down)

    routed = lax.map(chunk, (t.reshape(nc, MOE_CHUNK, D),
                             gates.reshape(nc, MOE_CHUNK, N_EXPERTS))).reshape(B * S, D)
    sg, su = jnp.split(t @ w_sh_gu, 2, axis=-1)
    shared = (jax.nn.silu(sg) * su) @ w_sh_down
    return (routed + shared).reshape(B, S, D)


def setup_inputs(seed: int = 0) -> dict:
    key = jax.random.key(seed)
    ks = jax.random.split(key, 32)
    L, D, C = DEPTH, D_MODEL, CONV_WIDTH
    f32 = jnp.float32

    def nrm(k, shape, scale):
        return jax.random.normal(k, shape, f32) * scale

    def gain(k, shape):
        return 1.0 + 0.05 * jax.random.normal(k, shape, f32)

    return {
        'x': nrm(ks[0], (BATCH, SEQ, D), 1.0),
        'c': nrm(ks[1], (BATCH, D), 1.0),
        'positions': jnp.broadcast_to(jnp.arange(SEQ, dtype=jnp.int32), (BATCH, SEQ)),
        'w_ada': nrm(ks[2], (L, D, 6 * D), 0.5 * D ** -0.5),
        'b_ada': nrm(ks[3], (L, 6 * D), 0.02),
        'norm1_g': gain(ks[4], (L, D)),
        'w_in': nrm(ks[5], (L, D, IN_WIDTH), D ** -0.5),
        'conv_dw': nrm(ks[6], (L, CONV_TAPS, C), CONV_TAPS ** -0.5),
        'conv_dw_b': nrm(ks[7], (L, C), 0.02),
        'conv_ln_g': gain(ks[8], (L, C)),
        'conv_ln_b': nrm(ks[9], (L, C), 0.02),
        'w_pw2': nrm(ks[10], (L, C, D), C ** -0.5),
        'b_pw2': nrm(ks[11], (L, D), 0.02),
        'q_norm_g': gain(ks[12], (L, DIFF_HEAD_DIM)),
        'k_norm_g': gain(ks[13], (L, DIFF_HEAD_DIM)),
        'lambda_q1': nrm(ks[14], (L, DIFF_HEAD_DIM), 0.1),
        'lambda_k1': nrm(ks[15], (L, DIFF_HEAD_DIM), 0.1),
        'lambda_q2': nrm(ks[16], (L, DIFF_HEAD_DIM), 0.1),
        'lambda_k2': nrm(ks[17], (L, DIFF_HEAD_DIM), 0.1),
        'subln_g': gain(ks[18], (L, DIFF_V_DIM)),
        'w_out': nrm(ks[19], (L, D, D), D ** -0.5),
        'norm2_g': gain(ks[20], (L, D)),
        'w_router': nrm(ks[21], (L, D, N_EXPERTS), D ** -0.5),
        'router_bias': nrm(ks[22], (L, N_EXPERTS), 0.01),
        'w_exp_gu': nrm(ks[23], (L, N_EXPERTS, D, 2 * EXPERT_DIM), D ** -0.5),
        'w_exp_down': nrm(ks[24], (L, N_EXPERTS, EXPERT_DIM, D), EXPERT_DIM ** -0.5),
        'w_sh_gu': nrm(ks[25], (L, D, 2 * SHARED_DIM), D ** -0.5),
        'w_sh_down': nrm(ks[26], (L, SHARED_DIM, D), SHARED_DIM ** -0.5),
    }


def reference(x, c, positions, w_ada, b_ada, norm1_g, w_in, conv_dw, conv_dw_b, conv_ln_g,
              conv_ln_b, w_pw2, b_pw2, q_norm_g, k_norm_g, lambda_q1, lambda_k1, lambda_q2,
              lambda_k2, subln_g, w_out, norm2_g, w_router, router_bias, w_exp_gu, w_exp_down,
              w_sh_gu, w_sh_down):
    inv_freq = ROPE_THETA ** (-jnp.arange(0, ROPE_DIM, 2, dtype=jnp.float32) / ROPE_DIM)
    ang = positions.astype(jnp.float32)[:, None, None, :, None] * inv_freq
    cos = jnp.cos(ang).astype(x.dtype)
    sin = jnp.sin(ang).astype(x.dtype)
    c_act = jax.nn.silu(c)
    offsets = []
    acc = 0
    for s in IN_SIZES[:-1]:
        acc += s
        offsets.append(acc)
    for l in range(DEPTH):
        lambda_init = 0.8 - 0.6 * math.exp(-0.3 * l)
        mod = c_act @ w_ada[l] + b_ada[l]
        sh1, sc1, g1, sh2, sc2, g2 = [m[:, None, :] for m in jnp.split(mod, 6, axis=-1)]
        h = rms_norm(x, norm1_g[l]) * (1 + sc1) + sh1
        proj = h @ w_in[l]
        ca, cb, q, k, v, gate_conv, gate_attn = jnp.split(proj, offsets, axis=-1)
        y_conv = conformer_conv(ca, cb, conv_dw[l], conv_dw_b[l], conv_ln_g[l], conv_ln_b[l],
                                w_pw2[l], b_pw2[l])
        y_attn = diff_attention(q, k, v, cos, sin, q_norm_g[l], k_norm_g[l], lambda_q1[l],
                                lambda_k1[l], lambda_q2[l], lambda_k2[l], subln_g[l], lambda_init)
        merged = jax.nn.sigmoid(gate_conv) * y_conv + jax.nn.sigmoid(gate_attn) * y_attn
        x = x + g1 * (merged @ w_out[l])
        h2 = rms_norm(x, norm2_g[l]) * (1 + sc2) + sh2
        x = x + g2 * moe_ffn(h2, w_router[l], router_bias[l], w_exp_gu[l], w_exp_down[l],
                             w_sh_gu[l], w_sh_down[l])
    return x
```

```cpp
#include <hip/hip_runtime.h>
#include <cstdio>
#include <cstdint>

#define GAS __attribute__((address_space(1)))
#define LAS __attribute__((address_space(3)))
typedef unsigned short bf16;
typedef short bf16x8 __attribute__((ext_vector_type(8)));
typedef short s16x4 __attribute__((ext_vector_type(4)));
typedef float f32x4 __attribute__((ext_vector_type(4)));
typedef float f32x2 __attribute__((ext_vector_type(2)));
typedef float f32x16 __attribute__((ext_vector_type(16)));
typedef unsigned u32x4 __attribute__((ext_vector_type(4)));
typedef unsigned u32x2 __attribute__((ext_vector_type(2)));
typedef int i32x4 __attribute__((ext_vector_type(4)));

constexpr int NB = 2, SEQ = 16384, T = NB * SEQ, D = 1024, NIN = 7168;
constexpr int NE = 64, TOPK = 8, ED = 256, NEX = NE + 1;
constexpr float EPS = 1e-6f;
constexpr float C2 = 0.125f * 1.4426950408889634f;
constexpr float LAMBDA_INIT = 0.2f;
constexpr int NWAVES = 8, NTHREADS = 512;

constexpr size_t MiB = 1u << 20;
constexpr size_t WS_CTL = 0, CTL_ZERO_BYTES = 64 * 1024;
constexpr size_t WS_MOD = 1 * MiB;
constexpr size_t WS_ROPE = 1 * MiB + 64 * 1024;
constexpr size_t WS_TKE = 3 * MiB + 256 * 1024;
constexpr size_t WS_TKR = 4 * MiB + 256 * 1024;
constexpr size_t WS_TKW = 5 * MiB + 256 * 1024;
constexpr size_t WS_POS = 6 * MiB + 256 * 1024;
constexpr size_t WS_CNT = 7 * MiB + 256 * 1024;
constexpr size_t WS_TE = WS_CNT + 64 * 1024;
constexpr size_t WS_META = WS_TE + 8 * 1024;
constexpr size_t WS_TOK = 7 * MiB + 512 * 1024;
constexpr size_t WS_WGT = 8 * MiB + 768 * 1024;
constexpr int RMAX = 262144 + 64 * 256 + T;
static_assert(WS_TOK + (size_t)RMAX * 4 <= WS_WGT && WS_WGT + (size_t)RMAX * 4 <= 10 * MiB, "small region");
constexpr size_t WS_WRH = 10 * MiB, WS_WRL = 10 * MiB + 128 * 1024;
constexpr size_t WS_WDN = 11 * MiB;
constexpr size_t WS_WIN = WS_WDN + (size_t)NEX * 1024 * 256 * 2 + MiB / 2;
constexpr size_t WS_WPW2 = WS_WIN + 14 * MiB, WS_WOUT = WS_WPW2 + 2 * MiB;
constexpr size_t WS_WGU = WS_WOUT + 2 * MiB;
constexpr size_t WS_U = 127 * MiB;
constexpr size_t WS_Q = WS_U + 64 * MiB, WS_K = WS_Q + 64 * MiB, WS_V = WS_K + 64 * MiB, WS_GC = WS_V + 64 * MiB, WS_GA = WS_GC + 64 * MiB;
constexpr size_t WS_END = WS_GA + 64 * MiB;
static_assert(WS_WGU + (size_t)NEX * 512 * 1024 * 2 <= WS_U && WS_END <= 512 * MiB, "ws map");
constexpr size_t WS_ACT = 359 * MiB;
constexpr size_t WS_Y = 44 * MiB;
static_assert(WS_ACT + (size_t)RMAX * 512 <= WS_END && WS_Y + (size_t)(262144 + 64 * 256) * 1024 <= WS_ACT && WS_Y >= WS_WDN + (size_t)NEX * 1024 * 256 * 2, "moe overlays");
constexpr int CW_BAR = 1024;

#ifndef DBG_A6
#define DBG_A6 WS_U
#endif
constexpr int RING_BYTES = 131072;
constexpr int LDS_BYTES = 163840;
constexpr int EPI_SCR = RING_BYTES;
constexpr int MISC_OFF = LDS_BYTES - 256;

#define LDS_WAIT() asm volatile("s_waitcnt lgkmcnt(0)" ::: "memory")
#define VM_WAIT() asm volatile("s_waitcnt vmcnt(0)" ::: "memory")
typedef __bf16 bf16x2_t __attribute__((ext_vector_type(2)));
__device__ __forceinline__ unsigned cvt_pk_bf16(float lo, float hi) { const f32x2 v = {lo, hi}; const bf16x2_t b = __builtin_convertvector(v, bf16x2_t); return __builtin_bit_cast(unsigned, b); }
__device__ __forceinline__ float bf_lo(unsigned u) { return __builtin_bit_cast(float, u << 16); }
__device__ __forceinline__ float bf_hi(unsigned u) { return __builtin_bit_cast(float, u & 0xffff0000u); }
__device__ __forceinline__ float sigmoidf_(float x) { return __builtin_amdgcn_rcpf(1.f + __expf(-x)); }
__device__ __forceinline__ float wave_sum(float v) {
#pragma unroll
    for (int o = 1; o < 64; o <<= 1) v += __shfl_xor(v, o);
    return v;
}
__device__ __forceinline__ float wave_max(float v) {
#pragma unroll
    for (int o = 1; o < 64; o <<= 1) v = fmaxf(v, __shfl_xor(v, o));
    return v;
}

namespace pg8 {
typedef int i32x8_t __attribute__((ext_vector_type(8)));
typedef int i32x4_t __attribute__((ext_vector_type(4)));
constexpr int BM = 256, BK = 64, HALF = 128, HTB = HALF * BK * 2, STAGE_BYTES = 8 * HTB, NXCD = 8, WGM = 8;
__host__ __device__ __forceinline__ int lds_byte(int r, int c) { const int st = (r >> 4) * 2 + (c >> 5), rr = r & 15, cc = c & 31, ob = rr * 64 + cc * 2; return st * 1024 + (ob ^ (((ob >> 9) & 1) << 5)); }
__host__ __device__ __forceinline__ void stage_rc(int b, int& R, int& C) { const int st = b / 1024, sb = b % 1024, swz = sb ^ (((sb >> 9) & 1) << 5); R = (st >> 1) * 16 + swz / 64; C = (st & 1) * 32 + (swz % 64) / 2; }
__host__ __device__ __forceinline__ int perm32(int rho) { const int n = rho >> 4, i = rho & 15; return 8 * (i >> 2) + 4 * n + (i & 3); }

struct Unit { int pm, pn; };
struct Gemm { const bf16* A; const bf16* Bt; int M, N, K; };

struct StaticOrder {
    int nM, nN, nwg, G, c;
    const int* tok;
    __host__ __device__ void init(int M, int N, int G_, int c_) { nM = M / BM; nN = N / BM; nwg = nM * nN; G = G_; c = c_; tok = nullptr; }
    __host__ __device__ bool next(int i, Unit& u) const {
        const long L = (long)i * G + c; if (L >= nwg) return false;
        int wgid = (int)L; { const int q = nwg / NXCD, r = nwg % NXCD, xcd = wgid % NXCD, off = wgid / NXCD; wgid = (xcd < r ? xcd * (q + 1) : r * (q + 1) + (xcd - r) * q) + off; }
        const int nig = WGM * nN, gid = wgid / nig, fm = gid * WGM, gsz = (nM - fm) < WGM ? (nM - fm) : WGM;
        u.pm = fm + ((wgid % nig) % gsz); u.pn = (wgid % nig) / gsz; return true;
    }
};

template <class Epi, class Sched, bool ALIGN_EPI, bool SP2, bool GATHER, bool FP8 = false>
__device__ __forceinline__ void gemm_phase(LAS unsigned char* lds, const Gemm g, const Sched& S, const Epi& E) {
    const int tid = threadIdx.x, wid = __builtin_amdgcn_readfirstlane(tid >> 6), lane = tid & 63, wr = wid >> 2, wc = wid & 3, fr = lane & 15, fq = lane >> 4;
    const int K = g.K, nt = K / BK;
    unsigned voffA[2], voffB[2]; int RA[2]; unsigned CA2[2];
#pragma unroll
    for (int i = 0; i < 2; ++i) { int R, C; stage_rc(tid * 16 + i * 8192, R, C); const int Rb = Epi::PERM ? ((R & ~31) + perm32(R & 31)) : R;
        voffA[i] = (unsigned)(R * K + C) * 2u; voffB[i] = (unsigned)(Rb * K + C) * 2u; RA[i] = R; CA2[i] = (unsigned)C * 2u; }
    const size_t kstep = (size_t)(BK * 2);
    const size_t hstep = (size_t)HALF * K * 2;
    const size_t tstep = 2 * hstep;
    const unsigned ldsw = (unsigned)wid * 1024u;
    const int aoff = lds_byte(wr * 64 + fr, fq * 8), boff = lds_byte(wc * 32 + fr, fq * 8);
#define PG8_SA(b, h) (((b) * 2 + (h)) * HTB)
#define PG8_SB(b, h) ((4 + (b) * 2 + (h)) * HTB)
#define PG8_STAGE2(bufoff, gbase, o0, o1) do { \
        __builtin_amdgcn_global_load_lds((const unsigned*)((const char*)(gbase) + (o0)), (LAS unsigned*)(lds + (bufoff) + ldsw), 16, 0, 0); \
        __builtin_amdgcn_global_load_lds((const unsigned*)((const char*)(gbase) + (o1)), (LAS unsigned*)(lds + (bufoff) + ldsw + 8192), 16, 0, 0); } while (0)
#define PG8_STAGEB(bufoff, gbase) PG8_STAGE2(bufoff, gbase, voffB[0], voffB[1])
#define PG8_STAGEA(bufoff, gbase, h, o0, o1) do { if constexpr (GATHER) { PG8_STAGE2(bufoff, gbase, o0, o1); } else { PG8_STAGE2(bufoff, (gbase) + (h) * hstep, voffA[0], voffA[1]); } } while (0)
#define PG8_LD8(p) __builtin_shufflevector(*(const LAS i32x4_t*)(p), *(const LAS i32x4_t*)((p) + 1024), 0, 1, 2, 3, 4, 5, 6, 7)
#define PG8_LDA(dst, b, h) do { if constexpr (FP8) { _Pragma("unroll") for (int m = 0; m < 4; ++m) dst##8[m] = PG8_LD8(lds + PG8_SA(b, h) + aoff + m * 2048); } \
        else { _Pragma("unroll") for (int m = 0; m < 4; ++m) _Pragma("unroll") for (int k = 0; k < 2; ++k) dst[m][k] = *(const LAS bf16x8*)(lds + PG8_SA(b, h) + aoff + m * 2048 + k * 1024); } } while (0)
#define PG8_LDB(dst, b, h) do { if constexpr (FP8) { _Pragma("unroll") for (int n = 0; n < 2; ++n) dst##8[n] = PG8_LD8(lds + PG8_SB(b, h) + boff + n * 2048); } \
        else { _Pragma("unroll") for (int n = 0; n < 2; ++n) _Pragma("unroll") for (int k = 0; k < 2; ++k) dst[n][k] = *(const LAS bf16x8*)(lds + PG8_SB(b, h) + boff + n * 2048 + k * 1024); } } while (0)
#define PG8_CAT(x) __builtin_shufflevector(__builtin_bit_cast(i32x4_t, (x)[0]), __builtin_bit_cast(i32x4_t, (x)[1]), 0, 1, 2, 3, 4, 5, 6, 7)
#define PG8_MMA(ai, bj, At, Bt) do { __builtin_amdgcn_s_setprio(1); \
        if constexpr (FP8) { _Pragma("unroll") for (int m = 0; m < 4; ++m) _Pragma("unroll") for (int n = 0; n < 2; ++n) \
            asm volatile("v_mfma_f32_16x16x128_f8f6f4 %0, %1, %2, %0" : "+v"(acc[ai][bj][m][n]) : "v"(Bt##8[n]), "v"(At##8[m])); }   \
        else { _Pragma("unroll") for (int m = 0; m < 4; ++m) _Pragma("unroll") for (int n = 0; n < 2; ++n) _Pragma("unroll") for (int k = 0; k < 2; ++k) \
            acc[ai][bj][m][n] = __builtin_amdgcn_mfma_f32_16x16x32_bf16(Bt[n][k], At[m][k], acc[ai][bj][m][n], 0, 0, 0); } \
        __builtin_amdgcn_s_setprio(0); } while (0)
#define PG8_WAIT_V(n) asm volatile("s_waitcnt vmcnt(" #n ")" ::: "memory")
#define PG8_WAIT_L(n) asm volatile("s_waitcnt lgkmcnt(" #n ")" ::: "memory")
#define PG8_BAR __builtin_amdgcn_s_barrier()
#define PG8_SCHED __builtin_amdgcn_sched_barrier(0)
#define PG8_SETA(o, u) do { _Pragma("unroll") for (int h_ = 0; h_ < 2; ++h_) _Pragma("unroll") for (int i_ = 0; i_ < 2; ++i_) { \
        if constexpr (GATHER) { int t_ = S.tok[(u).pm * 256 + h_ * 128 + RA[i_]]; t_ = t_ < 0 ? 0 : t_; o[h_][i_] = (unsigned)t_ * (unsigned)(K * 2) + CA2[i_]; } \
        else { o[h_][i_] = (unsigned)(h_ * hstep) + voffA[i_]; } } } while (0)
    Unit cur, nxt; int ui = 0;
    if (!S.next(0, cur)) return;
    f32x4 acc[2][2][4][2];
#pragma unroll
    for (int a = 0; a < 2; ++a)
#pragma unroll
        for (int b = 0; b < 2; ++b)
#pragma unroll
            for (int m = 0; m < 4; ++m)
#pragma unroll
                for (int n = 0; n < 2; ++n) acc[a][b][m][n] = (f32x4){0.f, 0.f, 0.f, 0.f};
    bf16x8 At[4][2], B0[2][2], B1[2][2];
    i32x8_t At8[4], B08[2], B18[2];
    unsigned cO[2][2], nO[2][2];
    if constexpr (GATHER) { PG8_SETA(cO, cur); VM_WAIT(); }
    else { cO[0][0] = cO[0][1] = cO[1][0] = cO[1][1] = 0u; }
    const char* cA = GATHER ? (const char*)g.A : (const char*)g.A + (size_t)cur.pm * tstep; const char* cB = (const char*)g.Bt + (size_t)cur.pn * tstep;
    if constexpr (SP2) {
        PG8_STAGEB(PG8_SB(0, 0), cB); PG8_STAGEB(PG8_SB(0, 1), cB + hstep); PG8_STAGEA(PG8_SA(0, 0), cA, 0, cO[0][0], cO[0][1]); PG8_STAGEA(PG8_SA(0, 1), cA, 1, cO[1][0], cO[1][1]);
        if (wr == 1) PG8_BAR;
        PG8_WAIT_V(2); PG8_BAR;
        PG8_STAGEB(PG8_SB(1, 0), cB + kstep); PG8_STAGEA(PG8_SA(1, 0), cA + kstep, 0, cO[0][0], cO[0][1]); PG8_STAGEB(PG8_SB(1, 1), cB + hstep + kstep);
        PG8_WAIT_V(6); PG8_BAR;
    }
    for (;;) {
        const bool has_next = S.next(ui + 1, nxt);
        if constexpr (!GATHER) { nO[0][0] = nO[0][1] = nO[1][0] = nO[1][1] = 0u; }
        else if (has_next) { PG8_SETA(nO, nxt); } else {
#pragma unroll
            for (int h_ = 0; h_ < 2; ++h_)
#pragma unroll
                for (int i_ = 0; i_ < 2; ++i_) nO[h_][i_] = cO[h_][i_]; }
        const char* nA = GATHER ? (const char*)g.A : (has_next ? (const char*)g.A + (size_t)nxt.pm * tstep : cA);
        const char* nB = has_next ? (const char*)g.Bt + (size_t)nxt.pn * tstep : cB;
#pragma nounroll
        for (int t = 0; t < nt; t += 2) {
            const bool last = (t == nt - 2);
            const char* a1 = cA + (size_t)(t + 1) * kstep;
            const char* a2 = last ? nA : cA + (size_t)(t + 2) * kstep; const char* b2 = last ? nB : cB + (size_t)(t + 2) * kstep;
            const char* a3 = a2 + kstep; const char* b3 = b2 + kstep;
            const unsigned x00 = last ? nO[0][0] : cO[0][0], x01 = last ? nO[0][1] : cO[0][1], x10 = last ? nO[1][0] : cO[1][0], x11 = last ? nO[1][1] : cO[1][1];
            PG8_LDB(B0, 0, 0); PG8_LDB(B1, 0, 1); PG8_SCHED; PG8_LDA(At, 0, 0); PG8_STAGEA(PG8_SA(1, 1), a1, 1, cO[1][0], cO[1][1]);
            PG8_WAIT_V(8); PG8_WAIT_L(0); PG8_BAR; PG8_MMA(0, 0, At, B0); PG8_MMA(0, 1, At, B1); PG8_BAR; PG8_SCHED;
            PG8_LDA(At, 0, 1); PG8_STAGEB(PG8_SB(0, 0), b2); PG8_STAGEB(PG8_SB(0, 1), b2 + hstep); PG8_STAGEA(PG8_SA(0, 0), a2, 0, x00, x01);
            PG8_WAIT_V(8); PG8_WAIT_L(0); PG8_BAR; PG8_MMA(1, 0, At, B0); PG8_MMA(1, 1, At, B1); PG8_BAR; PG8_SCHED;
            PG8_LDB(B0, 1, 0); PG8_LDB(B1, 1, 1); PG8_SCHED; PG8_LDA(At, 1, 0); PG8_STAGEA(PG8_SA(0, 1), a2, 1, x10, x11);
            PG8_WAIT_V(8); PG8_WAIT_L(0); PG8_BAR; PG8_MMA(0, 0, At, B0); PG8_MMA(0, 1, At, B1); PG8_BAR; PG8_SCHED;
            PG8_LDA(At, 1, 1); PG8_STAGEB(PG8_SB(1, 0), b3); PG8_STAGEB(PG8_SB(1, 1), b3 + hstep); PG8_STAGEA(PG8_SA(1, 0), a3, 0, x00, x01);
            PG8_WAIT_V(8); PG8_WAIT_L(0); PG8_BAR; PG8_MMA(1, 0, At, B0); PG8_MMA(1, 1, At, B1); PG8_BAR; PG8_SCHED;
        }
        if constexpr (ALIGN_EPI) { if (wr == 0) PG8_BAR; }
        if constexpr (FP8) asm volatile("s_nop 15\n\ts_nop 15" ::: "memory");
        E(acc, cur, wr, wc, fr, fq);
        if (!has_next) break;
#pragma unroll
        for (int a = 0; a < 2; ++a)
#pragma unroll
            for (int b = 0; b < 2; ++b)
#pragma unroll
                for (int m = 0; m < 4; ++m)
#pragma unroll
                    for (int n = 0; n < 2; ++n) acc[a][b][m][n] = (f32x4){0.f, 0.f, 0.f, 0.f};
        cur = nxt; cA = nA; cB = nB; ++ui;
#pragma unroll
        for (int h_ = 0; h_ < 2; ++h_)
#pragma unroll
            for (int i_ = 0; i_ < 2; ++i_) cO[h_][i_] = nO[h_][i_];
        if constexpr (ALIGN_EPI) { if (wr == 1) PG8_BAR; }
    }
    PG8_WAIT_V(0);
    if constexpr (!ALIGN_EPI) { if (wr == 0) PG8_BAR; }
    PG8_BAR;
#undef PG8_SA
#undef PG8_SB
#undef PG8_STAGE2
#undef PG8_STAGEB
#undef PG8_STAGEA
#undef PG8_LDA
#undef PG8_LD8
#undef PG8_LDB
#undef PG8_MMA
#undef PG8_CAT
#undef PG8_WAIT_V
#undef PG8_WAIT_L
#undef PG8_BAR
#undef PG8_SCHED
#undef PG8_SETA
}
}

#define XB_TMO      128
#define XB_XCNT(j)  (256  + 64 * (j))
#define XB_XSUB(j)  (1280 + 64 * (j))
#define XB_XGEN(j)  (2304 + 64 * (j))
#define XB_TOP      3328
#define XB_TOPGEN   3392
#define XCD_BAR_WORDS 3456
#define XB_SPIN_CAP (1u << 18)
__device__ __forceinline__ unsigned xb_ld(unsigned* p)              { return __hip_atomic_load(p, __ATOMIC_RELAXED, __HIP_MEMORY_SCOPE_AGENT); }
__device__ __forceinline__ unsigned xb_add(unsigned* p, unsigned v) { return __hip_atomic_fetch_add(p, v, __ATOMIC_RELAXED, __HIP_MEMORY_SCOPE_AGENT); }
__device__ __forceinline__ unsigned xb_xcc_id() { return (unsigned)__builtin_amdgcn_s_getreg((3 << 11) | 20) & 0xFu; }
#define XB_SPIN(cond, bar) do { unsigned _sp = 0; while (cond) { __builtin_amdgcn_s_sleep(1); \
    if ((++_sp & 255u) == 0u) { if (xb_ld(&(bar)[XB_TMO])) break; if (_sp > XB_SPIN_CAP) { atomicAdd(&(bar)[XB_TMO], 1u); break; } } } } while (0)
struct XcdBarrier { unsigned* bar; unsigned x; volatile LAS unsigned* st; };
__device__ __forceinline__ XcdBarrier xcd_barrier_post(unsigned* bar, volatile LAS unsigned* st) {
    XcdBarrier b; b.bar = bar; b.x = xb_xcc_id(); b.st = st;
    if (threadIdx.x == 0) (void)xb_add(&bar[XB_XCNT(b.x)], 1u);
    return b;
}
__device__ __forceinline__ void xcd_barrier_complete(unsigned* bar, unsigned x, unsigned& nloc, unsigned& nx) {
    const unsigned G = gridDim.x * gridDim.y * gridDim.z;
    unsigned sum, cnt, mine, sp = 0u;
    for (;;) {
        sum = 0u; cnt = 0u; mine = 0u;
#pragma unroll
        for (unsigned j = 0; j < 16; ++j) { const unsigned c = xb_ld(&bar[XB_XCNT(j)]); sum += c; cnt += (c > 0u) ? 1u : 0u; mine = (j == x) ? c : mine; }
        if (sum == G) break;
        __builtin_amdgcn_s_sleep(1);
        if ((++sp & 255u) == 0u) { if (xb_ld(&bar[XB_TMO])) break; if (sp > XB_SPIN_CAP) { atomicAdd(&bar[XB_TMO], 1u); break; } }
    }
    nloc = mine > 0u ? mine : 1u; nx = cnt > 0u ? cnt : 1u;
}
__device__ __forceinline__ void xcd_barrier(const XcdBarrier& b) {
    asm volatile("s_waitcnt vmcnt(0)" ::: "memory");
    __syncthreads();
    if (threadIdx.x == 0) {
        unsigned* bar = b.bar;
        __builtin_amdgcn_s_waitcnt(0);
        unsigned nloc = b.st[0], nx = b.st[1];
        if (nloc == 0u) { xcd_barrier_complete(bar, b.x, nloc, nx); b.st[0] = nloc; b.st[1] = nx; }
        const unsigned old = xb_add(&bar[XB_XSUB(b.x)], 1u);
        const unsigned gen = old / nloc;
        if (old + 1u == (gen + 1u) * nloc) {
            __builtin_amdgcn_fence(__ATOMIC_RELEASE, "agent");
            asm volatile("s_waitcnt vmcnt(0)" ::: "memory");
            const unsigned og = xb_add(&bar[XB_TOP], 1u);
            const unsigned tg = og / nx;
            if (og + 1u == (tg + 1u) * nx) xb_add(&bar[XB_TOPGEN], 1u);
            else XB_SPIN(xb_ld(&bar[XB_TOPGEN]) == tg, bar);
            __builtin_amdgcn_fence(__ATOMIC_ACQUIRE, "agent");
            xb_add(&bar[XB_XGEN(b.x)], 1u);
            asm volatile("s_waitcnt vmcnt(0)" ::: "memory");
        } else {
            XB_SPIN(xb_ld(&bar[XB_XGEN(b.x)]) == gen, bar);
            __builtin_amdgcn_fence(__ATOMIC_ACQUIRE, "agent");
            asm volatile("s_waitcnt vmcnt(0)" ::: "memory");
        }
    }
    __syncthreads();
}

struct Args { const void* in[28]; float* out; unsigned char* ws; int ph_lo, ph_hi; };
struct Frame {
    LAS unsigned char* lds;
    int tid, lane, wave, vcu, G;
    unsigned char* ws; float* out;
    const __attribute__((address_space(4))) unsigned char* ka;
    __device__ __forceinline__ const float* in(int i) const { return ((const float* const __attribute__((address_space(4)))*)ka)[i]; }
};
enum { I_X = 0, I_C, I_POS, I_WADA, I_BADA, I_N1G, I_WIN, I_CDW, I_CDWB, I_CLNG, I_CLNB, I_WPW2, I_BPW2, I_QNG, I_KNG, I_LQ1, I_LK1, I_LQ2, I_LK2, I_SUBG, I_WOUT, I_N2G, I_WR, I_RB, I_WEGU, I_WEDN, I_WSGU, I_WSDN };

__device__ __forceinline__ int win_map(int n) {
    if (n < 1024) return 256 * (n >> 7) + (n & 127);
    if (n < 2048) { const int j = n - 1024; return 256 * (j >> 7) + 128 + (j & 127); }
    if (n < 4096) { const int qk = (n - 2048) >> 10, j = (n - 2048) & 1023, g = j >> 6, dl = j & 63; const int tile = 8 + 4 * qk + (g >> 2), wc = g & 3;
        int bj, fq, e; if (dl < 8) { bj = 0; fq = 0; e = dl; } else if (dl < 16) { bj = 1; fq = 0; e = dl - 8; } else { const int rho = dl - 16; bj = rho / 24; fq = 1 + (rho % 24) / 8; e = rho & 7; }
        return 256 * tile + 128 * bj + 32 * wc + 8 * fq + e; }
    return n;
}
__device__ __forceinline__ int glu_map(int n) { const int j = n & 255; return 256 * (j >> 7) + ((n >> 8) << 7) + (j & 127); }
__device__ __forceinline__ int qk_dim(int bj, int fq, int e) { return fq == 0 ? bj * 8 + e : 16 + bj * 24 + (fq - 1) * 8 + e; }

template <int MAP>
__device__ __forceinline__ void transpose_item(const float* W, int K, int N, bf16* WT, LAS float* scr, int item, int lane) {
    const int nblk = N / 32, kb = item / nblk, nb = item % nblk, k0 = 64 * kb, n0 = 32 * nb;
    {
        const int rr = lane >> 3, c4 = (lane & 7) * 4; f32x4 t[8];
#pragma unroll
        for (int i = 0; i < 8; ++i) t[i] = __builtin_nontemporal_load((const f32x4*)(W + (size_t)(k0 + 8 * i + rr) * N + n0 + c4));
#pragma unroll
        for (int i = 0; i < 8; ++i) { LAS float* d = scr + (8 * i + rr) * 33 + c4; d[0] = t[i].x; d[1] = t[i].y; d[2] = t[i].z; d[3] = t[i].w; }
    }
    LDS_WAIT(); asm volatile("" ::: "memory");
    const int c = lane & 7;
#pragma unroll
    for (int j = 0; j < 4; ++j) { const int n = (lane >> 3) + 8 * j; const LAS float* s = scr + (8 * c) * 33 + n;
        u32x4 o; o.x = cvt_pk_bf16(s[0 * 33], s[1 * 33]); o.y = cvt_pk_bf16(s[2 * 33], s[3 * 33]); o.z = cvt_pk_bf16(s[4 * 33], s[5 * 33]); o.w = cvt_pk_bf16(s[6 * 33], s[7 * 33]);
        const int nn = n0 + n; const int row = MAP == 1 ? win_map(nn) : (MAP == 2 ? glu_map(nn) : nn);
        *(u32x4*)(WT + (size_t)row * K + k0 + 8 * c) = o; }
    LDS_WAIT(); asm volatile("" ::: "memory");
}

constexpr float WDN_SCALE = 16.f, ACT_SCALE = 8.f;
constexpr float WIN_SCALE = 32.f;
template <int MAP>
__device__ __forceinline__ void transpose_item8(const float* W, int K, int N, unsigned char* WT, LAS float* scr, int item, int lane, float scale = WIN_SCALE) {
    const int nblk = N / 32, kb = item / nblk, nb = item % nblk, k0 = 64 * kb, n0 = 32 * nb;
    {
        const int rr = lane >> 3, c4 = (lane & 7) * 4; f32x4 t[8];
#pragma unroll
        for (int i = 0; i < 8; ++i) t[i] = __builtin_nontemporal_load((const f32x4*)(W + (size_t)(k0 + 8 * i + rr) * N + n0 + c4));
#pragma unroll
        for (int i = 0; i < 8; ++i) { LAS float* d = scr + (8 * i + rr) * 33 + c4; d[0] = t[i].x * scale; d[1] = t[i].y * scale; d[2] = t[i].z * scale; d[3] = t[i].w * scale; }
    }
    LDS_WAIT(); asm volatile("" ::: "memory");
    const int c = lane & 7;
#pragma unroll
    for (int j = 0; j < 4; ++j) { const int n = (lane >> 3) + 8 * j; const LAS float* sp = scr + (8 * c) * 33 + n;
        int d0 = 0, d1 = 0;
        d0 = __builtin_amdgcn_cvt_pk_fp8_f32(sp[0 * 33], sp[1 * 33], d0, false); d0 = __builtin_amdgcn_cvt_pk_fp8_f32(sp[2 * 33], sp[3 * 33], d0, true);
        d1 = __builtin_amdgcn_cvt_pk_fp8_f32(sp[4 * 33], sp[5 * 33], d1, false); d1 = __builtin_amdgcn_cvt_pk_fp8_f32(sp[6 * 33], sp[7 * 33], d1, true);
        const int nn = n0 + n; const int row = MAP == 1 ? win_map(nn) : (MAP == 2 ? glu_map(nn) : nn);
        *(u32x2*)(WT + (size_t)row * K + k0 + 8 * c) = (u32x2){(unsigned)d0, (unsigned)d1}; }
    LDS_WAIT(); asm volatile("" ::: "memory");
}
__device__ __forceinline__ void phase0(Frame& F) {
    if (F.vcu < 96) {
        const int col = F.vcu * 64 + F.lane; const float* c = F.in(I_C); const float* wa = F.in(I_WADA);
        float a0 = 0.f, a1 = 0.f;
        for (int k = F.wave * 128; k < F.wave * 128 + 128; ++k) { const float c0 = c[k], c1 = c[1024 + k]; const float s0 = c0 * sigmoidf_(c0), s1 = c1 * sigmoidf_(c1); const float w = wa[(size_t)k * 6144 + col]; a0 += s0 * w; a1 += s1 * w; }
        LAS float* red = (LAS float*)F.lds;
        red[(F.wave * 2 + 0) * 64 + F.lane] = a0; red[(F.wave * 2 + 1) * 64 + F.lane] = a1;
        __syncthreads();
        if (F.wave == 0) { float s0 = 0.f, s1 = 0.f;
#pragma unroll
            for (int w = 0; w < 8; ++w) { s0 += red[(w * 2 + 0) * 64 + F.lane]; s1 += red[(w * 2 + 1) * 64 + F.lane]; }
            float* mod = (float*)(F.ws + WS_MOD); const float bb = F.in(I_BADA)[col]; mod[col] = s0 + bb; mod[6144 + col] = s1 + bb; }
        __syncthreads();
    }
    LAS float* scr = (LAS float*)(F.lds + F.wave * 16384);
    const int gw = F.vcu * NWAVES + F.wave, NGW = F.G * NWAVES;
    constexpr int I_IN = 16 * (NIN / 32), I_SQ = 16 * 32, I_EGU = 16 * 16, I_EDN = 4 * 32;
    constexpr int NITEMS = I_IN + 2 * I_SQ + NEX * I_EGU + NEX * I_EDN;
    for (int it = gw; it < NITEMS; it += NGW) {
        int r = it;
        if (r < I_IN) { transpose_item8<1>(F.in(I_WIN), 1024, NIN, (unsigned char*)(F.ws + WS_WIN), scr, r, F.lane); continue; } r -= I_IN;
        if (r < I_SQ) { transpose_item8<0>(F.in(I_WPW2), 1024, 1024, (unsigned char*)(F.ws + WS_WPW2), scr, r, F.lane); continue; } r -= I_SQ;
        if (r < I_SQ) { transpose_item<0>(F.in(I_WOUT), 1024, 1024, (bf16*)(F.ws + WS_WOUT), scr, r, F.lane); continue; } r -= I_SQ;
        if (r < NEX * I_EGU) { const int e = r / I_EGU, rr = r % I_EGU; const float* W = e < NE ? F.in(I_WEGU) + (size_t)e * 1024 * 512 : F.in(I_WSGU);
            transpose_item8<2>(W, 1024, 512, (unsigned char*)(F.ws + WS_WGU) + (size_t)e * 512 * 1024, scr, rr, F.lane); continue; } r -= NEX * I_EGU;
        { const int e = r / I_EDN, rr = r % I_EDN; const float* W = e < NE ? F.in(I_WEDN) + (size_t)e * 256 * 1024 : F.in(I_WSDN);
            transpose_item8<0>(W, 256, 1024, (unsigned char*)(F.ws + WS_WDN) + (size_t)e * 1024 * 256, scr, rr, F.lane, WDN_SCALE); }
    }
    {
        const float* wr = F.in(I_WR); bf16* wh = (bf16*)(F.ws + WS_WRH); bf16* wl = (bf16*)(F.ws + WS_WRL);
        for (int idx = F.vcu * NTHREADS + F.tid; idx < 64 * 1024; idx += F.G * NTHREADS) { const int e = idx >> 10, k = idx & 1023; const float w = wr[k * 64 + e];
            const unsigned h = cvt_pk_bf16(w, 0.f) & 0xffffu; const float r = w - bf_lo(h); wh[idx] = (bf16)h; wl[idx] = (bf16)(cvt_pk_bf16(r, 0.f) & 0xffffu); }
    }
    {
        const int* pos = (const int*)F.in(I_POS); float* rope = (float*)(F.ws + WS_ROPE);
        for (int idx = F.vcu * NTHREADS + F.tid; idx < T * 8; idx += F.G * NTHREADS) {
            const int tok = idx >> 3, i = idx & 7;
            const unsigned fb = i == 0 ? 1065353216u : i == 1 ? 1044812719u : i == 2 ? 1025116360u : i == 3 ? 1005516622u : i == 4 ? 985226530u : i == 5 ? 965724408u : i == 6 ? 945754309u : 925697960u;
            const float ang = (float)pos[tok] * __builtin_bit_cast(float, fb);
            double rv = (double)ang * 0.15915494309189535; rv -= floor(rv);
            const float fr_ = (float)rv;
            rope[tok * 16 + i] = __builtin_amdgcn_cosf(fr_); rope[tok * 16 + 8 + i] = __builtin_amdgcn_sinf(fr_);
        }
    }
}

__device__ __forceinline__ void phase1(Frame& F) {
    const float* mod = (const float*)(F.ws + WS_MOD); const float* gn = F.in(I_N1G); bf16* H = (bf16*)F.out;
    const int gw = F.vcu * NWAVES + F.wave, NGW = F.G * NWAVES;
    for (int m = gw; m < T; m += NGW) {
        const int b = m >> 14;
        const f32x4* xr = (const f32x4*)(F.in(I_X) + (size_t)m * D) + F.lane;
        f32x4 v[4]; float s = 0.f;
#pragma unroll
        for (int j = 0; j < 4; ++j) { v[j] = xr[64 * j]; s += (v[j].x * v[j].x + v[j].y * v[j].y) + (v[j].z * v[j].z + v[j].w * v[j].w); }
        const float rstd = __builtin_amdgcn_rsqf(wave_sum(s) * (1.f / D) + EPS);
        unsigned* o4 = (unsigned*)((unsigned char*)H + (size_t)m * D) + F.lane;
#pragma unroll
        for (int j = 0; j < 4; ++j) { const int col = 4 * F.lane + 256 * j;
            const f32x4 g = *(const f32x4*)(gn + col), sc = *(const f32x4*)(mod + b * 6144 + 1024 + col), sh = *(const f32x4*)(mod + b * 6144 + col);
            const f32x4 y = v[j] * rstd * g * (sc + 1.f) + sh;
            int w = 0; w = __builtin_amdgcn_cvt_pk_fp8_f32(y.x, y.y, w, false); w = __builtin_amdgcn_cvt_pk_fp8_f32(y.z, y.w, w, true); o4[64 * j] = (unsigned)w; }
    }
}

struct EpiIn {
    static constexpr bool PERM = true;
    static constexpr float SI = 1.f / WIN_SCALE;
    bf16 *U, *Q, *Kb, *V, *GC, *GA; const float* rope; const float* qg; const float* kg; LAS unsigned char* scr;
    __device__ __forceinline__ void operator()(const f32x4 (&acc)[2][2][4][2], const pg8::Unit& u, int wr, int wc, int fr, int fq) const {
        asm volatile("" : "+v"(fr), "+v"(fq));
        const int pn = u.pn, row0 = u.pm * 256 + wr * 64 + fr;
        if (pn < 8) {
#pragma unroll
            for (int ai = 0; ai < 2; ++ai)
#pragma unroll
                for (int m = 0; m < 4; ++m) { const int row = row0 + ai * 128 + m * 16; float r[8];
#pragma unroll
                    for (int n = 0; n < 2; ++n)
#pragma unroll
                        for (int i = 0; i < 4; ++i) r[4 * n + i] = (acc[ai][0][m][n][i] * SI) * sigmoidf_(acc[ai][1][m][n][i] * SI);
                    u32x4 w; w.x = cvt_pk_bf16(r[0], r[1]); w.y = cvt_pk_bf16(r[2], r[3]); w.z = cvt_pk_bf16(r[4], r[5]); w.w = cvt_pk_bf16(r[6], r[7]);
                    *(u32x4*)(U + (size_t)row * D + pn * 128 + wc * 32 + fq * 8) = w; }
        } else if (pn < 16) {
            const bool isq = pn < 12; const int g = 4 * ((pn - 8) & 3) + wc, h = g >> 1, mp = g & 1;
            const float* gp = isq ? qg : kg; float gn[2][8];
#pragma unroll
            for (int bj = 0; bj < 2; ++bj)
#pragma unroll
                for (int e = 0; e < 8; ++e) gn[bj][e] = gp[qk_dim(bj, fq, e)] * (isq ? C2 : 1.f);
            bf16* dst = isq ? Q : Kb;
#pragma unroll
            for (int ai = 0; ai < 2; ++ai)
#pragma unroll
                for (int m = 0; m < 4; ++m) { const int row = row0 + ai * 128 + m * 16, b = row >> 14, s = row & (SEQ - 1);
                    float v[2][8]; float ss = 0.f;
#pragma unroll
                    for (int bj = 0; bj < 2; ++bj)
#pragma unroll
                        for (int n = 0; n < 2; ++n)
#pragma unroll
                            for (int i = 0; i < 4; ++i) { const float t = acc[ai][bj][m][n][i] * SI; v[bj][4 * n + i] = t; ss += t * t; }
                    ss += __shfl_xor(ss, 16); ss += __shfl_xor(ss, 32);
                    const float rstd = __builtin_amdgcn_rsqf(ss * (1.f / 64.f) + EPS);
#pragma unroll
                    for (int bj = 0; bj < 2; ++bj)
#pragma unroll
                        for (int e = 0; e < 8; ++e) v[bj][e] = v[bj][e] * rstd * gn[bj][e];
                    if (fq == 0) { const f32x4* rp = (const f32x4*)(rope + (size_t)row * 16); const f32x4 c0 = rp[0], c1 = rp[1], s0 = rp[2], s1 = rp[3];
#pragma unroll
                        for (int e = 0; e < 8; ++e) { const float cs = e < 4 ? c0[e & 3] : c1[e & 3], sn = e < 4 ? s0[e & 3] : s1[e & 3]; const float x1 = v[0][e], x2 = v[1][e];
                            v[0][e] = x1 * cs - x2 * sn; v[1][e] = x2 * cs + x1 * sn; } }
                    unsigned char* rowp = (unsigned char*)dst + ((size_t)((b * 8 + h) * 2 + mp) * SEQ + s) * 64;
                    const int sw = isq ? 0 : ((s >> 2) & 3);
                    u32x4 w;
                    { int d;
                      d = 0; d = __builtin_amdgcn_cvt_pk_fp8_f32(v[0][0], v[0][1], d, false); d = __builtin_amdgcn_cvt_pk_fp8_f32(v[0][2], v[0][3], d, true); w.x = (unsigned)d;
                      d = 0; d = __builtin_amdgcn_cvt_pk_fp8_f32(v[0][4], v[0][5], d, false); d = __builtin_amdgcn_cvt_pk_fp8_f32(v[0][6], v[0][7], d, true); w.y = (unsigned)d;
                      d = 0; d = __builtin_amdgcn_cvt_pk_fp8_f32(v[1][0], v[1][1], d, false); d = __builtin_amdgcn_cvt_pk_fp8_f32(v[1][2], v[1][3], d, true); w.z = (unsigned)d;
                      d = 0; d = __builtin_amdgcn_cvt_pk_fp8_f32(v[1][4], v[1][5], d, false); d = __builtin_amdgcn_cvt_pk_fp8_f32(v[1][6], v[1][7], d, true); w.w = (unsigned)d; }
                    *(u32x4*)(rowp + ((fq ^ sw) << 4)) = w; }
        } else if (pn < 20) {
            LAS unsigned char* wsb = scr + (wr * 4 + wc) * 2048; const int lane_ = fr + 16 * fq;
#pragma unroll
            for (int ai = 0; ai < 2; ++ai)
#pragma unroll
                for (int bj = 0; bj < 2; ++bj) {
#pragma unroll
                    for (int m = 0; m < 4; ++m) { const int kk = 16 * m + fr;
                        const int p = 32 * ((kk >> 2) & 1) + 16 * (kk >> 5) + (kk & 3) + 4 * ((kk & 31) >> 3);
#pragma unroll
                        for (int n = 0; n < 2; ++n) { const unsigned d01 = (unsigned)__builtin_amdgcn_cvt_pk_fp8_f32(acc[ai][bj][m][n][0] * SI, acc[ai][bj][m][n][1] * SI, 0, false);
                            const unsigned d23 = (unsigned)__builtin_amdgcn_cvt_pk_fp8_f32(acc[ai][bj][m][n][2] * SI, acc[ai][bj][m][n][3] * SI, 0, false);
#pragma unroll
                            for (int i = 0; i < 4; ++i) { const int e = 4 * n + i; const unsigned byte = ((i < 2 ? d01 : d23) >> (8 * (i & 1)));
                                const int sw = (2 * fq + (e >> 2)) & 3;
                                wsb[(fq * 8 + e) * 64 + ((((p >> 4) ^ sw) << 4) | (p & 15))] = (unsigned char)byte; } } }
                    LDS_WAIT(); asm volatile("" ::: "memory");
                    const u32x4 t0 = *(const LAS u32x4*)(wsb + lane_ * 32), t1 = *(const LAS u32x4*)(wsb + lane_ * 32 + 16);
                    const int row = u.pm * 256 + ai * 128 + wr * 64, b = row >> 14, s = row & (SEQ - 1), h = 2 * (pn - 16) + bj;
                    unsigned char* tp = (unsigned char*)V + (((size_t)(b * 8 + h) * 256 + (s >> 6)) * 128 + wc * 32) * 64 + lane_ * 32;
                    *(u32x4*)tp = t0; *(u32x4*)(tp + 16) = t1;
                    LDS_WAIT(); asm volatile("" ::: "memory"); }
        } else {
            bf16* dst = pn < 24 ? GC : GA; const int colt = ((pn - 20) & 3) * 256;
#pragma unroll
            for (int ai = 0; ai < 2; ++ai)
#pragma unroll
                for (int m = 0; m < 4; ++m) { const int row = row0 + ai * 128 + m * 16;
#pragma unroll
                    for (int bj = 0; bj < 2; ++bj) { float r[8];
#pragma unroll
                        for (int n = 0; n < 2; ++n)
#pragma unroll
                            for (int i = 0; i < 4; ++i) r[4 * n + i] = sigmoidf_(acc[ai][bj][m][n][i] * SI);
                        u32x4 w; w.x = cvt_pk_bf16(r[0], r[1]); w.y = cvt_pk_bf16(r[2], r[3]); w.z = cvt_pk_bf16(r[4], r[5]); w.w = cvt_pk_bf16(r[6], r[7]);
                        *(u32x4*)(dst + (size_t)row * D + colt + bj * 128 + wc * 32 + fq * 8) = w; } }
        }
    }
};

__device__ __forceinline__ void phase3(Frame& F) {
    const bf16* U = (const bf16*)(F.ws + WS_U); bf16* CV = (bf16*)F.out;
    const int ch = 2 * F.tid;
    float wa[31], wb[31];
#pragma unroll
    for (int j = 0; j < 31; ++j) { const f32x2 w = *(const f32x2*)(F.in(I_CDW) + j * 1024 + ch); wa[j] = w.x; wb[j] = w.y; }
    const f32x2 cb = *(const f32x2*)(F.in(I_CDWB) + ch);
    LAS float* tile = (LAS float*)F.lds;
    for (int unit = F.vcu; unit < T / 64; unit += F.G) {
        const int t0 = unit * 64, s0 = t0 & (SEQ - 1);
        float xa[38], xb[38];
#pragma unroll
        for (int k = 0; k < 30; ++k) { unsigned v = 0u; if (s0 - 30 + k >= 0) v = *(const unsigned*)(U + (size_t)(t0 - 30 + k) * D + ch); xa[k] = bf_lo(v); xb[k] = bf_hi(v); }
        for (int blk = 0; blk < 8; ++blk) {
#pragma unroll
            for (int k = 0; k < 8; ++k) { const unsigned v = *(const unsigned*)(U + (size_t)(t0 + blk * 8 + k) * D + ch); xa[30 + k] = bf_lo(v); xb[30 + k] = bf_hi(v); }
            LAS float* tl = tile + (blk & 1) * 8192;
#pragma unroll
            for (int i = 0; i < 8; ++i) { float a = cb.x, b = cb.y;
#pragma unroll
                for (int j = 0; j < 31; ++j) { a += xa[i + j] * wa[j]; b += xb[i + j] * wb[j]; }
                *(LAS f32x2*)(tl + i * 1024 + ch) = (f32x2){a, b}; }
#pragma unroll
            for (int k = 0; k < 30; ++k) { xa[k] = xa[k + 8]; xb[k] = xb[k + 8]; }
            __syncthreads();
            {
                const LAS float* rowp = tl + F.wave * 1024;
                f32x4 v[4];
#pragma unroll
                for (int jj = 0; jj < 2; ++jj) { v[2 * jj] = *(const LAS f32x4*)(rowp + 512 * jj + 8 * F.lane); v[2 * jj + 1] = *(const LAS f32x4*)(rowp + 512 * jj + 8 * F.lane + 4); }
                float s = 0.f;
#pragma unroll
                for (int q = 0; q < 4; ++q) s += (v[q].x + v[q].y) + (v[q].z + v[q].w);
                const float mean = wave_sum(s) * (1.f / D); float s2 = 0.f;
#pragma unroll
                for (int q = 0; q < 4; ++q) { v[q] = v[q] - mean; s2 += (v[q].x * v[q].x + v[q].y * v[q].y) + (v[q].z * v[q].z + v[q].w * v[q].w); }
                const float rstd = __builtin_amdgcn_rsqf(wave_sum(s2) * (1.f / D) + EPS);
                bf16* op = (bf16*)((unsigned char*)CV + (size_t)(t0 + blk * 8 + F.wave) * D);
#pragma unroll
                for (int jj = 0; jj < 2; ++jj) { const int col = 512 * jj + 8 * F.lane; float r[8];
#pragma unroll
                    for (int q = 0; q < 2; ++q) { const f32x4 g = *(const f32x4*)(F.in(I_CLNG) + col + 4 * q), bb = *(const f32x4*)(F.in(I_CLNB) + col + 4 * q); const f32x4 y = v[2 * jj + q] * rstd * g + bb;
#pragma unroll
                        for (int i = 0; i < 4; ++i) r[4 * q + i] = y[i] * sigmoidf_(y[i]); }
                    int d0 = 0, d1 = 0;
                    d0 = __builtin_amdgcn_cvt_pk_fp8_f32(r[0], r[1], d0, false); d0 = __builtin_amdgcn_cvt_pk_fp8_f32(r[2], r[3], d0, true);
                    d1 = __builtin_amdgcn_cvt_pk_fp8_f32(r[4], r[5], d1, false); d1 = __builtin_amdgcn_cvt_pk_fp8_f32(r[6], r[7], d1, true);
                    *(u32x2*)((unsigned char*)op + col) = (u32x2){(unsigned)d0, (unsigned)d1}; }
            }
        }
        __syncthreads();
    }
}

struct EpiPw2 {
    static constexpr bool PERM = true;
    bf16* O; const bf16* GC; const float* bias;
    __device__ __forceinline__ void operator()(const f32x4 (&acc)[2][2][4][2], const pg8::Unit& u, int wr, int wc, int fr, int fq) const {
        const int row0 = u.pm * 256 + wr * 64 + fr, col0 = u.pn * 256 + wc * 32 + fq * 8;
#pragma unroll
        for (int ai = 0; ai < 2; ++ai)
#pragma unroll
            for (int m = 0; m < 4; ++m) { const int row = row0 + ai * 128 + m * 16;
#pragma unroll
                for (int bj = 0; bj < 2; ++bj) { const int col = col0 + bj * 128; const u32x4 gv = *(const u32x4*)(GC + (size_t)row * D + col);
                    const f32x4 b0 = *(const f32x4*)(bias + col), b1 = *(const f32x4*)(bias + col + 4); float r[8];
#pragma unroll
                    for (int i = 0; i < 4; ++i) { r[i] = acc[ai][bj][m][0][i] * (1.f / WIN_SCALE) + b0[i]; r[4 + i] = acc[ai][bj][m][1][i] * (1.f / WIN_SCALE) + b1[i]; }
                    r[0] *= bf_lo(gv.x); r[1] *= bf_hi(gv.x); r[2] *= bf_lo(gv.y); r[3] *= bf_hi(gv.y); r[4] *= bf_lo(gv.z); r[5] *= bf_hi(gv.z); r[6] *= bf_lo(gv.w); r[7] *= bf_hi(gv.w);
                    u32x4 w; w.x = cvt_pk_bf16(r[0], r[1]); w.y = cvt_pk_bf16(r[2], r[3]); w.z = cvt_pk_bf16(r[4], r[5]); w.w = cvt_pk_bf16(r[6], r[7]);
                    *(u32x4*)(O + (size_t)row * D + col) = w; } }
    }
};

namespace att {
constexpr int SLOT = 32768, NSLOT = 3, XOFF = NSLOT * SLOT;
typedef int i32x8 __attribute__((ext_vector_type(8)));
__device__ __forceinline__ int crow(int r, int hi) { return (r & 3) + 8 * (r >> 2) + 4 * hi; }
__device__ __forceinline__ s16x4 vtr(const LAS char* p) { typedef short v4i16_t __attribute__((ext_vector_type(4))); return __builtin_bit_cast(s16x4, __builtin_amdgcn_ds_read_tr16_b64_v4i16((LAS v4i16_t*)p)); }
#define BUF_DMA16(m0v, voff, srd, soff) asm volatile("s_mov_b32 m0, %0\n\ts_nop 0\n\tbuffer_load_dwordx4 %1, %2, %3 offen lds" :: "s"(m0v), "v"(voff), "s"(srd), "s"(soff) : "m0", "memory")
#define ATT_SB() __builtin_amdgcn_sched_barrier(0)
#ifndef VLA
#define VLA 4
#endif
struct DmaSet { unsigned m0[2], so[2]; };
__device__ __forceinline__ f32x16 zacc() { return (f32x16){0.f, 0.f, 0.f, 0.f, 0.f, 0.f, 0.f, 0.f, 0.f, 0.f, 0.f, 0.f, 0.f, 0.f, 0.f, 0.f}; }
__device__ __forceinline__ f32x16 mfma8(i32x8 a, i32x8 b, f32x16 c) { return __builtin_amdgcn_mfma_scale_f32_32x32x64_f8f6f4(a, b, c, 0, 0, 0, 0, 0, 0); }
#define ATT_KFRAG(kp, blk) ({ const u32x4 lo_ = *(const LAS u32x4*)((kp) + (blk) * 2048 + kc0), hi_ = *(const LAS u32x4*)((kp) + (blk) * 2048 + kc1); \
        (i32x8){(int)lo_.x, (int)lo_.y, (int)lo_.z, (int)lo_.w, (int)hi_.x, (int)hi_.y, (int)hi_.z, (int)hi_.w}; })
template <bool MASK>
__device__ __forceinline__ void shift_mask(f32x16& c0, f32x16& c1, int kb, int qrow, float negM, bool shift) {
    if (shift) {
#pragma unroll
        for (int r = 0; r < 16; ++r) { c0[r] += negM; c1[r] += negM; } }
    if (MASK) {
#pragma unroll
        for (int r = 0; r < 16; ++r) { const int kv = kb + (r & 3) + 8 * (r >> 2); if (kv > qrow) c0[r] = -INFINITY; if (kv + 32 > qrow) c1[r] = -INFINITY; } }
}
#define ATT_VFRAG(dst, i) do { const s16x4 lo_ = vtr(vp + ((i) & 3) * 4096 + ((i) >> 2) * 1024), hh_ = vtr(vp + ((i) & 3) * 4096 + ((i) >> 2) * 1024 + 512); \
        dst = (bf16x8){lo_[0], lo_[1], lo_[2], lo_[3], hh_[0], hh_[1], hh_[2], hh_[3]}; } while (0)
__device__ __forceinline__ void pack8(i32x8& pf, const f32x16& p0, const f32x16& p1, int d) {
    const f32x16& P = d < 4 ? p0 : p1; const int e = 4 * (d & 3);
    int w = pf[d]; w = __builtin_amdgcn_cvt_pk_bf8_f32(P[e], P[e + 1], w, false); w = __builtin_amdgcn_cvt_pk_bf8_f32(P[e + 2], P[e + 3], w, true); pf[d] = w;
}
__device__ __forceinline__ f32x16 mfma_pv(i32x8 p, i32x8 v, f32x16 c) { return __builtin_amdgcn_mfma_scale_f32_32x32x64_f8f6f4(p, v, c, 1, 0, 0, 0, 0, 0); }
__device__ __forceinline__ void att_step(bool MASK, f32x16 (&o)[4], f32x16& c0, f32x16& c1, f32x16& p0, f32x16& p1, i32x8 (&kf)[2], const i32x8& qf, f32x16& lacc, const i32x8& ones, i32x8& pf,
                                         const LAS char* vp, const LAS char* kpn, int kc0, int kc1, int kb, int qrow,
                                         const DmaSet& dm, unsigned vdma, __amdgpu_buffer_rsrc_t srdK, __amdgpu_buffer_rsrc_t srdV) {
    i32x8 vf[4];
#pragma unroll
    for (int h2 = 0; h2 < 2; ++h2) {
        if (h2 == 0) c0 = mfma8(kf[0], qf, zacc()); else c1 = mfma8(kf[1], qf, zacc());
        const f32x16& P = h2 == 0 ? p0 : p1;
        vf[2 * h2] = ATT_KFRAG(vp, 2 * h2); vf[2 * h2 + 1] = ATT_KFRAG(vp, 2 * h2 + 1);
#pragma unroll
        for (int g = 0; g < 4; ++g) { const int e = 4 * g;
            pack8(pf, p0, p1, 4 * h2 + g);
            int w_ = pf[4 * h2 + g]; asm volatile("" : "+v"(w_)); pf[4 * h2 + g] = w_;
            if (g == 0) BUF_DMA16(dm.m0[h2], vdma, h2 == 0 ? srdK : srdV, dm.so[h2]);
        }
        ATT_SB();
    }
    if (MASK) {
#pragma unroll
        for (int r = 0; r < 16; ++r) { const int kv = kb + (r & 3) + 8 * (r >> 2); if (kv > qrow) c0[r] = -INFINITY; if (kv + 32 > qrow) c1[r] = -INFINITY; } }
    ATT_SB();
#pragma unroll
    for (int i = 0; i < 4; ++i) {
        if (i == 1) kf[0] = ATT_KFRAG(kpn, 0);
        if (i == 2) kf[1] = ATT_KFRAG(kpn, 1);
        o[i] = mfma_pv(pf, vf[i], o[i]);
        if (i == 3) lacc = mfma_pv(pf, ones, lacc);
#pragma unroll
        for (int x = 0; x < 8; ++x) { const int idx = 8 * i + x; float e0 = __builtin_amdgcn_exp2f(idx < 16 ? c0[idx] : c1[idx - 16]);
            asm volatile("" : "+v"(e0));
            if (idx < 16) c0[idx] = e0; else c1[idx - 16] = e0; }
        ATT_SB();
    }
}
__device__ __forceinline__ void att_drain(f32x16 (&o)[4], const f32x16& p0, const f32x16& p1, f32x16& lacc, const i32x8& ones, const LAS char* vp, int kc0, int kc1) {
    i32x8 pf = {0, 0, 0, 0, 0, 0, 0, 0};
#pragma unroll
    for (int d = 0; d < 8; ++d) pack8(pf, p0, p1, d);
#pragma unroll
    for (int i = 0; i < 4; ++i) { const i32x8 f = ATT_KFRAG(vp, i); o[i] = mfma_pv(pf, f, o[i]); }
    lacc = mfma_pv(pf, ones, lacc);
}

__device__ __forceinline__ void phase5(Frame& F, bf16* MGout) {
    const bf16* GA = (const bf16*)(F.ws + WS_GA); bf16* MG = (bf16*)(F.ws + WS_U);
    const int lane = F.lane, r32 = lane & 31, hi = lane >> 5, wid = F.wave, rg = wid & 3, mp = wid >> 2;
    float lam;
    {
        const float q1 = F.in(I_LQ1)[lane], k1 = F.in(I_LK1)[lane], q2 = F.in(I_LQ2)[lane], k2 = F.in(I_LK2)[lane];
        lam = __expf(wave_sum(q1 * k1)) - __expf(wave_sum(q2 * k2)) + LAMBDA_INIT;
    }
    const i32x8 ones = {0x38383838, 0x38383838, 0x38383838, 0x38383838, 0x38383838, 0x38383838, 0x38383838, 0x38383838};
    LAS char* ring = (LAS char*)F.lds;
    const unsigned ring0 = (unsigned)(size_t)ring;
    const int voff = r32 * 64;
    const int ksw = (r32 >> 2) & 3;
    const int koff = r32 * 64 + mp * 4096, kc0 = ((2 * hi) ^ ksw) << 4, kc1 = ((2 * hi + 1) ^ ksw) << 4;
    const __amdgpu_buffer_rsrc_t srdK = __builtin_amdgcn_make_buffer_rsrc((void*)(F.ws + WS_K), (short)0, 64 << 20, 0x00020000);
    const __amdgpu_buffer_rsrc_t srdV = __builtin_amdgcn_make_buffer_rsrc((void*)(F.ws + WS_V), (short)0, 64 << 20, 0x00020000);
    const __amdgpu_buffer_rsrc_t srdQ = __builtin_amdgcn_make_buffer_rsrc((void*)(F.ws + WS_Q), (short)0, 64 << 20, 0x00020000);
    const unsigned vdma = (unsigned)(wid * 1024 + lane * 16);
    const unsigned vdmk = (unsigned)((wid & 3) * 1024 + lane * 16);
    const unsigned vq = (unsigned)(r32 * 64 + hi * 32);
    if (wid >= 4) __builtin_amdgcn_s_setprio(1);
#ifndef DBG_ATT2
#define DBG_ATT2 0
#endif
    for (int p_ = F.vcu; p_ < (DBG_ATT2 ? 2048 : 1024); p_ += F.G) {
        const int p = p_ & 1023; bf16* const MGo = (DBG_ATT2 && p_ < 1024) ? (bf16*)F.out : MGout;
        const int bh = p >> 6, j = p & 63;
        for (int half = 0; half < 2; ++half) {
            const int qt = half == 0 ? j : 127 - j;
            const int NT = 2 * (qt + 1);
            const unsigned kxoff = (unsigned)(bh * 2 + (wid >> 2)) * (SEQ * 64u), voffg = (unsigned)bh * (256u * 8192u);
#define ATT_ISSUE_K(tk_, dst_) do { const unsigned tk__ = (unsigned)((tk_) < NT ? (tk_) : NT - 1) * 4096u; BUF_DMA16(ring0 + (dst_) + wid * 1024, vdmk, srdK, kxoff + tk__); } while (0)
#define ATT_ISSUE_V(tv_, dst_) do { const unsigned tv__ = voffg + (unsigned)((tv_) < NT ? (tv_) : NT - 1) * 8192u; BUF_DMA16(ring0 + (dst_) + wid * 1024, vdma, srdV, tv__); } while (0)
            u32x4 q0, q1;
            { const unsigned qs = ((unsigned)(bh * 2 + mp) * SEQ + (unsigned)(qt * 128 + rg * 32)) * 64u;
              asm volatile("buffer_load_dwordx4 %0, %2, %3, %4 offen\n\tbuffer_load_dwordx4 %1, %2, %3, %4 offen offset:16"
                           : "=&v"(q0), "=&v"(q1) : "v"(vq), "s"(srdQ), "s"(qs) : "memory"); }
            ATT_ISSUE_K(0, XOFF); ATT_ISSUE_K(1, XOFF + 16384);
            ATT_ISSUE_K(2, 0); ATT_ISSUE_V(0, 16384);
            ATT_ISSUE_K(3, SLOT); ATT_ISSUE_V(1, SLOT + 16384);
            asm volatile("s_waitcnt vmcnt(4)\n\ts_barrier" : "+v"(q0), "+v"(q1) :: "memory");
            const i32x8 qf = {(int)q0.x, (int)q0.y, (int)q0.z, (int)q0.w, (int)q1.x, (int)q1.y, (int)q1.z, (int)q1.w};
            f32x16 o[4];
#pragma unroll
            for (int vb = 0; vb < 4; ++vb)
#pragma unroll
                for (int r = 0; r < 16; ++r) o[vb][r] = 0.f;
            f32x16 lacc = zacc();
            const int qrow = qt * 128 + rg * 32 + r32;
            f32x16 pA0, pA1, pB0, pB1; i32x8 kf[2]; i32x8 pfr = {0, 0, 0, 0, 0, 0, 0, 0};
            { const LAS char* kp0 = ring + XOFF + koff; const f32x16 z = {0.f, 0.f, 0.f, 0.f, 0.f, 0.f, 0.f, 0.f, 0.f, 0.f, 0.f, 0.f, 0.f, 0.f, 0.f, 0.f};
              kf[0] = ATT_KFRAG(kp0, 0); kf[1] = ATT_KFRAG(kp0, 1);
              (void)z; pA0 = mfma8(kf[0], qf, zacc()); pA1 = mfma8(kf[1], qf, zacc()); }
            if (NT == 2) shift_mask<true>(pA0, pA1, 4 * hi, qrow, 0.f, false);
#pragma unroll
            for (int r = 0; r < 16; ++r) { pA0[r] = __builtin_amdgcn_exp2f(pA0[r]); pA1[r] = __builtin_amdgcn_exp2f(pA1[r]); }
            { const LAS char* kp1 = ring + XOFF + 16384 + koff; kf[0] = ATT_KFRAG(kp1, 0); kf[1] = ATT_KFRAG(kp1, 1); }
            unsigned sl_use = 0, sl_mid = SLOT, sl_new = 2 * SLOT;
#define ATT_STEP(MASKED, C0, C1, P0, P1, t_) do { asm volatile("s_waitcnt vmcnt(2) lgkmcnt(0)\n\ts_barrier" ::: "memory"); \
                DmaSet dm; { const unsigned tk__ = (unsigned)(((t_) + 3) < NT ? ((t_) + 3) : NT - 1) * 4096u, tv__ = voffg + (unsigned)(((t_) + 1) < NT ? ((t_) + 1) : NT - 1) * 8192u, d__ = ring0 + sl_new + wid * 1024; \
                    dm.m0[0] = d__; dm.m0[1] = d__ + 16384u; dm.so[0] = kxoff + tk__ - (unsigned)(wid >> 2) * 4096u; dm.so[1] = tv__; }   \
                { const LAS char* vp = ring + sl_use + 16384 + voff; const LAS char* kpn = ring + sl_use + koff; \
                  att_step(MASKED, o, C0, C1, P0, P1, kf, qf, lacc, ones, pfr, vp, kpn, kc0, kc1, 64 * (t_) + 4 * hi, qrow, dm, vdma, srdK, srdV); } \
                { const unsigned t__ = sl_use; sl_use = sl_mid; sl_mid = sl_new; sl_new = t__; } } while (0)
            int t = 1;
            for (; t + 1 < NT; t += 2) { ATT_STEP(false, pB0, pB1, pA0, pA1, t); ATT_STEP((t + 1 >= NT - 2), pA0, pA1, pB0, pB1, t + 1); }
            ATT_STEP(true, pB0, pB1, pA0, pA1, NT - 1);
            asm volatile("s_waitcnt vmcnt(0) lgkmcnt(0)\n\ts_barrier" ::: "memory");
            att_drain(o, pB0, pB1, lacc, ones, ring + sl_use + 16384 + voff, kc0, kc1);
#undef ATT_STEP
#undef ATT_ISSUE_K
#undef ATT_ISSUE_V
            float rl[16];
#pragma unroll
            for (int r = 0; r < 16; ++r) rl[r] = __builtin_amdgcn_rcpf(lacc[r]);
            asm volatile("s_waitcnt vmcnt(0) lgkmcnt(0)\n\ts_barrier" ::: "memory");
            LAS float* xch = (LAS float*)ring + rg * 4096;
            if (mp == 1) {
#pragma unroll
                for (int vb = 0; vb < 4; ++vb)
#pragma unroll
                    for (int r = 0; r < 16; ++r) xch[(vb * 16 + r) * 64 + lane] = o[vb][r] * rl[r] * lam;
            }
            asm volatile("s_waitcnt lgkmcnt(0)\n\ts_barrier" ::: "memory");
            if (mp == 0) {
                float ssq[16];
#pragma unroll
                for (int r = 0; r < 16; ++r) ssq[r] = 0.f;
#pragma unroll
                for (int vb = 0; vb < 4; ++vb)
#pragma unroll
                    for (int r = 0; r < 16; ++r) { const float d = o[vb][r] * rl[r] - xch[(vb * 16 + r) * 64 + lane]; o[vb][r] = d; ssq[r] += d * d; }
#pragma unroll
                for (int r = 0; r < 16; ++r) { float s = ssq[r];
#pragma unroll
                    for (int off = 1; off < 32; off <<= 1) s += __shfl_xor(s, off);
                    ssq[r] = __builtin_amdgcn_rsqf(s * (1.f / 128.f) + EPS) * (1.f - LAMBDA_INIT); }
#pragma unroll
                for (int vb = 0; vb < 4; ++vb)
#pragma unroll
                    for (int r = 0; r < 16; ++r) xch[(vb * 16 + r) * 64 + lane] = o[vb][r] * ssq[r];
            }
            asm volatile("s_waitcnt lgkmcnt(0)\n\ts_barrier" ::: "memory");
            {
                const int b = bh >> 3, h = bh & 7, q = F.tid >> 2, vb = F.tid & 3, q5 = q & 31;
                const int rr = (q5 & 3) + 4 * (q5 >> 3), hh = (q5 >> 2) & 1;
                const LAS float* src = (const LAS float*)ring + (q >> 5) * 4096 + (vb * 16 + rr) * 64 + hh * 32;
                const size_t idx = ((size_t)b * SEQ + qt * 128 + q) * D + h * 128 + vb * 32;
                const float* sgp = F.in(I_SUBG) + vb * 32; asm volatile("" : "+v"(sgp));
#pragma unroll
                for (int c8 = 0; c8 < 4; ++c8) { const f32x4 y0 = *(const LAS f32x4*)(src + c8 * 8), y1 = *(const LAS f32x4*)(src + c8 * 8 + 4);
                    const f32x4 g0 = *(const f32x4*)(sgp + c8 * 8), g1 = *(const f32x4*)(sgp + c8 * 8 + 4);
                    const u32x4 ga = *(const u32x4*)(GA + idx + c8 * 8), mc = *(const u32x4*)(MG + idx + c8 * 8);
                    u32x4 w;
                    w.x = cvt_pk_bf16(y0[0] * g0[0] * bf_lo(ga.x) + bf_lo(mc.x), y0[1] * g0[1] * bf_hi(ga.x) + bf_hi(mc.x));
                    w.y = cvt_pk_bf16(y0[2] * g0[2] * bf_lo(ga.y) + bf_lo(mc.y), y0[3] * g0[3] * bf_hi(ga.y) + bf_hi(mc.y));
                    w.z = cvt_pk_bf16(y1[0] * g1[0] * bf_lo(ga.z) + bf_lo(mc.z), y1[1] * g1[1] * bf_hi(ga.z) + bf_hi(mc.z));
                    w.w = cvt_pk_bf16(y1[2] * g1[2] * bf_lo(ga.w) + bf_lo(mc.w), y1[3] * g1[3] * bf_hi(ga.w) + bf_hi(mc.w));
                    *(u32x4*)(MGo + idx + c8 * 8) = w; }
            }
            asm volatile("s_waitcnt vmcnt(0) lgkmcnt(0)\n\ts_barrier" ::: "memory");
        }
    }
    __builtin_amdgcn_s_setprio(0);
}
}

struct EpiOut {
    static constexpr bool PERM = true;
    const float* X; float* O; const float* mod;
    __device__ __forceinline__ void operator()(const f32x4 (&acc)[2][2][4][2], const pg8::Unit& u, int wr, int wc, int fr, int fq) const {
        const int row0 = u.pm * 256 + wr * 64 + fr, col0 = u.pn * 256 + wc * 32 + fq * 8;
#pragma unroll
        for (int ai = 0; ai < 2; ++ai)
#pragma unroll
            for (int m = 0; m < 4; ++m) { const int row = row0 + ai * 128 + m * 16, b = row >> 14;
#pragma unroll
                for (int bj = 0; bj < 2; ++bj)
#pragma unroll
                    for (int n = 0; n < 2; ++n) { const int col = col0 + bj * 128 + 4 * n; const f32x4 g = *(const f32x4*)(mod + b * 6144 + 2048 + col), xv = *(const f32x4*)(X + (size_t)row * D + col);
                        *(f32x4*)(O + (size_t)row * D + col) = xv + g * acc[ai][bj][m][n]; } }
    }
};

__device__ __forceinline__ void phase7(Frame& F) {
    const float* X1 = F.out; const float* mod = (const float*)(F.ws + WS_MOD); const float* gn = F.in(I_N2G); bf16* H2 = (bf16*)(F.ws + WS_U);
    constexpr int PITCH = 272;
    LAS char* Ahi = (LAS char*)F.lds;
    LAS char* Alo = Ahi + 128 * PITCH;
    LAS char* Whi = Alo + 128 * PITCH;
    LAS char* Wlo = Whi + 64 * PITCH;
    LAS float* RS = (LAS float*)(F.lds + 104448);
    LAS int* CW = (LAS int*)(F.lds + 104960);
    LAS unsigned char* RK = (LAS unsigned char*)(F.lds + 105472);
    LAS float* LG = (LAS float*)F.lds;
    const int tid = F.tid, lane = F.lane, wid = F.wave, r32 = lane & 31, hi = lane >> 5;
    const bf16* WRH = (const bf16*)(F.ws + WS_WRH); const bf16* WRL = (const bf16*)(F.ws + WS_WRL);
    for (int chunk = F.vcu; chunk < T / 128; chunk += F.G) {
        const int t0 = chunk * 128, b = t0 >> 14;
        for (int i4 = 0; i4 < 16; i4 += 4) {
            f32x4 v[4][4]; float ss[4];
#pragma unroll
            for (int u = 0; u < 4; ++u) { const f32x4* xr = (const f32x4*)(X1 + (size_t)(t0 + wid * 16 + i4 + u) * D) + lane;
#pragma unroll
                for (int j = 0; j < 4; ++j) v[u][j] = xr[64 * j]; }
#pragma unroll
            for (int u = 0; u < 4; ++u) { float s = 0.f;
#pragma unroll
                for (int j = 0; j < 4; ++j) s += (v[u][j].x * v[u][j].x + v[u][j].y * v[u][j].y) + (v[u][j].z * v[u][j].z + v[u][j].w * v[u][j].w);
                ss[u] = s; }
#pragma unroll
            for (int o_ = 1; o_ < 64; o_ <<= 1) {
#pragma unroll
                for (int u = 0; u < 4; ++u) ss[u] += __shfl_xor(ss[u], o_); }
#pragma unroll
            for (int u = 0; u < 4; ++u) { const int m = t0 + wid * 16 + i4 + u; const float rstd = __builtin_amdgcn_rsqf(ss[u] * (1.f / D) + EPS);
                if (lane == 0) RS[wid * 16 + i4 + u] = rstd;
                unsigned* o4 = (unsigned*)((unsigned char*)H2 + (size_t)m * D) + lane;
#pragma unroll
                for (int j = 0; j < 4; ++j) { const int col = 4 * lane + 256 * j;
                    const f32x4 g = *(const f32x4*)(gn + col), sc = *(const f32x4*)(mod + b * 6144 + 4096 + col), sh = *(const f32x4*)(mod + b * 6144 + 3072 + col);
                    const f32x4 y = v[u][j] * rstd * g * (sc + 1.f) + sh;
                    int w = 0; w = __builtin_amdgcn_cvt_pk_fp8_f32(y.x, y.y, w, false); w = __builtin_amdgcn_cvt_pk_fp8_f32(y.z, y.w, w, true); o4[64 * j] = (unsigned)w; } } }
        __syncthreads();
        f32x16 c;
#pragma unroll
        for (int r = 0; r < 16; ++r) c[r] = 0.f;
        const int tb = wid & 3, eb = wid >> 2;
        for (int ks = 0; ks < 8; ++ks) {
            { const int row = tid & 127, seg = tid >> 7; const float rstd = RS[row];
              const float* xp = X1 + (size_t)(t0 + row) * D + ks * 128 + seg * 32;
              unsigned wh[16], wl[16];
#pragma unroll
              for (int q = 0; q < 8; ++q) { const int col = ks * 128 + seg * 32 + 4 * q; const f32x4 xv = *(const f32x4*)(xp + 4 * q);
                  const f32x4 g = *(const f32x4*)(gn + col), sc = *(const f32x4*)(mod + b * 6144 + 4096 + col), sh = *(const f32x4*)(mod + b * 6144 + 3072 + col);
                  const f32x4 y = xv * rstd * g * (sc + 1.f) + sh;
                  const unsigned h0 = cvt_pk_bf16(y.x, y.y), h1 = cvt_pk_bf16(y.z, y.w);
                  wh[2 * q] = h0; wh[2 * q + 1] = h1;
                  wl[2 * q] = cvt_pk_bf16(y.x - bf_lo(h0), y.y - bf_hi(h0)); wl[2 * q + 1] = cvt_pk_bf16(y.z - bf_lo(h1), y.w - bf_hi(h1)); }
#pragma unroll
              for (int q = 0; q < 4; ++q) { *(LAS u32x4*)(Ahi + row * PITCH + seg * 64 + q * 16) = (u32x4){wh[4 * q], wh[4 * q + 1], wh[4 * q + 2], wh[4 * q + 3]};
                  *(LAS u32x4*)(Alo + row * PITCH + seg * 64 + q * 16) = (u32x4){wl[4 * q], wl[4 * q + 1], wl[4 * q + 2], wl[4 * q + 3]}; }
#pragma unroll
              for (int q = 0; q < 2; ++q) { const int cc = tid + 512 * q, e = cc >> 4, kc = cc & 15;
                  *(LAS u32x4*)(Whi + e * PITCH + kc * 16) = *(const u32x4*)(WRH + e * 1024 + ks * 128 + kc * 8);
                  *(LAS u32x4*)(Wlo + e * PITCH + kc * 16) = *(const u32x4*)(WRL + e * 1024 + ks * 128 + kc * 8); } }
            __syncthreads();
#pragma unroll
            for (int st = 0; st < 8; ++st) { const int ao = (tb * 32 + r32) * PITCH + (2 * st + hi) * 16, bo = (eb * 32 + r32) * PITCH + (2 * st + hi) * 16;
                const bf16x8 ah = *(const LAS bf16x8*)(Ahi + ao), al = *(const LAS bf16x8*)(Alo + ao), bh = *(const LAS bf16x8*)(Whi + bo), bl = *(const LAS bf16x8*)(Wlo + bo);
                c = __builtin_amdgcn_mfma_f32_32x32x16_bf16(ah, bh, c, 0, 0, 0); c = __builtin_amdgcn_mfma_f32_32x32x16_bf16(ah, bl, c, 0, 0, 0); c = __builtin_amdgcn_mfma_f32_32x32x16_bf16(al, bh, c, 0, 0, 0); }
            __syncthreads();
        }
#pragma unroll
        for (int r = 0; r < 16; ++r) LG[(tb * 32 + att::crow(r, hi)) * 65 + eb * 32 + r32] = c[r];
        __syncthreads();
        unsigned long long chosen = 0ull; int ek[8]; float sk[8];
        if (tid < 128) {
            LAS float* L = LG + tid * 65;
            float gs[8];
#pragma unroll
            for (int g = 0; g < 8; ++g) { float m1 = -INFINITY, m2 = -INFINITY;
#pragma unroll
                for (int jx = 0; jx < 8; ++jx) { const float sc = sigmoidf_(L[g * 8 + jx]); const float ch = sc + F.in(I_RB)[g * 8 + jx]; L[g * 8 + jx] = ch;
                    if (ch > m1) { m2 = m1; m1 = ch; } else if (ch > m2) m2 = ch; }
                gs[g] = m1 + m2; }
            unsigned gm = 0u;
#pragma unroll
            for (int it = 0; it < 4; ++it) { float best = -INFINITY; int bi = 0;
#pragma unroll
                for (int g = 0; g < 8; ++g) { const bool ok = !((gm >> g) & 1u) && gs[g] > best; best = ok ? gs[g] : best; bi = ok ? g : bi; }
                gm |= 1u << bi; }
            int gsel[4]; float cand[32];
            { unsigned m = gm;
#pragma unroll
              for (int sx = 0; sx < 4; ++sx) { const int g = __builtin_ctz(m); m &= m - 1u; gsel[sx] = g;
#pragma unroll
                  for (int jx = 0; jx < 8; ++jx) cand[sx * 8 + jx] = L[g * 8 + jx]; } }
            float ssum = 0.f;
#pragma unroll
            for (int it = 0; it < 8; ++it) { float best = -INFINITY; int bi = 0;
#pragma unroll
                for (int i = 0; i < 32; ++i) { const bool ok = cand[i] > best; best = ok ? cand[i] : best; bi = ok ? i : bi; }
#pragma unroll
                for (int i = 0; i < 32; ++i) cand[i] = (i == bi) ? -INFINITY : cand[i];
                const int sx = bi >> 3; const int g = sx == 0 ? gsel[0] : sx == 1 ? gsel[1] : sx == 2 ? gsel[2] : gsel[3]; const int e = g * 8 + (bi & 7);
                chosen |= 1ull << e; ek[it] = e; const float sc = best - F.in(I_RB)[e]; sk[it] = sc; ssum += sc; }
            const float inv = 2.5f / ssum;
#pragma unroll
            for (int it = 0; it < 8; ++it) sk[it] *= inv;
        }
        if (wid < 2) {
            for (int e = 0; e < 64; ++e) { const bool f = (chosen >> e) & 1ull; const unsigned long long bm = __ballot(f);
                const int rk = __popcll(bm & ((1ull << lane) - 1ull));
                if (f) RK[tid * 64 + e] = (unsigned char)rk;
                if (lane == 0) CW[wid * 64 + e] = __popcll(bm); }
        }
        __syncthreads();
        if (tid < 128) {
            int* tke = (int*)(F.ws + WS_TKE) + (size_t)(t0 + tid) * 8; int* tkr = (int*)(F.ws + WS_TKR) + (size_t)(t0 + tid) * 8; float* tkw = (float*)(F.ws + WS_TKW) + (size_t)(t0 + tid) * 8;
#pragma unroll
            for (int it = 0; it < 8; ++it) { const int e = ek[it]; tke[it] = e; tkr[it] = (int)RK[tid * 64 + e] + (wid == 1 ? CW[e] : 0); tkw[it] = sk[it]; }
        }
        if (tid < 64) ((int*)(F.ws + WS_CNT))[chunk * 64 + tid] = CW[tid] + CW[64 + tid];
        __syncthreads();
    }
}

__device__ __forceinline__ void phase8(Frame& F) {
    const int* CNT = (const int*)(F.ws + WS_CNT); int* TOK = (int*)(F.ws + WS_TOK); float* WGT = (float*)(F.ws + WS_WGT); int* POS = (int*)(F.ws + WS_POS);
    LAS int* part = (LAS int*)F.lds;
    LAS int* tot = part + 1024;
    LAS int* below = tot + 64;
    LAS int* ebase = below + 64;
    const int tid = F.tid;
    for (int chunk = F.vcu; chunk < T / 128; chunk += F.G) {
        { const int e = tid & 63, pr = tid >> 6; int s = 0, sb = 0;
          for (int c = pr * 32; c < pr * 32 + 32; ++c) { const int v = CNT[c * 64 + e]; s += v; sb += c < chunk ? v : 0; }
          part[(pr * 2 + 0) * 64 + e] = s; part[(pr * 2 + 1) * 64 + e] = sb; }
        __syncthreads();
        if (tid < 64) { int s = 0, sb = 0;
#pragma unroll
            for (int pr = 0; pr < 8; ++pr) { s += part[(pr * 2 + 0) * 64 + tid]; sb += part[(pr * 2 + 1) * 64 + tid]; }
            tot[tid] = s; below[tid] = sb; }
        __syncthreads();
        if (tid == 0) { int a = 0; for (int e = 0; e < 64; ++e) { ebase[e] = a; a += (tot[e] + 255) & ~255; } ebase[64] = a; }
        __syncthreads();
        if (tid < 128) { const int tokn = chunk * 128 + tid;
            const int* tke = (const int*)(F.ws + WS_TKE) + (size_t)tokn * 8; const int* tkr = (const int*)(F.ws + WS_TKR) + (size_t)tokn * 8; const float* tkw = (const float*)(F.ws + WS_TKW) + (size_t)tokn * 8;
#pragma unroll
            for (int k = 0; k < 8; ++k) { const int e = tke[k]; const int pos = ebase[e] + below[e] + tkr[k]; TOK[pos] = tokn; WGT[pos] = tkw[k]; POS[tokn * 8 + k] = pos; } }
        const int RTOT = ebase[64];
        if (chunk < 64) { const int e = chunk; for (int p = ebase[e] + tot[e] + tid; p < ebase[e + 1]; p += NTHREADS) { TOK[p] = -1; WGT[p] = 0.f; } }
        { const int tokn = chunk * 128 + (tid & 127); if (tid < 128) { TOK[RTOT + tokn] = tokn; WGT[RTOT + tokn] = 1.f; } }
        if (chunk == 0) { int* TE = (int*)(F.ws + WS_TE); const int NTR = RTOT >> 8;
            for (int pm = tid; pm < NTR + 128; pm += NTHREADS) { int e = 64; if (pm < NTR) { e = 0; for (int x = 1; x < 64; ++x) e = (pm * 256 >= ebase[x]) ? x : e; } TE[pm] = e; }
            if (tid == 0) ((int*)(F.ws + WS_META))[0] = NTR; }
        __syncthreads();
    }
}

struct SchedMoe {
    int G, c, nunits, pm0, csh, colbase, bmul; const int* te; const int* tok;
    __device__ __forceinline__ bool next(int i, pg8::Unit& u) const {
        int pm, ct;
        if ((G & 7) == 0) { const int x = c & 7, w = c >> 3, W = G >> 3, nrows = nunits >> csh, nloc = (nrows + 7) >> 3;
            const long Lx = (long)i * W + w; const int pl = (int)(Lx >> csh), pr = x * nloc + pl; if (pl >= nloc || pr >= nrows) return false;
            pm = pm0 + pr; ct = colbase + (int)(Lx & ((1 << csh) - 1)); }
        else { const long L = (long)i * G + c; if (L >= nunits) return false; pm = pm0 + (int)(L >> csh); ct = colbase + (int)(L & ((1 << csh) - 1)); }
        u.pm = pm; u.pn = bmul * te[pm] + ct; return true; }
};
template <int MODE> struct EpiNull {
    static constexpr bool PERM = true;
    float* sink;
    __device__ __forceinline__ void operator()(const f32x4 (&acc)[2][2][4][2], const pg8::Unit& u, int wr, int wc, int fr, int fq) const {
        float s = 0.f;
        if (MODE == 1) {
#pragma unroll
            for (int ai = 0; ai < 2; ++ai)
#pragma unroll
                for (int bj = 0; bj < 2; ++bj)
#pragma unroll
                    for (int m = 0; m < 4; ++m)
#pragma unroll
                        for (int n = 0; n < 2; ++n) s += (acc[ai][bj][m][n][0] + acc[ai][bj][m][n][1]) + (acc[ai][bj][m][n][2] + acc[ai][bj][m][n][3]);
        } else s = acc[0][0][0][0][0] + acc[1][1][3][1][3];
        if (s == 12345.678f) sink[0] = s;
    }
};
struct EpiGU {
    static constexpr bool PERM = true;
    unsigned char* ACT; const float* WGT;
    __device__ __forceinline__ void operator()(const f32x4 (&acc)[2][2][4][2], const pg8::Unit& u, int wr, int wc, int fr, int fq) const {
        const int row0 = u.pm * 256 + wr * 64 + fr, ct = u.pn & 1;
#pragma unroll
        for (int ai = 0; ai < 2; ++ai)
#pragma unroll
            for (int m = 0; m < 4; ++m) { const int row = row0 + ai * 128 + m * 16; const float w = WGT[row] * ACT_SCALE; float r[8];
#pragma unroll
                for (int n = 0; n < 2; ++n)
#pragma unroll
                    for (int i = 0; i < 4; ++i) { const float g = acc[ai][0][m][n][i] * (1.f / WIN_SCALE); r[4 * n + i] = g * sigmoidf_(g) * (acc[ai][1][m][n][i] * (1.f / WIN_SCALE)) * w; }
                int d0 = 0, d1 = 0;
                d0 = __builtin_amdgcn_cvt_pk_fp8_f32(r[0], r[1], d0, false); d0 = __builtin_amdgcn_cvt_pk_fp8_f32(r[2], r[3], d0, true);
                d1 = __builtin_amdgcn_cvt_pk_fp8_f32(r[4], r[5], d1, false); d1 = __builtin_amdgcn_cvt_pk_fp8_f32(r[6], r[7], d1, true);
                *(u32x2*)(ACT + (size_t)row * 256 + ct * 128 + wc * 32 + fq * 8) = (u32x2){(unsigned)d0, (unsigned)d1}; }
    }
};
constexpr float Y_SCALE = 16.f;
struct EpiDown {
    static constexpr bool PERM = true;
    static constexpr float YD = Y_SCALE / (ACT_SCALE * WDN_SCALE);
    unsigned char* Y;
    __device__ __forceinline__ void operator()(const f32x4 (&acc)[2][2][4][2], const pg8::Unit& u, int wr, int wc, int fr, int fq) const {
        const int row0 = u.pm * 256 + wr * 64 + fr, col0 = (u.pn & 3) * 256 + (wc * 4 + fq) * 16;
#pragma unroll
        for (int ai = 0; ai < 2; ++ai)
#pragma unroll
            for (int m = 0; m < 4; ++m) { const int row = row0 + ai * 128 + m * 16; u32x4 w;
#pragma unroll
                for (int bj = 0; bj < 2; ++bj) { int d0 = 0, d1 = 0;
                    d0 = __builtin_amdgcn_cvt_pk_fp8_f32(acc[ai][bj][m][0][0] * YD, acc[ai][bj][m][0][1] * YD, d0, false); d0 = __builtin_amdgcn_cvt_pk_fp8_f32(acc[ai][bj][m][0][2] * YD, acc[ai][bj][m][0][3] * YD, d0, true);
                    d1 = __builtin_amdgcn_cvt_pk_fp8_f32(acc[ai][bj][m][1][0] * YD, acc[ai][bj][m][1][1] * YD, d1, false); d1 = __builtin_amdgcn_cvt_pk_fp8_f32(acc[ai][bj][m][1][2] * YD, acc[ai][bj][m][1][3] * YD, d1, true);
                    if (bj == 0) { w.x = (unsigned)d0; w.y = (unsigned)d1; } else { w.z = (unsigned)d0; w.w = (unsigned)d1; } }
                *(u32x4*)(Y + (size_t)row * 1024 + col0) = w; }
    }
};
struct EpiComb {
    static constexpr bool PERM = true;
    float* O; const unsigned char* Y; const int* POS; const float* mod; int rtiles;
    __device__ __forceinline__ void operator()(const f32x4 (&acc)[2][2][4][2], const pg8::Unit& u, int wr, int wc, int fr, int fq) const {
        const int row0 = (u.pm - rtiles) * 256 + wr * 64 + fr, ct = u.pn & 3, col0 = ct * 256 + wc * 32 + fq * 8;
#pragma unroll
        for (int ai = 0; ai < 2; ++ai)
#pragma unroll
            for (int m = 0; m < 4; ++m) { const int row = row0 + ai * 128 + m * 16, b = row >> 14;
                const i32x4 p0 = *(const i32x4*)(POS + (size_t)row * 8), p1 = *(const i32x4*)(POS + (size_t)row * 8 + 4);
                f32x2 t[8] = {{0.f, 0.f}, {0.f, 0.f}, {0.f, 0.f}, {0.f, 0.f}, {0.f, 0.f}, {0.f, 0.f}, {0.f, 0.f}, {0.f, 0.f}};
#pragma unroll
                for (int k = 0; k < 8; ++k) { const int pos = k < 4 ? p0[k & 3] : p1[k & 3]; const u32x4 y = *(const u32x4*)(Y + (size_t)pos * 1024 + ct * 256 + (wc * 4 + fq) * 16);
                    t[0] += __builtin_amdgcn_cvt_pk_f32_fp8((int)y.x, false); t[1] += __builtin_amdgcn_cvt_pk_f32_fp8((int)y.x, true);
                    t[2] += __builtin_amdgcn_cvt_pk_f32_fp8((int)y.y, false); t[3] += __builtin_amdgcn_cvt_pk_f32_fp8((int)y.y, true);
                    t[4] += __builtin_amdgcn_cvt_pk_f32_fp8((int)y.z, false); t[5] += __builtin_amdgcn_cvt_pk_f32_fp8((int)y.z, true);
                    t[6] += __builtin_amdgcn_cvt_pk_f32_fp8((int)y.w, false); t[7] += __builtin_amdgcn_cvt_pk_f32_fp8((int)y.w, true); }
#pragma unroll
                for (int bj = 0; bj < 2; ++bj) {
                    const int col = col0 + bj * 128; float* op = O + (size_t)row * D + col;
#pragma unroll
                    for (int n = 0; n < 2; ++n) { const f32x4 g = *(const f32x4*)(mod + b * 6144 + 5120 + col + 4 * n), xv = *(const f32x4*)(op + 4 * n);
                        const f32x4 sv = acc[ai][bj][m][n] * (1.f / (ACT_SCALE * WDN_SCALE)) + (f32x4){t[bj * 4 + 2 * n].x, t[bj * 4 + 2 * n].y, t[bj * 4 + 2 * n + 1].x, t[bj * 4 + 2 * n + 1].y} * (1.f / Y_SCALE);
                        *(f32x4*)(op + 4 * n) = xv + g * sv; } } }
    }
};

constexpr int NPHASE = 12;
__global__ void __launch_bounds__(NTHREADS, 2) fwd_kernel(Args args) {
    extern __shared__ __attribute__((aligned(16))) unsigned char lds[];
    Frame F;
    F.lds = (LAS unsigned char*)lds;
    F.tid = threadIdx.x; F.lane = F.tid & 63; F.wave = __builtin_amdgcn_readfirstlane(F.tid >> 6);
    F.G = gridDim.x; { const int bx = blockIdx.x; F.vcu = (F.G % 8 == 0) ? (bx % 8) * (F.G / 8) + bx / 8 : bx; }
    F.ws = args.ws; F.out = args.out;
    F.ka = (const __attribute__((address_space(4))) unsigned char*)__builtin_amdgcn_kernarg_segment_ptr();
    volatile LAS unsigned* MISC = (volatile LAS unsigned*)(F.lds + MISC_OFF);
    if (F.tid < 64) MISC[F.tid] = 0u;
    __syncthreads();
    const int lo = args.ph_lo, hi = args.ph_hi;
    unsigned* barw = (unsigned*)(F.ws + WS_CTL) + CW_BAR;
    XcdBarrier bar; bar.bar = barw; bar.x = 0; bar.st = nullptr;
    if (hi - lo > 1) bar = xcd_barrier_post(barw, MISC + 8);
#ifndef ONLY_PHASE
#define ONLY_PHASE -1
#endif
#define HASP(k) (ONLY_PHASE < 0 || ONLY_PHASE == (k) || (ONLY_PHASE == 100 && (k) == 10) || (ONLY_PHASE == 101 && (k) == 11))
#define IN(k) (HASP(k) && lo <= (k) && (k) < hi)
#ifndef DBG_REP
#define DBG_REP -1
#endif
#ifndef DBG_REPN
#define DBG_REPN 2
#endif
#define REPS(k) for (int rep_ = 0; rep_ < ((DBG_REP == (k)) ? DBG_REPN : 1); (void)({ asm volatile("" ::: "memory"); 0; }), ++rep_)
#define SEAM(k) do { if (IN(k) && IN((k) + 1)) xcd_barrier(bar); } while (0)
    bf16* const H = (bf16*)F.out;

    if (IN(0)) { REPS(0) phase0(F); } SEAM(0);
    if (IN(1)) { REPS(1) phase1(F); } SEAM(1);
    if (IN(2)) REPS(2) {
        pg8::Gemm g{H, (const bf16*)(F.ws + WS_WIN), T, NIN, D / 2}; pg8::StaticOrder S; S.init(T, NIN, F.G, (int)blockIdx.x);
        EpiIn E{(bf16*)(F.ws + WS_U), (bf16*)(F.ws + WS_Q), (bf16*)(F.ws + WS_K), (bf16*)(F.ws + WS_V), (bf16*)(F.ws + WS_GC), (bf16*)(F.ws + WS_GA), (const float*)(F.ws + WS_ROPE), F.in(I_QNG), F.in(I_KNG), F.lds + EPI_SCR};
        pg8::gemm_phase<EpiIn, pg8::StaticOrder, true, true, false, true>(F.lds, g, S, E);
    } SEAM(2);
    if (IN(3)) { REPS(3) phase3(F); } SEAM(3);
    if (IN(4)) REPS(4) {
        pg8::Gemm g{H, (const bf16*)(F.ws + WS_WPW2), T, D, D / 2}; pg8::StaticOrder S; S.init(T, D, F.G, (int)blockIdx.x);
        EpiPw2 E{(bf16*)(F.ws + WS_U), (const bf16*)(F.ws + WS_GC), F.in(I_BPW2)};
        pg8::gemm_phase<EpiPw2, pg8::StaticOrder, true, true, false, true>(F.lds, g, S, E);
    } SEAM(4);
#ifndef DBG_ATTVAR
#define DBG_ATTVAR 0
#endif
    if (IN(5)) { att::phase5(F, (bf16*)(F.ws + WS_U)); } SEAM(5);
    if (IN(6)) REPS(6) {
        pg8::Gemm g{(const bf16*)(F.ws + WS_U), (const bf16*)(F.ws + WS_WOUT), T, D, D}; pg8::StaticOrder S; S.init(T, D, F.G, (int)blockIdx.x);
        EpiOut E{F.in(I_X), F.out, (const float*)(F.ws + WS_MOD)};
        pg8::gemm_phase<EpiOut, pg8::StaticOrder, true, true, false>(F.lds, g, S, E);
    } SEAM(6);
    if (IN(7)) { REPS(7) phase7(F); } SEAM(7);
    if (IN(8)) { REPS(8) phase8(F); } SEAM(8);
    const int* TE = (const int*)(F.ws + WS_TE); const int* TOK = (const int*)(F.ws + WS_TOK);
    if (IN(9)) REPS(9) {
        const int NTR = ((const int*)(F.ws + WS_META))[0];
        pg8::Gemm g{(const bf16*)(F.ws + WS_U), (const bf16*)(F.ws + WS_WGU), 0, 0, D / 2};
        SchedMoe S{F.G, (int)blockIdx.x, 2 * (NTR + 128), 0, 1, 0, 2, TE, TOK};
        EpiGU E{(unsigned char*)(F.ws + WS_ACT), (const float*)(F.ws + WS_WGT)};
        pg8::gemm_phase<EpiGU, SchedMoe, true, true, true, true>(F.lds, g, S, E);
    } SEAM(9);
    if (IN(10)) REPS(10) { const int NTR = ((const int*)(F.ws + WS_META))[0];
        pg8::Gemm g{(const bf16*)(F.ws + WS_ACT), (const bf16*)(F.ws + WS_WDN), 0, 0, ED / 2};
        SchedMoe S{F.G, (int)blockIdx.x, 4 * NTR, 0, 2, 0, 4, TE, TOK};
        EpiDown E{(unsigned char*)(F.ws + WS_Y)};
#ifndef DBG_P10VAR
#define DBG_P10VAR 0
#endif
        if (DBG_P10VAR == 1) { EpiNull<0> E0{(float*)(F.ws + WS_META) + 8}; pg8::gemm_phase<EpiNull<0>, SchedMoe, true, true, false>(F.lds, g, S, E0); }
        if (DBG_P10VAR == 2) { EpiNull<1> E0{(float*)(F.ws + WS_META) + 8}; pg8::gemm_phase<EpiNull<1>, SchedMoe, true, true, false>(F.lds, g, S, E0); }
        pg8::gemm_phase<EpiDown, SchedMoe, true, true, false, true>(F.lds, g, S, E);
    } SEAM(10);
    if (IN(11)) { const int NTR = ((const int*)(F.ws + WS_META))[0];
        pg8::Gemm g{(const bf16*)(F.ws + WS_ACT), (const bf16*)(F.ws + WS_WDN), 0, 0, ED / 2};
        SchedMoe S{F.G, (int)blockIdx.x, 512, NTR, 2, 0, 4, TE, TOK};
        EpiComb E{F.out, (const unsigned char*)(F.ws + WS_Y), (const int*)(F.ws + WS_POS), (const float*)(F.ws + WS_MOD), NTR};
        pg8::gemm_phase<EpiComb, SchedMoe, true, true, false, true>(F.lds, g, S, E);
    }
#undef IN
#undef SEAM

}

#ifndef DBG_A6
#define DBG_A6 WS_U
#endif
#ifndef DBG_SKIP
#define DBG_SKIP 0
#endif
#ifndef DBG_NPH
#define DBG_NPH NPHASE
#endif
#ifndef N_LAUNCH_MODE
#define N_LAUNCH_MODE 1
#endif
extern "C" void kernel_launch(void* const* d_in, const int* in_sizes, int n_in, void* d_out, int out_size, void* d_ws, size_t ws_size, hipStream_t stream) {
    static int grid = 0;
    if (grid == 0) {
        if (n_in != 28 || out_size != T * D || ws_size < WS_END) { fprintf(stderr, "kernel_launch: unexpected problem (n_in %d out %d ws %zu)\n", n_in, out_size, ws_size); grid = -1; return; }
        int dev = 0, cus = 0, per_cu = 0;
        if (hipGetDevice(&dev) != hipSuccess || hipDeviceGetAttribute(&cus, hipDeviceAttributeMultiprocessorCount, dev) != hipSuccess) { grid = -1; return; }
        if (hipFuncSetAttribute((const void*)fwd_kernel, hipFuncAttributeMaxDynamicSharedMemorySize, LDS_BYTES) != hipSuccess) { grid = -1; return; }
        if (hipOccupancyMaxActiveBlocksPerMultiprocessor(&per_cu, (const void*)fwd_kernel, NTHREADS, LDS_BYTES) != hipSuccess || per_cu < 1) { fprintf(stderr, "kernel_launch: occupancy query says %d\n", per_cu); }
        (void)hipGetLastError();
        grid = cus;
    }
    if (grid < 0) return;
    (void)hipMemsetAsync((char*)d_ws + WS_CTL, 0, CTL_ZERO_BYTES, stream);
    Args a{};
    for (int i = 0; i < 28; ++i) a.in[i] = d_in[i];
    a.out = (float*)d_out; a.ws = (unsigned char*)d_ws;
    if (N_LAUNCH_MODE == 1) { a.ph_lo = 0; a.ph_hi = NPHASE; hipLaunchKernelGGL(fwd_kernel, dim3(grid), dim3(NTHREADS), LDS_BYTES, stream, a); }
    else { for (int p = 0; p < DBG_NPH; ++p) { if ((DBG_SKIP >> p) & 1) continue; a.ph_lo = p; a.ph_hi = p + 1; hipLaunchKernelGGL(fwd_kernel, dim3(grid), dim3(NTHREADS), LDS_BYTES, stream, a); } }
}
```

```cpp
#include <hip/hip_runtime.h>
#include <cstdio>
#include <cstdint>

#define GAS __attribute__((address_space(1)))
#define LAS __attribute__((address_space(3)))
typedef unsigned short bf16;
typedef short bf16x8 __attribute__((ext_vector_type(8)));
typedef short s16x4 __attribute__((ext_vector_type(4)));
typedef float f32x4 __attribute__((ext_vector_type(4)));
typedef float f32x2 __attribute__((ext_vector_type(2)));
typedef float f32x16 __attribute__((ext_vector_type(16)));
typedef unsigned u32x4 __attribute__((ext_vector_type(4)));
typedef unsigned u32x2 __attribute__((ext_vector_type(2)));
typedef int i32x4 __attribute__((ext_vector_type(4)));

constexpr int NB = 2, SEQ = 16384, T = NB * SEQ, D = 1024, NIN = 7168;
constexpr int NE = 64, TOPK = 8, ED = 256, NEX = NE + 1;
constexpr float EPS = 1e-6f;
constexpr float C2 = 0.125f * 1.4426950408889634f;
constexpr float LAMBDA_INIT = 0.2f;
constexpr int NWAVES = 8, NTHREADS = 512;

constexpr size_t MiB = 1u << 20;
constexpr size_t WS_CTL = 0, CTL_ZERO_BYTES = 64 * 1024;
constexpr size_t WS_MOD = 1 * MiB;
constexpr size_t WS_ROPE = 1 * MiB + 64 * 1024;
constexpr size_t WS_TKE = 3 * MiB + 256 * 1024;
constexpr size_t WS_TKR = 4 * MiB + 256 * 1024;
constexpr size_t WS_TKW = 5 * MiB + 256 * 1024;
constexpr size_t WS_POS = 6 * MiB + 256 * 1024;
constexpr size_t WS_CNT = 7 * MiB + 256 * 1024;
constexpr size_t WS_TE = WS_CNT + 64 * 1024;
constexpr size_t WS_META = WS_TE + 8 * 1024;
constexpr size_t WS_TOK = 7 * MiB + 512 * 1024;
constexpr size_t WS_WGT = 8 * MiB + 768 * 1024;
constexpr int RMAX = 262144 + 64 * 256 + T;
static_assert(WS_TOK + (size_t)RMAX * 4 <= WS_WGT && WS_WGT + (size_t)RMAX * 4 <= 10 * MiB, "small region");
constexpr size_t WS_WRH = 10 * MiB, WS_WRL = 10 * MiB + 128 * 1024;
constexpr size_t WS_WDN = 11 * MiB;
constexpr size_t WS_WIN = WS_WDN + (size_t)NEX * 1024 * 256 * 2 + MiB / 2;
constexpr size_t WS_WPW2 = WS_WIN + 14 * MiB, WS_WOUT = WS_WPW2 + 2 * MiB;
constexpr size_t WS_WGU = WS_WOUT + 2 * MiB;
constexpr size_t WS_U = 127 * MiB;
constexpr size_t WS_Q = WS_U + 64 * MiB, WS_K = WS_Q + 64 * MiB, WS_V = WS_K + 64 * MiB, WS_GC = WS_V + 64 * MiB, WS_GA = WS_GC + 64 * MiB;
constexpr size_t WS_END = WS_GA + 64 * MiB;
static_assert(WS_WGU + (size_t)NEX * 512 * 1024 * 2 <= WS_U && WS_END <= 512 * MiB, "ws map");
constexpr size_t WS_ACT = 359 * MiB;
constexpr size_t WS_Y = 44 * MiB;
static_assert(WS_ACT + (size_t)RMAX * 512 <= WS_END && WS_Y + (size_t)(262144 + 64 * 256) * 1024 <= WS_ACT && WS_Y >= WS_WDN + (size_t)NEX * 1024 * 256 * 2, "moe overlays");
constexpr int CW_BAR = 1024;

#ifndef DBG_A6
#define DBG_A6 WS_U
#endif
constexpr int RING_BYTES = 131072;
constexpr int LDS_BYTES = 163840;
constexpr int EPI_SCR = RING_BYTES;
constexpr int MISC_OFF = LDS_BYTES - 256;

#define LDS_WAIT() asm volatile("s_waitcnt lgkmcnt(0)" ::: "memory")
#define VM_WAIT() asm volatile("s_waitcnt vmcnt(0)" ::: "memory")
typedef __bf16 bf16x2_t __attribute__((ext_vector_type(2)));
__device__ __forceinline__ unsigned cvt_pk_bf16(float lo, float hi) { const f32x2 v = {lo, hi}; const bf16x2_t b = __builtin_convertvector(v, bf16x2_t); return __builtin_bit_cast(unsigned, b); }
__device__ __forceinline__ float bf_lo(unsigned u) { return __builtin_bit_cast(float, u << 16); }
__device__ __forceinline__ float bf_hi(unsigned u) { return __builtin_bit_cast(float, u & 0xffff0000u); }
__device__ __forceinline__ float sigmoidf_(float x) { return __builtin_amdgcn_rcpf(1.f + __expf(-x)); }
__device__ __forceinline__ float wave_sum(float v) {
#pragma unroll
    for (int o = 1; o < 64; o <<= 1) v += __shfl_xor(v, o);
    return v;
}
__device__ __forceinline__ float wave_max(float v) {
#pragma unroll
    for (int o = 1; o < 64; o <<= 1) v = fmaxf(v, __shfl_xor(v, o));
    return v;
}

namespace pg8 {
typedef int i32x8_t __attribute__((ext_vector_type(8)));
typedef int i32x4_t __attribute__((ext_vector_type(4)));
constexpr int BM = 256, BK = 64, HALF = 128, HTB = HALF * BK * 2, STAGE_BYTES = 8 * HTB, NXCD = 8, WGM = 8;
__host__ __device__ __forceinline__ int lds_byte(int r, int c) { const int st = (r >> 4) * 2 + (c >> 5), rr = r & 15, cc = c & 31, ob = rr * 64 + cc * 2; return st * 1024 + (ob ^ (((ob >> 9) & 1) << 5)); }
__host__ __device__ __forceinline__ void stage_rc(int b, int& R, int& C) { const int st = b / 1024, sb = b % 1024, swz = sb ^ (((sb >> 9) & 1) << 5); R = (st >> 1) * 16 + swz / 64; C = (st & 1) * 32 + (swz % 64) / 2; }
__host__ __device__ __forceinline__ int perm32(int rho) { const int n = rho >> 4, i = rho & 15; return 8 * (i >> 2) + 4 * n + (i & 3); }

struct Unit { int pm, pn; };
struct Gemm { const bf16* A; const bf16* Bt; int M, N, K; };

struct StaticOrder {
    int nM, nN, nwg, G, c;
    const int* tok;
    __host__ __device__ void init(int M, int N, int G_, int c_) { nM = M / BM; nN = N / BM; nwg = nM * nN; G = G_; c = c_; tok = nullptr; }
    __host__ __device__ bool next(int i, Unit& u) const {
        const long L = (long)i * G + c; if (L >= nwg) return false;
        int wgid = (int)L; { const int q = nwg / NXCD, r = nwg % NXCD, xcd = wgid % NXCD, off = wgid / NXCD; wgid = (xcd < r ? xcd * (q + 1) : r * (q + 1) + (xcd - r) * q) + off; }
        const int nig = WGM * nN, gid = wgid / nig, fm = gid * WGM, gsz = (nM - fm) < WGM ? (nM - fm) : WGM;
        u.pm = fm + ((wgid % nig) % gsz); u.pn = (wgid % nig) / gsz; return true;
    }
};

template <class Epi, class Sched, bool ALIGN_EPI, bool SP2, bool GATHER, bool FP8 = false>
__device__ __forceinline__ void gemm_phase(LAS unsigned char* lds, const Gemm g, const Sched& S, const Epi& E) {
    const int tid = threadIdx.x, wid = __builtin_amdgcn_readfirstlane(tid >> 6), lane = tid & 63, wr = wid >> 2, wc = wid & 3, fr = lane & 15, fq = lane >> 4;
    const int K = g.K, nt = K / BK;
    unsigned voffA[2], voffB[2]; int RA[2]; unsigned CA2[2];
#pragma unroll
    for (int i = 0; i < 2; ++i) { int R, C; stage_rc(tid * 16 + i * 8192, R, C); const int Rb = Epi::PERM ? ((R & ~31) + perm32(R & 31)) : R;
        voffA[i] = (unsigned)(R * K + C) * 2u; voffB[i] = (unsigned)(Rb * K + C) * 2u; RA[i] = R; CA2[i] = (unsigned)C * 2u; }
    const size_t kstep = (size_t)(BK * 2);
    const size_t hstep = (size_t)HALF * K * 2;
    const size_t tstep = 2 * hstep;
    const unsigned ldsw = (unsigned)wid * 1024u;
    const int aoff = lds_byte(wr * 64 + fr, fq * 8), boff = lds_byte(wc * 32 + fr, fq * 8);
#define PG8_SA(b, h) (((b) * 2 + (h)) * HTB)
#define PG8_SB(b, h) ((4 + (b) * 2 + (h)) * HTB)
#define PG8_STAGE2(bufoff, gbase, o0, o1) do { \
        __builtin_amdgcn_global_load_lds((const unsigned*)((const char*)(gbase) + (o0)), (LAS unsigned*)(lds + (bufoff) + ldsw), 16, 0, 0); \
        __builtin_amdgcn_global_load_lds((const unsigned*)((const char*)(gbase) + (o1)), (LAS unsigned*)(lds + (bufoff) + ldsw + 8192), 16, 0, 0); } while (0)
#define PG8_STAGEB(bufoff, gbase) PG8_STAGE2(bufoff, gbase, voffB[0], voffB[1])
#define PG8_STAGEA(bufoff, gbase, h, o0, o1) do { if constexpr (GATHER) { PG8_STAGE2(bufoff, gbase, o0, o1); } else { PG8_STAGE2(bufoff, (gbase) + (h) * hstep, voffA[0], voffA[1]); } } while (0)
#define PG8_LD8(p) __builtin_shufflevector(*(const LAS i32x4_t*)(p), *(const LAS i32x4_t*)((p) + 1024), 0, 1, 2, 3, 4, 5, 6, 7)
#define PG8_LDA(dst, b, h) do { if constexpr (FP8) { _Pragma("unroll") for (int m = 0; m < 4; ++m) dst##8[m] = PG8_LD8(lds + PG8_SA(b, h) + aoff + m * 2048); } \
        else { _Pragma("unroll") for (int m = 0; m < 4; ++m) _Pragma("unroll") for (int k = 0; k < 2; ++k) dst[m][k] = *(const LAS bf16x8*)(lds + PG8_SA(b, h) + aoff + m * 2048 + k * 1024); } } while (0)
#define PG8_LDB(dst, b, h) do { if constexpr (FP8) { _Pragma("unroll") for (int n = 0; n < 2; ++n) dst##8[n] = PG8_LD8(lds + PG8_SB(b, h) + boff + n * 2048); } \
        else { _Pragma("unroll") for (int n = 0; n < 2; ++n) _Pragma("unroll") for (int k = 0; k < 2; ++k) dst[n][k] = *(const LAS bf16x8*)(lds + PG8_SB(b, h) + boff + n * 2048 + k * 1024); } } while (0)
#define PG8_CAT(x) __builtin_shufflevector(__builtin_bit_cast(i32x4_t, (x)[0]), __builtin_bit_cast(i32x4_t, (x)[1]), 0, 1, 2, 3, 4, 5, 6, 7)
#define PG8_MMA(ai, bj, At, Bt) do { __builtin_amdgcn_s_setprio(1); \
        if constexpr (FP8) { _Pragma("unroll") for (int m = 0; m < 4; ++m) _Pragma("unroll") for (int n = 0; n < 2; ++n) \
            asm volatile("v_mfma_f32_16x16x128_f8f6f4 %0, %1, %2, %0" : "+v"(acc[ai][bj][m][n]) : "v"(Bt##8[n]), "v"(At##8[m])); }   \
        else { _Pragma("unroll") for (int m = 0; m < 4; ++m) _Pragma("unroll") for (int n = 0; n < 2; ++n) _Pragma("unroll") for (int k = 0; k < 2; ++k) \
            acc[ai][bj][m][n] = __builtin_amdgcn_mfma_f32_16x16x32_bf16(Bt[n][k], At[m][k], acc[ai][bj][m][n], 0, 0, 0); } \
        __builtin_amdgcn_s_setprio(0); } while (0)
#define PG8_WAIT_V(n) asm volatile("s_waitcnt vmcnt(" #n ")" ::: "memory")
#define PG8_WAIT_L(n) asm volatile("s_waitcnt lgkmcnt(" #n ")" ::: "memory")
#define PG8_BAR __builtin_amdgcn_s_barrier()
#define PG8_SCHED __builtin_amdgcn_sched_barrier(0)
#define PG8_SETA(o, u) do { _Pragma("unroll") for (int h_ = 0; h_ < 2; ++h_) _Pragma("unroll") for (int i_ = 0; i_ < 2; ++i_) { \
        if constexpr (GATHER) { int t_ = S.tok[(u).pm * 256 + h_ * 128 + RA[i_]]; t_ = t_ < 0 ? 0 : t_; o[h_][i_] = (unsigned)t_ * (unsigned)(K * 2) + CA2[i_]; } \
        else { o[h_][i_] = (unsigned)(h_ * hstep) + voffA[i_]; } } } while (0)
    Unit cur, nxt; int ui = 0;
    if (!S.next(0, cur)) return;
    f32x4 acc[2][2][4][2];
#pragma unroll
    for (int a = 0; a < 2; ++a)
#pragma unroll
        for (int b = 0; b < 2; ++b)
#pragma unroll
            for (int m = 0; m < 4; ++m)
#pragma unroll
                for (int n = 0; n < 2; ++n) acc[a][b][m][n] = (f32x4){0.f, 0.f, 0.f, 0.f};
    bf16x8 At[4][2], B0[2][2], B1[2][2];
    i32x8_t At8[4], B08[2], B18[2];
    unsigned cO[2][2], nO[2][2];
    if constexpr (GATHER) { PG8_SETA(cO, cur); VM_WAIT(); }
    else { cO[0][0] = cO[0][1] = cO[1][0] = cO[1][1] = 0u; }
    const char* cA = GATHER ? (const char*)g.A : (const char*)g.A + (size_t)cur.pm * tstep; const char* cB = (const char*)g.Bt + (size_t)cur.pn * tstep;
    if constexpr (SP2) {
        PG8_STAGEB(PG8_SB(0, 0), cB); PG8_STAGEB(PG8_SB(0, 1), cB + hstep); PG8_STAGEA(PG8_SA(0, 0), cA, 0, cO[0][0], cO[0][1]); PG8_STAGEA(PG8_SA(0, 1), cA, 1, cO[1][0], cO[1][1]);
        if (wr == 1) PG8_BAR;
        PG8_WAIT_V(2); PG8_BAR;
        PG8_STAGEB(PG8_SB(1, 0), cB + kstep); PG8_STAGEA(PG8_SA(1, 0), cA + kstep, 0, cO[0][0], cO[0][1]); PG8_STAGEB(PG8_SB(1, 1), cB + hstep + kstep);
        PG8_WAIT_V(6); PG8_BAR;
    }
    for (;;) {
        const bool has_next = S.next(ui + 1, nxt);
        if constexpr (!GATHER) { nO[0][0] = nO[0][1] = nO[1][0] = nO[1][1] = 0u; }
        else if (has_next) { PG8_SETA(nO, nxt); } else {
#pragma unroll
            for (int h_ = 0; h_ < 2; ++h_)
#pragma unroll
                for (int i_ = 0; i_ < 2; ++i_) nO[h_][i_] = cO[h_][i_]; }
        const char* nA = GATHER ? (const char*)g.A : (has_next ? (const char*)g.A + (size_t)nxt.pm * tstep : cA);
        const char* nB = has_next ? (const char*)g.Bt + (size_t)nxt.pn * tstep : cB;
#pragma nounroll
        for (int t = 0; t < nt; t += 2) {
            const bool last = (t == nt - 2);
            const char* a1 = cA + (size_t)(t + 1) * kstep;
            const char* a2 = last ? nA : cA + (size_t)(t + 2) * kstep; const char* b2 = last ? nB : cB + (size_t)(t + 2) * kstep;
            const char* a3 = a2 + kstep; const char* b3 = b2 + kstep;
            const unsigned x00 = last ? nO[0][0] : cO[0][0], x01 = last ? nO[0][1] : cO[0][1], x10 = last ? nO[1][0] : cO[1][0], x11 = last ? nO[1][1] : cO[1][1];
            PG8_LDB(B0, 0, 0); PG8_LDB(B1, 0, 1); PG8_SCHED; PG8_LDA(At, 0, 0); PG8_STAGEA(PG8_SA(1, 1), a1, 1, cO[1][0], cO[1][1]);
            PG8_WAIT_V(8); PG8_WAIT_L(0); PG8_BAR; PG8_MMA(0, 0, At, B0); PG8_MMA(0, 1, At, B1); PG8_BAR; PG8_SCHED;
            PG8_LDA(At, 0, 1); PG8_STAGEB(PG8_SB(0, 0), b2); PG8_STAGEB(PG8_SB(0, 1), b2 + hstep); PG8_STAGEA(PG8_SA(0, 0), a2, 0, x00, x01);
            PG8_WAIT_V(8); PG8_WAIT_L(0); PG8_BAR; PG8_MMA(1, 0, At, B0); PG8_MMA(1, 1, At, B1); PG8_BAR; PG8_SCHED;
            PG8_LDB(B0, 1, 0); PG8_LDB(B1, 1, 1); PG8_SCHED; PG8_LDA(At, 1, 0); PG8_STAGEA(PG8_SA(0, 1), a2, 1, x10, x11);
            PG8_WAIT_V(8); PG8_WAIT_L(0); PG8_BAR; PG8_MMA(0, 0, At, B0); PG8_MMA(0, 1, At, B1); PG8_BAR; PG8_SCHED;
            PG8_LDA(At, 1, 1); PG8_STAGEB(PG8_SB(1, 0), b3); PG8_STAGEB(PG8_SB(1, 1), b3 + hstep); PG8_STAGEA(PG8_SA(1, 0), a3, 0, x00, x01);
            PG8_WAIT_V(8); PG8_WAIT_L(0); PG8_BAR; PG8_MMA(1, 0, At, B0); PG8_MMA(1, 1, At, B1); PG8_BAR; PG8_SCHED;
        }
        if constexpr (ALIGN_EPI) { if (wr == 0) PG8_BAR; }
        if constexpr (FP8) asm volatile("s_nop 15\n\ts_nop 15" ::: "memory");
        E(acc, cur, wr, wc, fr, fq);
        if (!has_next) break;
#pragma unroll
        for (int a = 0; a < 2; ++a)
#pragma unroll
            for (int b = 0; b < 2; ++b)
#pragma unroll
                for (int m = 0; m < 4; ++m)
#pragma unroll
                    for (int n = 0; n < 2; ++n) acc[a][b][m][n] = (f32x4){0.f, 0.f, 0.f, 0.f};
        cur = nxt; cA = nA; cB = nB; ++ui;
#pragma unroll
        for (int h_ = 0; h_ < 2; ++h_)
#pragma unroll
            for (int i_ = 0; i_ < 2; ++i_) cO[h_][i_] = nO[h_][i_];
        if constexpr (ALIGN_EPI) { if (wr == 1) PG8_BAR; }
    }
    PG8_WAIT_V(0);
    if constexpr (!ALIGN_EPI) { if (wr == 0) PG8_BAR; }
    PG8_BAR;
#undef PG8_SA
#undef PG8_SB
#undef PG8_STAGE2
#undef PG8_STAGEB
#undef PG8_STAGEA
#undef PG8_LDA
#undef PG8_LD8
#undef PG8_LDB
#undef PG8_MMA
#undef PG8_CAT
#undef PG8_WAIT_V
#undef PG8_WAIT_L
#undef PG8_BAR
#undef PG8_SCHED
#undef PG8_SETA
}
}

#define XB_TMO      128
#define XB_XCNT(j)  (256  + 64 * (j))
#define XB_XSUB(j)  (1280 + 64 * (j))
#define XB_XGEN(j)  (2304 + 64 * (j))
#define XB_TOP      3328
#define XB_TOPGEN   3392
#define XCD_BAR_WORDS 3456
#define XB_SPIN_CAP (1u << 18)
__device__ __forceinline__ unsigned xb_ld(unsigned* p)              { return __hip_atomic_load(p, __ATOMIC_RELAXED, __HIP_MEMORY_SCOPE_AGENT); }
__device__ __forceinline__ unsigned xb_add(unsigned* p, unsigned v) { return __hip_atomic_fetch_add(p, v, __ATOMIC_RELAXED, __HIP_MEMORY_SCOPE_AGENT); }
__device__ __forceinline__ unsigned xb_xcc_id() { return (unsigned)__builtin_amdgcn_s_getreg((3 << 11) | 20) & 0xFu; }
#define XB_SPIN(cond, bar) do { unsigned _sp = 0; while (cond) { __builtin_amdgcn_s_sleep(1); \
    if ((++_sp & 255u) == 0u) { if (xb_ld(&(bar)[XB_TMO])) break; if (_sp > XB_SPIN_CAP) { atomicAdd(&(bar)[XB_TMO], 1u); break; } } } } while (0)
struct XcdBarrier { unsigned* bar; unsigned x; volatile LAS unsigned* st; };
__device__ __forceinline__ XcdBarrier xcd_barrier_post(unsigned* bar, volatile LAS unsigned* st) {
    XcdBarrier b; b.bar = bar; b.x = xb_xcc_id(); b.st = st;
    if (threadIdx.x == 0) (void)xb_add(&bar[XB_XCNT(b.x)], 1u);
    return b;
}
__device__ __forceinline__ void xcd_barrier_complete(unsigned* bar, unsigned x, unsigned& nloc, unsigned& nx) {
    const unsigned G = gridDim.x * gridDim.y * gridDim.z;
    unsigned sum, cnt, mine, sp = 0u;
    for (;;) {
        sum = 0u; cnt = 0u; mine = 0u;
#pragma unroll
        for (unsigned j = 0; j < 16; ++j) { const unsigned c = xb_ld(&bar[XB_XCNT(j)]); sum += c; cnt += (c > 0u) ? 1u : 0u; mine = (j == x) ? c : mine; }
        if (sum == G) break;
        __builtin_amdgcn_s_sleep(1);
        if ((++sp & 255u) == 0u) { if (xb_ld(&bar[XB_TMO])) break; if (sp > XB_SPIN_CAP) { atomicAdd(&bar[XB_TMO], 1u); break; } }
    }
    nloc = mine > 0u ? mine : 1u; nx = cnt > 0u ? cnt : 1u;
}
__device__ __forceinline__ void xcd_barrier(const XcdBarrier& b) {
    asm volatile("s_waitcnt vmcnt(0)" ::: "memory");
    __syncthreads();
    if (threadIdx.x == 0) {
        unsigned* bar = b.bar;
        __builtin_amdgcn_s_waitcnt(0);
        unsigned nloc = b.st[0], nx = b.st[1];
        if (nloc == 0u) { xcd_barrier_complete(bar, b.x, nloc, nx); b.st[0] = nloc; b.st[1] = nx; }
        const unsigned old = xb_add(&bar[XB_XSUB(b.x)], 1u);
        const unsigned gen = old / nloc;
        if (old + 1u == (gen + 1u) * nloc) {
            __builtin_amdgcn_fence(__ATOMIC_RELEASE, "agent");
            asm volatile("s_waitcnt vmcnt(0)" ::: "memory");
            const unsigned og = xb_add(&bar[XB_TOP], 1u);
            const unsigned tg = og / nx;
            if (og + 1u == (tg + 1u) * nx) xb_add(&bar[XB_TOPGEN], 1u);
            else XB_SPIN(xb_ld(&bar[XB_TOPGEN]) == tg, bar);
            __builtin_amdgcn_fence(__ATOMIC_ACQUIRE, "agent");
            xb_add(&bar[XB_XGEN(b.x)], 1u);
            asm volatile("s_waitcnt vmcnt(0)" ::: "memory");
        } else {
            XB_SPIN(xb_ld(&bar[XB_XGEN(b.x)]) == gen, bar);
            __builtin_amdgcn_fence(__ATOMIC_ACQUIRE, "agent");
            asm volatile("s_waitcnt vmcnt(0)" ::: "memory");
        }
    }
    __syncthreads();
}

struct Args { const void* in[28]; float* out; unsigned char* ws; int ph_lo, ph_hi; };
struct Frame {
    LAS unsigned char* lds;
    int tid, lane, wave, vcu, G;
    unsigned char* ws; float* out;
    const __attribute__((address_space(4))) unsigned char* ka;
    __device__ __forceinline__ const float* in(int i) const { return ((const float* const __attribute__((address_space(4)))*)ka)[i]; }
};
enum { I_X = 0, I_C, I_POS, I_WADA, I_BADA, I_N1G, I_WIN, I_CDW, I_CDWB, I_CLNG, I_CLNB, I_WPW2, I_BPW2, I_QNG, I_KNG, I_LQ1, I_LK1, I_LQ2, I_LK2, I_SUBG, I_WOUT, I_N2G, I_WR, I_RB, I_WEGU, I_WEDN, I_WSGU, I_WSDN };

__device__ __forceinline__ int win_map(int n) {
    if (n < 1024) return 256 * (n >> 7) + (n & 127);
    if (n < 2048) { const int j = n - 1024; return 256 * (j >> 7) + 128 + (j & 127); }
    if (n < 4096) { const int qk = (n - 2048) >> 10, j = (n - 2048) & 1023, g = j >> 6, dl = j & 63; const int tile = 8 + 4 * qk + (g >> 2), wc = g & 3;
        int bj, fq, e; if (dl < 8) { bj = 0; fq = 0; e = dl; } else if (dl < 16) { bj = 1; fq = 0; e = dl - 8; } else { const int rho = dl - 16; bj = rho / 24; fq = 1 + (rho % 24) / 8; e = rho & 7; }
        return 256 * tile + 128 * bj + 32 * wc + 8 * fq + e; }
    return n;
}
__device__ __forceinline__ int glu_map(int n) { const int j = n & 255; return 256 * (j >> 7) + ((n >> 8) << 7) + (j & 127); }
__device__ __forceinline__ int qk_dim(int bj, int fq, int e) { return fq == 0 ? bj * 8 + e : 16 + bj * 24 + (fq - 1) * 8 + e; }

template <int MAP>
__device__ __forceinline__ void transpose_item(const float* W, int K, int N, bf16* WT, LAS float* scr, int item, int lane) {
    const int nblk = N / 32, kb = item / nblk, nb = item % nblk, k0 = 64 * kb, n0 = 32 * nb;
    {
        const int rr = lane >> 3, c4 = (lane & 7) * 4; f32x4 t[8];
#pragma unroll
        for (int i = 0; i < 8; ++i) t[i] = __builtin_nontemporal_load((const f32x4*)(W + (size_t)(k0 + 8 * i + rr) * N + n0 + c4));
#pragma unroll
        for (int i = 0; i < 8; ++i) { LAS float* d = scr + (8 * i + rr) * 33 + c4; d[0] = t[i].x; d[1] = t[i].y; d[2] = t[i].z; d[3] = t[i].w; }
    }
    LDS_WAIT(); asm volatile("" ::: "memory");
    const int c = lane & 7;
#pragma unroll
    for (int j = 0; j < 4; ++j) { const int n = (lane >> 3) + 8 * j; const LAS float* s = scr + (8 * c) * 33 + n;
        u32x4 o; o.x = cvt_pk_bf16(s[0 * 33], s[1 * 33]); o.y = cvt_pk_bf16(s[2 * 33], s[3 * 33]); o.z = cvt_pk_bf16(s[4 * 33], s[5 * 33]); o.w = cvt_pk_bf16(s[6 * 33], s[7 * 33]);
        const int nn = n0 + n; const int row = MAP == 1 ? win_map(nn) : (MAP == 2 ? glu_map(nn) : nn);
        *(u32x4*)(WT + (size_t)row * K + k0 + 8 * c) = o; }
    LDS_WAIT(); asm volatile("" ::: "memory");
}

constexpr float WDN_SCALE = 16.f, ACT_SCALE = 8.f;
constexpr float WIN_SCALE = 32.f;
template <int MAP>
__device__ __forceinline__ void transpose_item8(const float* W, int K, int N, unsigned char* WT, LAS float* scr, int item, int lane, float scale = WIN_SCALE) {
    const int nblk = N / 32, kb = item / nblk, nb = item % nblk, k0 = 64 * kb, n0 = 32 * nb;
    {
        const int rr = lane >> 3, c4 = (lane & 7) * 4; f32x4 t[8];
#pragma unroll
        for (int i = 0; i < 8; ++i) t[i] = __builtin_nontemporal_load((const f32x4*)(W + (size_t)(k0 + 8 * i + rr) * N + n0 + c4));
#pragma unroll
        for (int i = 0; i < 8; ++i) { LAS float* d = scr + (8 * i + rr) * 33 + c4; d[0] = t[i].x * scale; d[1] = t[i].y * scale; d[2] = t[i].z * scale; d[3] = t[i].w * scale; }
    }
    LDS_WAIT(); asm volatile("" ::: "memory");
    const int c = lane & 7;
#pragma unroll
    for (int j = 0; j < 4; ++j) { const int n = (lane >> 3) + 8 * j; const LAS float* sp = scr + (8 * c) * 33 + n;
        int d0 = 0, d1 = 0;
        d0 = __builtin_amdgcn_cvt_pk_fp8_f32(sp[0 * 33], sp[1 * 33], d0, false); d0 = __builtin_amdgcn_cvt_pk_fp8_f32(sp[2 * 33], sp[3 * 33], d0, true);
        d1 = __builtin_amdgcn_cvt_pk_fp8_f32(sp[4 * 33], sp[5 * 33], d1, false); d1 = __builtin_amdgcn_cvt_pk_fp8_f32(sp[6 * 33], sp[7 * 33], d1, true);
        const int nn = n0 + n; const int row = MAP == 1 ? win_map(nn) : (MAP == 2 ? glu_map(nn) : nn);
        *(u32x2*)(WT + (size_t)row * K + k0 + 8 * c) = (u32x2){(unsigned)d0, (unsigned)d1}; }
    LDS_WAIT(); asm volatile("" ::: "memory");
}
__device__ __forceinline__ void phase0(Frame& F) {
    if (F.vcu < 96) {
        const int col = F.vcu * 64 + F.lane; const float* c = F.in(I_C); const float* wa = F.in(I_WADA);
        float a0 = 0.f, a1 = 0.f;
        for (int k = F.wave * 128; k < F.wave * 128 + 128; ++k) { const float c0 = c[k], c1 = c[1024 + k]; const float s0 = c0 * sigmoidf_(c0), s1 = c1 * sigmoidf_(c1); const float w = wa[(size_t)k * 6144 + col]; a0 += s0 * w; a1 += s1 * w; }
        LAS float* red = (LAS float*)F.lds;
        red[(F.wave * 2 + 0) * 64 + F.lane] = a0; red[(F.wave * 2 + 1) * 64 + F.lane] = a1;
        __syncthreads();
        if (F.wave == 0) { float s0 = 0.f, s1 = 0.f;
#pragma unroll
            for (int w = 0; w < 8; ++w) { s0 += red[(w * 2 + 0) * 64 + F.lane]; s1 += red[(w * 2 + 1) * 64 + F.lane]; }
            float* mod = (float*)(F.ws + WS_MOD); const float bb = F.in(I_BADA)[col]; mod[col] = s0 + bb; mod[6144 + col] = s1 + bb; }
        __syncthreads();
    }
    LAS float* scr = (LAS float*)(F.lds + F.wave * 16384);
    const int gw = F.vcu * NWAVES + F.wave, NGW = F.G * NWAVES;
    constexpr int I_IN = 16 * (NIN / 32), I_SQ = 16 * 32, I_EGU = 16 * 16, I_EDN = 4 * 32;
    constexpr int NITEMS = I_IN + 2 * I_SQ + NEX * I_EGU + NEX * I_EDN;
    for (int it = gw; it < NITEMS; it += NGW) {
        int r = it;
        if (r < I_IN) { transpose_item8<1>(F.in(I_WIN), 1024, NIN, (unsigned char*)(F.ws + WS_WIN), scr, r, F.lane); continue; } r -= I_IN;
        if (r < I_SQ) { transpose_item8<0>(F.in(I_WPW2), 1024, 1024, (unsigned char*)(F.ws + WS_WPW2), scr, r, F.lane); continue; } r -= I_SQ;
        if (r < I_SQ) { transpose_item<0>(F.in(I_WOUT), 1024, 1024, (bf16*)(F.ws + WS_WOUT), scr, r, F.lane); continue; } r -= I_SQ;
        if (r < NEX * I_EGU) { const int e = r / I_EGU, rr = r % I_EGU; const float* W = e < NE ? F.in(I_WEGU) + (size_t)e * 1024 * 512 : F.in(I_WSGU);
            transpose_item8<2>(W, 1024, 512, (unsigned char*)(F.ws + WS_WGU) + (size_t)e * 512 * 1024, scr, rr, F.lane); continue; } r -= NEX * I_EGU;
        { const int e = r / I_EDN, rr = r % I_EDN; const float* W = e < NE ? F.in(I_WEDN) + (size_t)e * 256 * 1024 : F.in(I_WSDN);
            transpose_item8<0>(W, 256, 1024, (unsigned char*)(F.ws + WS_WDN) + (size_t)e * 1024 * 256, scr, rr, F.lane, WDN_SCALE); }
    }
    {
        const float* wr = F.in(I_WR); bf16* wh = (bf16*)(F.ws + WS_WRH); bf16* wl = (bf16*)(F.ws + WS_WRL);
        for (int idx = F.vcu * NTHREADS + F.tid; idx < 64 * 1024; idx += F.G * NTHREADS) { const int e = idx >> 10, k = idx & 1023; const float w = wr[k * 64 + e];
            const unsigned h = cvt_pk_bf16(w, 0.f) & 0xffffu; const float r = w - bf_lo(h); wh[idx] = (bf16)h; wl[idx] = (bf16)(cvt_pk_bf16(r, 0.f) & 0xffffu); }
    }
    {
        const int* pos = (const int*)F.in(I_POS); float* rope = (float*)(F.ws + WS_ROPE);
        for (int idx = F.vcu * NTHREADS + F.tid; idx < T * 8; idx += F.G * NTHREADS) {
            const int tok = idx >> 3, i = idx & 7;
            const unsigned fb = i == 0 ? 1065353216u : i == 1 ? 1044812719u : i == 2 ? 1025116360u : i == 3 ? 1005516622u : i == 4 ? 985226530u : i == 5 ? 965724408u : i == 6 ? 945754309u : 925697960u;
            const float ang = (float)pos[tok] * __builtin_bit_cast(float, fb);
            double rv = (double)ang * 0.15915494309189535; rv -= floor(rv);
            const float fr_ = (float)rv;
            rope[tok * 16 + i] = __builtin_amdgcn_cosf(fr_); rope[tok * 16 + 8 + i] = __builtin_amdgcn_sinf(fr_);
        }
    }
}

__device__ __forceinline__ void phase1(Frame& F) {
    const float* mod = (const float*)(F.ws + WS_MOD); const float* gn = F.in(I_N1G); bf16* H = (bf16*)F.out;
    const int gw = F.vcu * NWAVES + F.wave, NGW = F.G * NWAVES;
    for (int m = gw; m < T; m += NGW) {
        const int b = m >> 14;
        const f32x4* xr = (const f32x4*)(F.in(I_X) + (size_t)m * D) + F.lane;
        f32x4 v[4]; float s = 0.f;
#pragma unroll
        for (int j = 0; j < 4; ++j) { v[j] = xr[64 * j]; s += (v[j].x * v[j].x + v[j].y * v[j].y) + (v[j].z * v[j].z + v[j].w * v[j].w); }
        const float rstd = __builtin_amdgcn_rsqf(wave_sum(s) * (1.f / D) + EPS);
        unsigned* o4 = (unsigned*)((unsigned char*)H + (size_t)m * D) + F.lane;
#pragma unroll
        for (int j = 0; j < 4; ++j) { const int col = 4 * F.lane + 256 * j;
            const f32x4 g = *(const f32x4*)(gn + col), sc = *(const f32x4*)(mod + b * 6144 + 1024 + col), sh = *(const f32x4*)(mod + b * 6144 + col);
            const f32x4 y = v[j] * rstd * g * (sc + 1.f) + sh;
            int w = 0; w = __builtin_amdgcn_cvt_pk_fp8_f32(y.x, y.y, w, false); w = __builtin_amdgcn_cvt_pk_fp8_f32(y.z, y.w, w, true); o4[64 * j] = (unsigned)w; }
    }
}

struct EpiIn {
    static constexpr bool PERM = true;
    static constexpr float SI = 1.f / WIN_SCALE;
    bf16 *U, *Q, *Kb, *V, *GC, *GA; const float* rope; const float* qg; const float* kg; LAS unsigned char* scr;
    __device__ __forceinline__ void operator()(const f32x4 (&acc)[2][2][4][2], const pg8::Unit& u, int wr, int wc, int fr, int fq) const {
        asm volatile("" : "+v"(fr), "+v"(fq));
        const int pn = u.pn, row0 = u.pm * 256 + wr * 64 + fr;
        if (pn < 8) {
#pragma unroll
            for (int ai = 0; ai < 2; ++ai)
#pragma unroll
                for (int m = 0; m < 4; ++m) { const int row = row0 + ai * 128 + m * 16; float r[8];
#pragma unroll
                    for (int n = 0; n < 2; ++n)
#pragma unroll
                        for (int i = 0; i < 4; ++i) r[4 * n + i] = (acc[ai][0][m][n][i] * SI) * sigmoidf_(acc[ai][1][m][n][i] * SI);
                    u32x4 w; w.x = cvt_pk_bf16(r[0], r[1]); w.y = cvt_pk_bf16(r[2], r[3]); w.z = cvt_pk_bf16(r[4], r[5]); w.w = cvt_pk_bf16(r[6], r[7]);
                    *(u32x4*)(U + (size_t)row * D + pn * 128 + wc * 32 + fq * 8) = w; }
        } else if (pn < 16) {
            const bool isq = pn < 12; const int g = 4 * ((pn - 8) & 3) + wc, h = g >> 1, mp = g & 1;
            const float* gp = isq ? qg : kg; float gn[2][8];
#pragma unroll
            for (int bj = 0; bj < 2; ++bj)
#pragma unroll
                for (int e = 0; e < 8; ++e) gn[bj][e] = gp[qk_dim(bj, fq, e)] * (isq ? C2 : 1.f);
            bf16* dst = isq ? Q : Kb;
#pragma unroll
            for (int ai = 0; ai < 2; ++ai)
#pragma unroll
                for (int m = 0; m < 4; ++m) { const int row = row0 + ai * 128 + m * 16, b = row >> 14, s = row & (SEQ - 1);
                    float v[2][8]; float ss = 0.f;
#pragma unroll
                    for (int bj = 0; bj < 2; ++bj)
#pragma unroll
                        for (int n = 0; n < 2; ++n)
#pragma unroll
                            for (int i = 0; i < 4; ++i) { const float t = acc[ai][bj][m][n][i] * SI; v[bj][4 * n + i] = t; ss += t * t; }
                    ss += __shfl_xor(ss, 16); ss += __shfl_xor(ss, 32);
                    const float rstd = __builtin_amdgcn_rsqf(ss * (1.f / 64.f) + EPS);
#pragma unroll
                    for (int bj = 0; bj < 2; ++bj)
#pragma unroll
                        for (int e = 0; e < 8; ++e) v[bj][e] = v[bj][e] * rstd * gn[bj][e];
                    if (fq == 0) { const f32x4* rp = (const f32x4*)(rope + (size_t)row * 16); const f32x4 c0 = rp[0], c1 = rp[1], s0 = rp[2], s1 = rp[3];
#pragma unroll
                        for (int e = 0; e < 8; ++e) { const float cs = e < 4 ? c0[e & 3] : c1[e & 3], sn = e < 4 ? s0[e & 3] : s1[e & 3]; const float x1 = v[0][e], x2 = v[1][e];
                            v[0][e] = x1 * cs - x2 * sn; v[1][e] = x2 * cs + x1 * sn; } }
                    unsigned char* rowp = (unsigned char*)dst + ((size_t)((b * 8 + h) * 2 + mp) * SEQ + s) * 64;
                    const int sw = isq ? 0 : ((s >> 2) & 3);
                    u32x4 w;
                    { int d;
                      d = 0; d = __builtin_amdgcn_cvt_pk_fp8_f32(v[0][0], v[0][1], d, false); d = __builtin_amdgcn_cvt_pk_fp8_f32(v[0][2], v[0][3], d, true); w.x = (unsigned)d;
                      d = 0; d = __builtin_amdgcn_cvt_pk_fp8_f32(v[0][4], v[0][5], d, false); d = __builtin_amdgcn_cvt_pk_fp8_f32(v[0][6], v[0][7], d, true); w.y = (unsigned)d;
                      d = 0; d = __builtin_amdgcn_cvt_pk_fp8_f32(v[1][0], v[1][1], d, false); d = __builtin_amdgcn_cvt_pk_fp8_f32(v[1][2], v[1][3], d, true); w.z = (unsigned)d;
                      d = 0; d = __builtin_amdgcn_cvt_pk_fp8_f32(v[1][4], v[1][5], d, false); d = __builtin_amdgcn_cvt_pk_fp8_f32(v[1][6], v[1][7], d, true); w.w = (unsigned)d; }
                    *(u32x4*)(rowp + ((fq ^ sw) << 4)) = w; }
        } else if (pn < 20) {
            LAS unsigned char* wsb = scr + (wr * 4 + wc) * 2048; const int lane_ = fr + 16 * fq;
#pragma unroll
            for (int ai = 0; ai < 2; ++ai)
#pragma unroll
                for (int bj = 0; bj < 2; ++bj) {
#pragma unroll
                    for (int m = 0; m < 4; ++m) { const int kk = 16 * m + fr;
                        const int p = 32 * ((kk >> 2) & 1) + 16 * (kk >> 5) + (kk & 3) + 4 * ((kk & 31) >> 3);
#pragma unroll
                        for (int n = 0; n < 2; ++n) { const unsigned d01 = (unsigned)__builtin_amdgcn_cvt_pk_fp8_f32(acc[ai][bj][m][n][0] * SI, acc[ai][bj][m][n][1] * SI, 0, false);
                            const unsigned d23 = (unsigned)__builtin_amdgcn_cvt_pk_fp8_f32(acc[ai][bj][m][n][2] * SI, acc[ai][bj][m][n][3] * SI, 0, false);
#pragma unroll
                            for (int i = 0; i < 4; ++i) { const int e = 4 * n + i; const unsigned byte = ((i < 2 ? d01 : d23) >> (8 * (i & 1)));
                                const int sw = (2 * fq + (e >> 2)) & 3;
                                wsb[(fq * 8 + e) * 64 + ((((p >> 4) ^ sw) << 4) | (p & 15))] = (unsigned char)byte; } } }
                    LDS_WAIT(); asm volatile("" ::: "memory");
                    const u32x4 t0 = *(const LAS u32x4*)(wsb + lane_ * 32), t1 = *(const LAS u32x4*)(wsb + lane_ * 32 + 16);
                    const int row = u.pm * 256 + ai * 128 + wr * 64, b = row >> 14, s = row & (SEQ - 1), h = 2 * (pn - 16) + bj;
                    unsigned char* tp = (unsigned char*)V + (((size_t)(b * 8 + h) * 256 + (s >> 6)) * 128 + wc * 32) * 64 + lane_ * 32;
                    *(u32x4*)tp = t0; *(u32x4*)(tp + 16) = t1;
                    LDS_WAIT(); asm volatile("" ::: "memory"); }
        } else {
            bf16* dst = pn < 24 ? GC : GA; const int colt = ((pn - 20) & 3) * 256;
#pragma unroll
            for (int ai = 0; ai < 2; ++ai)
#pragma unroll
                for (int m = 0; m < 4; ++m) { const int row = row0 + ai * 128 + m * 16;
#pragma unroll
                    for (int bj = 0; bj < 2; ++bj) { float r[8];
#pragma unroll
                        for (int n = 0; n < 2; ++n)
#pragma unroll
                            for (int i = 0; i < 4; ++i) r[4 * n + i] = sigmoidf_(acc[ai][bj][m][n][i] * SI);
                        u32x4 w; w.x = cvt_pk_bf16(r[0], r[1]); w.y = cvt_pk_bf16(r[2], r[3]); w.z = cvt_pk_bf16(r[4], r[5]); w.w = cvt_pk_bf16(r[6], r[7]);
                        *(u32x4*)(dst + (size_t)row * D + colt + bj * 128 + wc * 32 + fq * 8) = w; } }
        }
    }
};

__device__ __forceinline__ void phase3(Frame& F) {
    const bf16* U = (const bf16*)(F.ws + WS_U); bf16* CV = (bf16*)F.out;
    const int ch = 2 * F.tid;
    float wa[31], wb[31];
#pragma unroll
    for (int j = 0; j < 31; ++j) { const f32x2 w = *(const f32x2*)(F.in(I_CDW) + j * 1024 + ch); wa[j] = w.x; wb[j] = w.y; }
    const f32x2 cb = *(const f32x2*)(F.in(I_CDWB) + ch);
    LAS float* tile = (LAS float*)F.lds;
    for (int unit = F.vcu; unit < T / 64; unit += F.G) {
        const int t0 = unit * 64, s0 = t0 & (SEQ - 1);
        float xa[38], xb[38];
#pragma unroll
        for (int k = 0; k < 30; ++k) { unsigned v = 0u; if (s0 - 30 + k >= 0) v = *(const unsigned*)(U + (size_t)(t0 - 30 + k) * D + ch); xa[k] = bf_lo(v); xb[k] = bf_hi(v); }
        for (int blk = 0; blk < 8; ++blk) {
#pragma unroll
            for (int k = 0; k < 8; ++k) { const unsigned v = *(const unsigned*)(U + (size_t)(t0 + blk * 8 + k) * D + ch); xa[30 + k] = bf_lo(v); xb[30 + k] = bf_hi(v); }
            LAS float* tl = tile + (blk & 1) * 8192;
#pragma unroll
            for (int i = 0; i < 8; ++i) { float a = cb.x, b = cb.y;
#pragma unroll
                for (int j = 0; j < 31; ++j) { a += xa[i + j] * wa[j]; b += xb[i + j] * wb[j]; }
                *(LAS f32x2*)(tl + i * 1024 + ch) = (f32x2){a, b}; }
#pragma unroll
            for (int k = 0; k < 30; ++k) { xa[k] = xa[k + 8]; xb[k] = xb[k + 8]; }
            __syncthreads();
            {
                const LAS float* rowp = tl + F.wave * 1024;
                f32x4 v[4];
#pragma unroll
                for (int jj = 0; jj < 2; ++jj) { v[2 * jj] = *(const LAS f32x4*)(rowp + 512 * jj + 8 * F.lane); v[2 * jj + 1] = *(const LAS f32x4*)(rowp + 512 * jj + 8 * F.lane + 4); }
                float s = 0.f;
#pragma unroll
                for (int q = 0; q < 4; ++q) s += (v[q].x + v[q].y) + (v[q].z + v[q].w);
                const float mean = wave_sum(s) * (1.f / D); float s2 = 0.f;
#pragma unroll
                for (int q = 0; q < 4; ++q) { v[q] = v[q] - mean; s2 += (v[q].x * v[q].x + v[q].y * v[q].y) + (v[q].z * v[q].z + v[q].w * v[q].w); }
                const float rstd = __builtin_amdgcn_rsqf(wave_sum(s2) * (1.f / D) + EPS);
                bf16* op = (bf16*)((unsigned char*)CV + (size_t)(t0 + blk * 8 + F.wave) * D);
#pragma unroll
                for (int jj = 0; jj < 2; ++jj) { const int col = 512 * jj + 8 * F.lane; float r[8];
#pragma unroll
                    for (int q = 0; q < 2; ++q) { const f32x4 g = *(const f32x4*)(F.in(I_CLNG) + col + 4 * q), bb = *(const f32x4*)(F.in(I_CLNB) + col + 4 * q); const f32x4 y = v[2 * jj + q] * rstd * g + bb;
#pragma unroll
                        for (int i = 0; i < 4; ++i) r[4 * q + i] = y[i] * sigmoidf_(y[i]); }
                    int d0 = 0, d1 = 0;
                    d0 = __builtin_amdgcn_cvt_pk_fp8_f32(r[0], r[1], d0, false); d0 = __builtin_amdgcn_cvt_pk_fp8_f32(r[2], r[3], d0, true);
                    d1 = __builtin_amdgcn_cvt_pk_fp8_f32(r[4], r[5], d1, false); d1 = __builtin_amdgcn_cvt_pk_fp8_f32(r[6], r[7], d1, true);
                    *(u32x2*)((unsigned char*)op + col) = (u32x2){(unsigned)d0, (unsigned)d1}; }
            }
        }
        __syncthreads();
    }
}

struct EpiPw2 {
    static constexpr bool PERM = true;
    bf16* O; const bf16* GC; const float* bias;
    __device__ __forceinline__ void operator()(const f32x4 (&acc)[2][2][4][2], const pg8::Unit& u, int wr, int wc, int fr, int fq) const {
        const int row0 = u.pm * 256 + wr * 64 + fr, col0 = u.pn * 256 + wc * 32 + fq * 8;
#pragma unroll
        for (int ai = 0; ai < 2; ++ai)
#pragma unroll
            for (int m = 0; m < 4; ++m) { const int row = row0 + ai * 128 + m * 16;
#pragma unroll
                for (int bj = 0; bj < 2; ++bj) { const int col = col0 + bj * 128; const u32x4 gv = *(const u32x4*)(GC + (size_t)row * D + col);
                    const f32x4 b0 = *(const f32x4*)(bias + col), b1 = *(const f32x4*)(bias + col + 4); float r[8];
#pragma unroll
                    for (int i = 0; i < 4; ++i) { r[i] = acc[ai][bj][m][0][i] * (1.f / WIN_SCALE) + b0[i]; r[4 + i] = acc[ai][bj][m][1][i] * (1.f / WIN_SCALE) + b1[i]; }
                    r[0] *= bf_lo(gv.x); r[1] *= bf_hi(gv.x); r[2] *= bf_lo(gv.y); r[3] *= bf_hi(gv.y); r[4] *= bf_lo(gv.z); r[5] *= bf_hi(gv.z); r[6] *= bf_lo(gv.w); r[7] *= bf_hi(gv.w);
                    u32x4 w; w.x = cvt_pk_bf16(r[0], r[1]); w.y = cvt_pk_bf16(r[2], r[3]); w.z = cvt_pk_bf16(r[4], r[5]); w.w = cvt_pk_bf16(r[6], r[7]);
                    *(u32x4*)(O + (size_t)row * D + col) = w; } }
    }
};

namespace att {
constexpr int SLOT = 32768, NSLOT = 3, XOFF = NSLOT * SLOT;
typedef int i32x8 __attribute__((ext_vector_type(8)));
__device__ __forceinline__ int crow(int r, int hi) { return (r & 3) + 8 * (r >> 2) + 4 * hi; }
__device__ __forceinline__ s16x4 vtr(const LAS char* p) { typedef short v4i16_t __attribute__((ext_vector_type(4))); return __builtin_bit_cast(s16x4, __builtin_amdgcn_ds_read_tr16_b64_v4i16((LAS v4i16_t*)p)); }
#define BUF_DMA16(m0v, voff, srd, soff) asm volatile("s_mov_b32 m0, %0\n\ts_nop 0\n\tbuffer_load_dwordx4 %1, %2, %3 offen lds" :: "s"(m0v), "v"(voff), "s"(srd), "s"(soff) : "m0", "memory")
#define ATT_SB() __builtin_amdgcn_sched_barrier(0)
#ifndef VLA
#define VLA 4
#endif
struct DmaSet { unsigned m0[2], so[2]; };
__device__ __forceinline__ f32x16 zacc() { return (f32x16){0.f, 0.f, 0.f, 0.f, 0.f, 0.f, 0.f, 0.f, 0.f, 0.f, 0.f, 0.f, 0.f, 0.f, 0.f, 0.f}; }
__device__ __forceinline__ f32x16 mfma8(i32x8 a, i32x8 b, f32x16 c) { return __builtin_amdgcn_mfma_scale_f32_32x32x64_f8f6f4(a, b, c, 0, 0, 0, 0, 0, 0); }
#define ATT_KFRAG(kp, blk) ({ const u32x4 lo_ = *(const LAS u32x4*)((kp) + (blk) * 2048 + kc0), hi_ = *(const LAS u32x4*)((kp) + (blk) * 2048 + kc1); \
        (i32x8){(int)lo_.x, (int)lo_.y, (int)lo_.z, (int)lo_.w, (int)hi_.x, (int)hi_.y, (int)hi_.z, (int)hi_.w}; })
template <bool MASK>
__device__ __forceinline__ void shift_mask(f32x16& c0, f32x16& c1, int kb, int qrow, float negM, bool shift) {
    if (shift) {
#pragma unroll
        for (int r = 0; r < 16; ++r) { c0[r] += negM; c1[r] += negM; } }
    if (MASK) {
#pragma unroll
        for (int r = 0; r < 16; ++r) { const int kv = kb + (r & 3) + 8 * (r >> 2); if (kv > qrow) c0[r] = -INFINITY; if (kv + 32 > qrow) c1[r] = -INFINITY; } }
}
#define ATT_VFRAG(dst, i) do { const s16x4 lo_ = vtr(vp + ((i) & 3) * 4096 + ((i) >> 2) * 1024), hh_ = vtr(vp + ((i) & 3) * 4096 + ((i) >> 2) * 1024 + 512); \
        dst = (bf16x8){lo_[0], lo_[1], lo_[2], lo_[3], hh_[0], hh_[1], hh_[2], hh_[3]}; } while (0)
__device__ __forceinline__ void pack8(i32x8& pf, const f32x16& p0, const f32x16& p1, int d) {
    const f32x16& P = d < 4 ? p0 : p1; const int e = 4 * (d & 3);
    typedef __fp16 h2_t __attribute__((ext_vector_type(2)));
    const h2_t x = __builtin_amdgcn_cvt_pkrtz(P[e], P[e + 1]), y = __builtin_amdgcn_cvt_pkrtz(P[e + 2], P[e + 3]);
    pf[d] = (int)__builtin_amdgcn_perm(__builtin_bit_cast(unsigned, y), __builtin_bit_cast(unsigned, x), 0x07050301u);
}
__device__ __forceinline__ f32x16 mfma_pv(i32x8 p, i32x8 v, f32x16 c) { return __builtin_amdgcn_mfma_scale_f32_32x32x64_f8f6f4(p, v, c, 1, 0, 0, 0, 0, 0); }
__device__ __forceinline__ void att_step(bool MASK, f32x16 (&o)[4], f32x16& c0, f32x16& c1, f32x16& p0, f32x16& p1, i32x8 (&kf)[2], const i32x8& qf, f32x16& lacc, const i32x8& ones, i32x8& pf,
                                         const LAS char* vp, const LAS char* kpn, int kc0, int kc1, int kb, int qrow,
                                         const DmaSet& dm, unsigned vdma, __amdgpu_buffer_rsrc_t srdK, __amdgpu_buffer_rsrc_t srdV) {
    i32x8 vf[4];
#pragma unroll
    for (int h2 = 0; h2 < 2; ++h2) {
        if (h2 == 0) c0 = mfma8(kf[0], qf, zacc()); else c1 = mfma8(kf[1], qf, zacc());
        const f32x16& P = h2 == 0 ? p0 : p1;
        vf[2 * h2] = ATT_KFRAG(vp, 2 * h2); vf[2 * h2 + 1] = ATT_KFRAG(vp, 2 * h2 + 1);
#pragma unroll
        for (int g = 0; g < 4; ++g) { const int e = 4 * g;
            pack8(pf, p0, p1, 4 * h2 + g);
            int w_ = pf[4 * h2 + g]; asm volatile("" : "+v"(w_)); pf[4 * h2 + g] = w_;
            if (g == 3) BUF_DMA16(dm.m0[h2], vdma, h2 == 0 ? srdK : srdV, dm.so[h2]);
        }
        ATT_SB();
    }
    if (MASK) {
#pragma unroll
        for (int r = 0; r < 16; ++r) { const int kv = kb + (r & 3) + 8 * (r >> 2); if (kv > qrow) c0[r] = -INFINITY; if (kv + 32 > qrow) c1[r] = -INFINITY; } }
    ATT_SB();
#pragma unroll
    for (int i = 0; i < 4; ++i) {
        if (i == 1) kf[0] = ATT_KFRAG(kpn, 0);
        if (i == 2) kf[1] = ATT_KFRAG(kpn, 1);
        o[i] = mfma_pv(pf, vf[i], o[i]);
        if (i == 3) lacc = mfma_pv(pf, ones, lacc);
#pragma unroll
        for (int x = 0; x < 8; ++x) { const int idx = 8 * i + x; float e0 = __builtin_amdgcn_exp2f(idx < 16 ? c0[idx] : c1[idx - 16]);
            asm volatile("" : "+v"(e0));
            if (idx < 16) c0[idx] = e0; else c1[idx - 16] = e0; }
        ATT_SB();
    }
}
__device__ __forceinline__ void att_drain(f32x16 (&o)[4], const f32x16& p0, const f32x16& p1, f32x16& lacc, const i32x8& ones, const LAS char* vp, int kc0, int kc1) {
    i32x8 pf = {0, 0, 0, 0, 0, 0, 0, 0};
#pragma unroll
    for (int d = 0; d < 8; ++d) pack8(pf, p0, p1, d);
#pragma unroll
    for (int i = 0; i < 4; ++i) { const i32x8 f = ATT_KFRAG(vp, i); o[i] = mfma_pv(pf, f, o[i]); }
    lacc = mfma_pv(pf, ones, lacc);
}

__device__ __forceinline__ void phase5(Frame& F, bf16* MGout) {
    const bf16* GA = (const bf16*)(F.ws + WS_GA); bf16* MG = (bf16*)(F.ws + WS_U);
    const int lane = F.lane, r32 = lane & 31, hi = lane >> 5, wid = F.wave, rg = wid & 3, mp = wid >> 2;
    float lam;
    {
        const float q1 = F.in(I_LQ1)[lane], k1 = F.in(I_LK1)[lane], q2 = F.in(I_LQ2)[lane], k2 = F.in(I_LK2)[lane];
        lam = __expf(wave_sum(q1 * k1)) - __expf(wave_sum(q2 * k2)) + LAMBDA_INIT;
    }
    const i32x8 ones = {0x38383838, 0x38383838, 0x38383838, 0x38383838, 0x38383838, 0x38383838, 0x38383838, 0x38383838};
    LAS char* ring = (LAS char*)F.lds;
    const unsigned ring0 = (unsigned)(size_t)ring;
    const int voff = r32 * 64;
    const int ksw = (r32 >> 2) & 3;
    const int koff = r32 * 64 + mp * 4096, kc0 = ((2 * hi) ^ ksw) << 4, kc1 = ((2 * hi + 1) ^ ksw) << 4;
    const __amdgpu_buffer_rsrc_t srdK = __builtin_amdgcn_make_buffer_rsrc((void*)(F.ws + WS_K), (short)0, 64 << 20, 0x00020000);
    const __amdgpu_buffer_rsrc_t srdV = __builtin_amdgcn_make_buffer_rsrc((void*)(F.ws + WS_V), (short)0, 64 << 20, 0x00020000);
    const __amdgpu_buffer_rsrc_t srdQ = __builtin_amdgcn_make_buffer_rsrc((void*)(F.ws + WS_Q), (short)0, 64 << 20, 0x00020000);
    const unsigned vdma = (unsigned)(wid * 1024 + lane * 16);
    const unsigned vdmk = (unsigned)((wid & 3) * 1024 + lane * 16);
    const unsigned vq = (unsigned)(r32 * 64 + hi * 32);
    if (wid >= 4) __builtin_amdgcn_s_setprio(1);
#ifndef DBG_ATT2
#define DBG_ATT2 0
#endif
    for (int p_ = F.vcu; p_ < (DBG_ATT2 ? 2048 : 1024); p_ += F.G) {
        const int p = p_ & 1023; bf16* const MGo = (DBG_ATT2 && p_ < 1024) ? (bf16*)F.out : MGout;
        const int bh = p >> 6, j = p & 63;
        for (int half = 0; half < 2; ++half) {
            const int qt = half == 0 ? j : 127 - j;
            const int NT = 2 * (qt + 1);
            const unsigned kxoff = (unsigned)(bh * 2 + (wid >> 2)) * (SEQ * 64u), voffg = (unsigned)bh * (256u * 8192u);
#define ATT_ISSUE_K(tk_, dst_) do { const unsigned tk__ = (unsigned)((tk_) < NT ? (tk_) : NT - 1) * 4096u; BUF_DMA16(ring0 + (dst_) + wid * 1024, vdmk, srdK, kxoff + tk__); } while (0)
#define ATT_ISSUE_V(tv_, dst_) do { const unsigned tv__ = voffg + (unsigned)((tv_) < NT ? (tv_) : NT - 1) * 8192u; BUF_DMA16(ring0 + (dst_) + wid * 1024, vdma, srdV, tv__); } while (0)
            u32x4 q0, q1;
            { const unsigned qs = ((unsigned)(bh * 2 + mp) * SEQ + (unsigned)(qt * 128 + rg * 32)) * 64u;
              asm volatile("buffer_load_dwordx4 %0, %2, %3, %4 offen\n\tbuffer_load_dwordx4 %1, %2, %3, %4 offen offset:16"
                           : "=&v"(q0), "=&v"(q1) : "v"(vq), "s"(srdQ), "s"(qs) : "memory"); }
            ATT_ISSUE_K(0, XOFF); ATT_ISSUE_K(1, XOFF + 16384);
            ATT_ISSUE_K(2, 0); ATT_ISSUE_V(0, 16384);
            ATT_ISSUE_K(3, SLOT); ATT_ISSUE_V(1, SLOT + 16384);
            asm volatile("s_waitcnt vmcnt(4)\n\ts_barrier" : "+v"(q0), "+v"(q1) :: "memory");
            const i32x8 qf = {(int)q0.x, (int)q0.y, (int)q0.z, (int)q0.w, (int)q1.x, (int)q1.y, (int)q1.z, (int)q1.w};
            f32x16 o[4];
#pragma unroll
            for (int vb = 0; vb < 4; ++vb)
#pragma unroll
                for (int r = 0; r < 16; ++r) o[vb][r] = 0.f;
            f32x16 lacc = zacc();
            const int qrow = qt * 128 + rg * 32 + r32;
            f32x16 pA0, pA1, pB0, pB1; i32x8 kf[2]; i32x8 pfr = {0, 0, 0, 0, 0, 0, 0, 0};
            { const LAS char* kp0 = ring + XOFF + koff; const f32x16 z = {0.f, 0.f, 0.f, 0.f, 0.f, 0.f, 0.f, 0.f, 0.f, 0.f, 0.f, 0.f, 0.f, 0.f, 0.f, 0.f};
              kf[0] = ATT_KFRAG(kp0, 0); kf[1] = ATT_KFRAG(kp0, 1);
              (void)z; pA0 = mfma8(kf[0], qf, zacc()); pA1 = mfma8(kf[1], qf, zacc()); }
            if (NT == 2) shift_mask<true>(pA0, pA1, 4 * hi, qrow, 0.f, false);
#pragma unroll
            for (int r = 0; r < 16; ++r) { pA0[r] = __builtin_amdgcn_exp2f(pA0[r]); pA1[r] = __builtin_amdgcn_exp2f(pA1[r]); }
            { const LAS char* kp1 = ring + XOFF + 16384 + koff; kf[0] = ATT_KFRAG(kp1, 0); kf[1] = ATT_KFRAG(kp1, 1); }
            unsigned sl_use = 0, sl_mid = SLOT, sl_new = 2 * SLOT;
#define ATT_STEP(MASKED, C0, C1, P0, P1, t_) do { asm volatile("s_waitcnt vmcnt(2) lgkmcnt(0)\n\ts_barrier" ::: "memory"); \
                DmaSet dm; { const unsigned tk__ = (unsigned)(((t_) + 3) < NT ? ((t_) + 3) : NT - 1) * 4096u, tv__ = voffg + (unsigned)(((t_) + 1) < NT ? ((t_) + 1) : NT - 1) * 8192u, d__ = ring0 + sl_new + wid * 1024; \
                    dm.m0[0] = d__; dm.m0[1] = d__ + 16384u; dm.so[0] = kxoff + tk__ - (unsigned)(wid >> 2) * 4096u; dm.so[1] = tv__; }   \
                { const LAS char* vp = ring + sl_use + 16384 + voff; const LAS char* kpn = ring + sl_use + koff; \
                  att_step(MASKED, o, C0, C1, P0, P1, kf, qf, lacc, ones, pfr, vp, kpn, kc0, kc1, 64 * (t_) + 4 * hi, qrow, dm, vdma, srdK, srdV); } \
                { const unsigned t__ = sl_use; sl_use = sl_mid; sl_mid = sl_new; sl_new = t__; } } while (0)
            int t = 1;
            for (; t + 1 < NT; t += 2) { ATT_STEP(false, pB0, pB1, pA0, pA1, t); ATT_STEP((t + 1 >= NT - 2), pA0, pA1, pB0, pB1, t + 1); }
            ATT_STEP(true, pB0, pB1, pA0, pA1, NT - 1);
            asm volatile("s_waitcnt vmcnt(0) lgkmcnt(0)\n\ts_barrier" ::: "memory");
            att_drain(o, pB0, pB1, lacc, ones, ring + sl_use + 16384 + voff, kc0, kc1);
#undef ATT_STEP
#undef ATT_ISSUE_K
#undef ATT_ISSUE_V
            float rl[16];
#pragma unroll
            for (int r = 0; r < 16; ++r) rl[r] = __builtin_amdgcn_rcpf(lacc[r]);
            asm volatile("s_waitcnt vmcnt(0) lgkmcnt(0)\n\ts_barrier" ::: "memory");
            LAS float* xch = (LAS float*)ring + rg * 4096;
            if (mp == 1) {
#pragma unroll
                for (int vb = 0; vb < 4; ++vb)
#pragma unroll
                    for (int r = 0; r < 16; ++r) xch[(vb * 16 + r) * 64 + lane] = o[vb][r] * rl[r] * lam;
            }
            asm volatile("s_waitcnt lgkmcnt(0)\n\ts_barrier" ::: "memory");
            if (mp == 0) {
                float ssq[16];
#pragma unroll
                for (int r = 0; r < 16; ++r) ssq[r] = 0.f;
#pragma unroll
                for (int vb = 0; vb < 4; ++vb)
#pragma unroll
                    for (int r = 0; r < 16; ++r) { const float d = o[vb][r] * rl[r] - xch[(vb * 16 + r) * 64 + lane]; o[vb][r] = d; ssq[r] += d * d; }
#pragma unroll
                for (int r = 0; r < 16; ++r) { float s = ssq[r];
#pragma unroll
                    for (int off = 1; off < 32; off <<= 1) s += __shfl_xor(s, off);
                    ssq[r] = __builtin_amdgcn_rsqf(s * (1.f / 128.f) + EPS) * (1.f - LAMBDA_INIT); }
#pragma unroll
                for (int vb = 0; vb < 4; ++vb)
#pragma unroll
                    for (int r = 0; r < 16; ++r) xch[(vb * 16 + r) * 64 + lane] = o[vb][r] * ssq[r];
            }
            asm volatile("s_waitcnt lgkmcnt(0)\n\ts_barrier" ::: "memory");
            {
                const int b = bh >> 3, h = bh & 7, q = F.tid >> 2, vb = F.tid & 3, q5 = q & 31;
                const int rr = (q5 & 3) + 4 * (q5 >> 3), hh = (q5 >> 2) & 1;
                const LAS float* src = (const LAS float*)ring + (q >> 5) * 4096 + (vb * 16 + rr) * 64 + hh * 32;
                const size_t idx = ((size_t)b * SEQ + qt * 128 + q) * D + h * 128 + vb * 32;
                const float* sgp = F.in(I_SUBG) + vb * 32; asm volatile("" : "+v"(sgp));
#pragma unroll
                for (int c8 = 0; c8 < 4; ++c8) { const f32x4 y0 = *(const LAS f32x4*)(src + c8 * 8), y1 = *(const LAS f32x4*)(src + c8 * 8 + 4);
                    const f32x4 g0 = *(const f32x4*)(sgp + c8 * 8), g1 = *(const f32x4*)(sgp + c8 * 8 + 4);
                    const u32x4 ga = *(const u32x4*)(GA + idx + c8 * 8), mc = *(const u32x4*)(MG + idx + c8 * 8);
                    u32x4 w;
                    w.x = cvt_pk_bf16(y0[0] * g0[0] * bf_lo(ga.x) + bf_lo(mc.x), y0[1] * g0[1] * bf_hi(ga.x) + bf_hi(mc.x));
                    w.y = cvt_pk_bf16(y0[2] * g0[2] * bf_lo(ga.y) + bf_lo(mc.y), y0[3] * g0[3] * bf_hi(ga.y) + bf_hi(mc.y));
                    w.z = cvt_pk_bf16(y1[0] * g1[0] * bf_lo(ga.z) + bf_lo(mc.z), y1[1] * g1[1] * bf_hi(ga.z) + bf_hi(mc.z));
                    w.w = cvt_pk_bf16(y1[2] * g1[2] * bf_lo(ga.w) + bf_lo(mc.w), y1[3] * g1[3] * bf_hi(ga.w) + bf_hi(mc.w));
                    *(u32x4*)(MGo + idx + c8 * 8) = w; }
            }
            asm volatile("s_waitcnt vmcnt(0) lgkmcnt(0)\n\ts_barrier" ::: "memory");
        }
    }
    __builtin_amdgcn_s_setprio(0);
}
}

struct EpiOut {
    static constexpr bool PERM = true;
    const float* X; float* O; const float* mod;
    __device__ __forceinline__ void operator()(const f32x4 (&acc)[2][2][4][2], const pg8::Unit& u, int wr, int wc, int fr, int fq) const {
        const int row0 = u.pm * 256 + wr * 64 + fr, col0 = u.pn * 256 + wc * 32 + fq * 8;
#pragma unroll
        for (int ai = 0; ai < 2; ++ai)
#pragma unroll
            for (int m = 0; m < 4; ++m) { const int row = row0 + ai * 128 + m * 16, b = row >> 14;
#pragma unroll
                for (int bj = 0; bj < 2; ++bj)
#pragma unroll
                    for (int n = 0; n < 2; ++n) { const int col = col0 + bj * 128 + 4 * n; const f32x4 g = *(const f32x4*)(mod + b * 6144 + 2048 + col), xv = *(const f32x4*)(X + (size_t)row * D + col);
                        *(f32x4*)(O + (size_t)row * D + col) = xv + g * acc[ai][bj][m][n]; } }
    }
};

__device__ __forceinline__ void phase7(Frame& F) {
    const float* X1 = F.out; const float* mod = (const float*)(F.ws + WS_MOD); const float* gn = F.in(I_N2G); bf16* H2 = (bf16*)(F.ws + WS_U);
    constexpr int PITCH = 272;
    LAS char* Ahi = (LAS char*)F.lds;
    LAS char* Alo = Ahi + 128 * PITCH;
    LAS char* Whi = Alo + 128 * PITCH;
    LAS char* Wlo = Whi + 64 * PITCH;
    LAS float* RS = (LAS float*)(F.lds + 104448);
    LAS int* CW = (LAS int*)(F.lds + 104960);
    LAS unsigned char* RK = (LAS unsigned char*)(F.lds + 105472);
    LAS float* LG = (LAS float*)F.lds;
    const int tid = F.tid, lane = F.lane, wid = F.wave, r32 = lane & 31, hi = lane >> 5;
    const bf16* WRH = (const bf16*)(F.ws + WS_WRH); const bf16* WRL = (const bf16*)(F.ws + WS_WRL);
    for (int chunk = F.vcu; chunk < T / 128; chunk += F.G) {
        const int t0 = chunk * 128, b = t0 >> 14;
        for (int i4 = 0; i4 < 16; i4 += 4) {
            f32x4 v[4][4]; float ss[4];
#pragma unroll
            for (int u = 0; u < 4; ++u) { const f32x4* xr = (const f32x4*)(X1 + (size_t)(t0 + wid * 16 + i4 + u) * D) + lane;
#pragma unroll
                for (int j = 0; j < 4; ++j) v[u][j] = xr[64 * j]; }
#pragma unroll
            for (int u = 0; u < 4; ++u) { float s = 0.f;
#pragma unroll
                for (int j = 0; j < 4; ++j) s += (v[u][j].x * v[u][j].x + v[u][j].y * v[u][j].y) + (v[u][j].z * v[u][j].z + v[u][j].w * v[u][j].w);
                ss[u] = s; }
#pragma unroll
            for (int o_ = 1; o_ < 64; o_ <<= 1) {
#pragma unroll
                for (int u = 0; u < 4; ++u) ss[u] += __shfl_xor(ss[u], o_); }
#pragma unroll
            for (int u = 0; u < 4; ++u) { const int m = t0 + wid * 16 + i4 + u; const float rstd = __builtin_amdgcn_rsqf(ss[u] * (1.f / D) + EPS);
                if (lane == 0) RS[wid * 16 + i4 + u] = rstd;
                unsigned* o4 = (unsigned*)((unsigned char*)H2 + (size_t)m * D) + lane;
#pragma unroll
                for (int j = 0; j < 4; ++j) { const int col = 4 * lane + 256 * j;
                    const f32x4 g = *(const f32x4*)(gn + col), sc = *(const f32x4*)(mod + b * 6144 + 4096 + col), sh = *(const f32x4*)(mod + b * 6144 + 3072 + col);
                    const f32x4 y = v[u][j] * rstd * g * (sc + 1.f) + sh;
                    int w = 0; w = __builtin_amdgcn_cvt_pk_fp8_f32(y.x, y.y, w, false); w = __builtin_amdgcn_cvt_pk_fp8_f32(y.z, y.w, w, true); o4[64 * j] = (unsigned)w; } } }
        __syncthreads();
        f32x16 c;
#pragma unroll
        for (int r = 0; r < 16; ++r) c[r] = 0.f;
        const int tb = wid & 3, eb = wid >> 2;
        for (int ks = 0; ks < 8; ++ks) {
            { const int row = tid & 127, seg = tid >> 7; const float rstd = RS[row];
              const float* xp = X1 + (size_t)(t0 + row) * D + ks * 128 + seg * 32;
              unsigned wh[16], wl[16];
#pragma unroll
              for (int q = 0; q < 8; ++q) { const int col = ks * 128 + seg * 32 + 4 * q; const f32x4 xv = *(const f32x4*)(xp + 4 * q);
                  const f32x4 g = *(const f32x4*)(gn + col), sc = *(const f32x4*)(mod + b * 6144 + 4096 + col), sh = *(const f32x4*)(mod + b * 6144 + 3072 + col);
                  const f32x4 y = xv * rstd * g * (sc + 1.f) + sh;
                  const unsigned h0 = cvt_pk_bf16(y.x, y.y), h1 = cvt_pk_bf16(y.z, y.w);
                  wh[2 * q] = h0; wh[2 * q + 1] = h1;
                  wl[2 * q] = cvt_pk_bf16(y.x - bf_lo(h0), y.y - bf_hi(h0)); wl[2 * q + 1] = cvt_pk_bf16(y.z - bf_lo(h1), y.w - bf_hi(h1)); }
#pragma unroll
              for (int q = 0; q < 4; ++q) { *(LAS u32x4*)(Ahi + row * PITCH + seg * 64 + q * 16) = (u32x4){wh[4 * q], wh[4 * q + 1], wh[4 * q + 2], wh[4 * q + 3]};
                  *(LAS u32x4*)(Alo + row * PITCH + seg * 64 + q * 16) = (u32x4){wl[4 * q], wl[4 * q + 1], wl[4 * q + 2], wl[4 * q + 3]}; }
#pragma unroll
              for (int q = 0; q < 2; ++q) { const int cc = tid + 512 * q, e = cc >> 4, kc = cc & 15;
                  *(LAS u32x4*)(Whi + e * PITCH + kc * 16) = *(const u32x4*)(WRH + e * 1024 + ks * 128 + kc * 8);
                  *(LAS u32x4*)(Wlo + e * PITCH + kc * 16) = *(const u32x4*)(WRL + e * 1024 + ks * 128 + kc * 8); } }
            __syncthreads();
#pragma unroll
            for (int st = 0; st < 8; ++st) { const int ao = (tb * 32 + r32) * PITCH + (2 * st + hi) * 16, bo = (eb * 32 + r32) * PITCH + (2 * st + hi) * 16;
                const bf16x8 ah = *(const LAS bf16x8*)(Ahi + ao), al = *(const LAS bf16x8*)(Alo + ao), bh = *(const LAS bf16x8*)(Whi + bo), bl = *(const LAS bf16x8*)(Wlo + bo);
                c = __builtin_amdgcn_mfma_f32_32x32x16_bf16(ah, bh, c, 0, 0, 0); c = __builtin_amdgcn_mfma_f32_32x32x16_bf16(ah, bl, c, 0, 0, 0); c = __builtin_amdgcn_mfma_f32_32x32x16_bf16(al, bh, c, 0, 0, 0); }
            __syncthreads();
        }
#pragma unroll
        for (int r = 0; r < 16; ++r) LG[(tb * 32 + att::crow(r, hi)) * 65 + eb * 32 + r32] = c[r];
        __syncthreads();
        unsigned long long chosen = 0ull; int ek[8]; float sk[8];
        if (tid < 128) {
            LAS float* L = LG + tid * 65;
            float gs[8];
#pragma unroll
            for (int g = 0; g < 8; ++g) { float m1 = -INFINITY, m2 = -INFINITY;
#pragma unroll
                for (int jx = 0; jx < 8; ++jx) { const float sc = sigmoidf_(L[g * 8 + jx]); const float ch = sc + F.in(I_RB)[g * 8 + jx]; L[g * 8 + jx] = ch;
                    if (ch > m1) { m2 = m1; m1 = ch; } else if (ch > m2) m2 = ch; }
                gs[g] = m1 + m2; }
            unsigned gm = 0u;
#pragma unroll
            for (int it = 0; it < 4; ++it) { float best = -INFINITY; int bi = 0;
#pragma unroll
                for (int g = 0; g < 8; ++g) { const bool ok = !((gm >> g) & 1u) && gs[g] > best; best = ok ? gs[g] : best; bi = ok ? g : bi; }
                gm |= 1u << bi; }
            int gsel[4]; float cand[32];
            { unsigned m = gm;
#pragma unroll
              for (int sx = 0; sx < 4; ++sx) { const int g = __builtin_ctz(m); m &= m - 1u; gsel[sx] = g;
#pragma unroll
                  for (int jx = 0; jx < 8; ++jx) cand[sx * 8 + jx] = L[g * 8 + jx]; } }
            float ssum = 0.f;
#pragma unroll
            for (int it = 0; it < 8; ++it) { float best = -INFINITY; int bi = 0;
#pragma unroll
                for (int i = 0; i < 32; ++i) { const bool ok = cand[i] > best; best = ok ? cand[i] : best; bi = ok ? i : bi; }
#pragma unroll
                for (int i = 0; i < 32; ++i) cand[i] = (i == bi) ? -INFINITY : cand[i];
                const int sx = bi >> 3; const int g = sx == 0 ? gsel[0] : sx == 1 ? gsel[1] : sx == 2 ? gsel[2] : gsel[3]; const int e = g * 8 + (bi & 7);
                chosen |= 1ull << e; ek[it] = e; const float sc = best - F.in(I_RB)[e]; sk[it] = sc; ssum += sc; }
            const float inv = 2.5f / ssum;
#pragma unroll
            for (int it = 0; it < 8; ++it) sk[it] *= inv;
        }
        if (wid < 2) {
            for (int e = 0; e < 64; ++e) { const bool f = (chosen >> e) & 1ull; const unsigned long long bm = __ballot(f);
                const int rk = __popcll(bm & ((1ull << lane) - 1ull));
                if (f) RK[tid * 64 + e] = (unsigned char)rk;
                if (lane == 0) CW[wid * 64 + e] = __popcll(bm); }
        }
        __syncthreads();
        if (tid < 128) {
            int* tke = (int*)(F.ws + WS_TKE) + (size_t)(t0 + tid) * 8; int* tkr = (int*)(F.ws + WS_TKR) + (size_t)(t0 + tid) * 8; float* tkw = (float*)(F.ws + WS_TKW) + (size_t)(t0 + tid) * 8;
#pragma unroll
            for (int it = 0; it < 8; ++it) { const int e = ek[it]; tke[it] = e; tkr[it] = (int)RK[tid * 64 + e] + (wid == 1 ? CW[e] : 0); tkw[it] = sk[it]; }
        }
        if (tid < 64) ((int*)(F.ws + WS_CNT))[chunk * 64 + tid] = CW[tid] + CW[64 + tid];
        __syncthreads();
    }
}

__device__ __forceinline__ void phase8(Frame& F) {
    const int* CNT = (const int*)(F.ws + WS_CNT); int* TOK = (int*)(F.ws + WS_TOK); float* WGT = (float*)(F.ws + WS_WGT); int* POS = (int*)(F.ws + WS_POS);
    LAS int* part = (LAS int*)F.lds;
    LAS int* tot = part + 1024;
    LAS int* below = tot + 64;
    LAS int* ebase = below + 64;
    const int tid = F.tid;
    for (int chunk = F.vcu; chunk < T / 128; chunk += F.G) {
        { const int e = tid & 63, pr = tid >> 6; int s = 0, sb = 0;
          for (int c = pr * 32; c < pr * 32 + 32; ++c) { const int v = CNT[c * 64 + e]; s += v; sb += c < chunk ? v : 0; }
          part[(pr * 2 + 0) * 64 + e] = s; part[(pr * 2 + 1) * 64 + e] = sb; }
        __syncthreads();
        if (tid < 64) { int s = 0, sb = 0;
#pragma unroll
            for (int pr = 0; pr < 8; ++pr) { s += part[(pr * 2 + 0) * 64 + tid]; sb += part[(pr * 2 + 1) * 64 + tid]; }
            tot[tid] = s; below[tid] = sb; }
        __syncthreads();
        if (tid == 0) { int a = 0; for (int e = 0; e < 64; ++e) { ebase[e] = a; a += (tot[e] + 255) & ~255; } ebase[64] = a; }
        __syncthreads();
        if (tid < 128) { const int tokn = chunk * 128 + tid;
            const int* tke = (const int*)(F.ws + WS_TKE) + (size_t)tokn * 8; const int* tkr = (const int*)(F.ws + WS_TKR) + (size_t)tokn * 8; const float* tkw = (const float*)(F.ws + WS_TKW) + (size_t)tokn * 8;
#pragma unroll
            for (int k = 0; k < 8; ++k) { const int e = tke[k]; const int pos = ebase[e] + below[e] + tkr[k]; TOK[pos] = tokn; WGT[pos] = tkw[k]; POS[tokn * 8 + k] = pos; } }
        const int RTOT = ebase[64];
        if (chunk < 64) { const int e = chunk; for (int p = ebase[e] + tot[e] + tid; p < ebase[e + 1]; p += NTHREADS) { TOK[p] = -1; WGT[p] = 0.f; } }
        { const int tokn = chunk * 128 + (tid & 127); if (tid < 128) { TOK[RTOT + tokn] = tokn; WGT[RTOT + tokn] = 1.f; } }
        if (chunk == 0) { int* TE = (int*)(F.ws + WS_TE); const int NTR = RTOT >> 8;
            for (int pm = tid; pm < NTR + 128; pm += NTHREADS) { int e = 64; if (pm < NTR) { e = 0; for (int x = 1; x < 64; ++x) e = (pm * 256 >= ebase[x]) ? x : e; } TE[pm] = e; }
            if (tid == 0) ((int*)(F.ws + WS_META))[0] = NTR; }
        __syncthreads();
    }
}

struct SchedMoe {
    int G, c, nunits, pm0, csh, colbase, bmul; const int* te; const int* tok;
    __device__ __forceinline__ bool next(int i, pg8::Unit& u) const {
        int pm, ct;
        if ((G & 7) == 0) { const int x = c & 7, w = c >> 3, W = G >> 3, nrows = nunits >> csh, nloc = (nrows + 7) >> 3;
            const long Lx = (long)i * W + w; const int pl = (int)(Lx >> csh), pr = x * nloc + pl; if (pl >= nloc || pr >= nrows) return false;
            pm = pm0 + pr; ct = colbase + (int)(Lx & ((1 << csh) - 1)); }
        else { const long L = (long)i * G + c; if (L >= nunits) return false; pm = pm0 + (int)(L >> csh); ct = colbase + (int)(L & ((1 << csh) - 1)); }
        u.pm = pm; u.pn = bmul * te[pm] + ct; return true; }
};
template <int MODE> struct EpiNull {
    static constexpr bool PERM = true;
    float* sink;
    __device__ __forceinline__ void operator()(const f32x4 (&acc)[2][2][4][2], const pg8::Unit& u, int wr, int wc, int fr, int fq) const {
        float s = 0.f;
        if (MODE == 1) {
#pragma unroll
            for (int ai = 0; ai < 2; ++ai)
#pragma unroll
                for (int bj = 0; bj < 2; ++bj)
#pragma unroll
                    for (int m = 0; m < 4; ++m)
#pragma unroll
                        for (int n = 0; n < 2; ++n) s += (acc[ai][bj][m][n][0] + acc[ai][bj][m][n][1]) + (acc[ai][bj][m][n][2] + acc[ai][bj][m][n][3]);
        } else s = acc[0][0][0][0][0] + acc[1][1][3][1][3];
        if (s == 12345.678f) sink[0] = s;
    }
};
struct EpiGU {
    static constexpr bool PERM = true;
    unsigned char* ACT; const float* WGT;
    __device__ __forceinline__ void operator()(const f32x4 (&acc)[2][2][4][2], const pg8::Unit& u, int wr, int wc, int fr, int fq) const {
        const int row0 = u.pm * 256 + wr * 64 + fr, ct = u.pn & 1;
#pragma unroll
        for (int ai = 0; ai < 2; ++ai)
#pragma unroll
            for (int m = 0; m < 4; ++m) { const int row = row0 + ai * 128 + m * 16; const float w = WGT[row] * ACT_SCALE; float r[8];
#pragma unroll
                for (int n = 0; n < 2; ++n)
#pragma unroll
                    for (int i = 0; i < 4; ++i) { const float g = acc[ai][0][m][n][i] * (1.f / WIN_SCALE); r[4 * n + i] = g * sigmoidf_(g) * (acc[ai][1][m][n][i] * (1.f / WIN_SCALE)) * w; }
                int d0 = 0, d1 = 0;
                d0 = __builtin_amdgcn_cvt_pk_fp8_f32(r[0], r[1], d0, false); d0 = __builtin_amdgcn_cvt_pk_fp8_f32(r[2], r[3], d0, true);
                d1 = __builtin_amdgcn_cvt_pk_fp8_f32(r[4], r[5], d1, false); d1 = __builtin_amdgcn_cvt_pk_fp8_f32(r[6], r[7], d1, true);
                *(u32x2*)(ACT + (size_t)row * 256 + ct * 128 + wc * 32 + fq * 8) = (u32x2){(unsigned)d0, (unsigned)d1}; }
    }
};
constexpr float Y_SCALE = 16.f;
struct EpiDown {
    static constexpr bool PERM = true;
    static constexpr float YD = Y_SCALE / (ACT_SCALE * WDN_SCALE);
    unsigned char* Y;
    __device__ __forceinline__ void operator()(const f32x4 (&acc)[2][2][4][2], const pg8::Unit& u, int wr, int wc, int fr, int fq) const {
        const int row0 = u.pm * 256 + wr * 64 + fr, col0 = (u.pn & 3) * 256 + (wc * 4 + fq) * 16;
#pragma unroll
        for (int ai = 0; ai < 2; ++ai)
#pragma unroll
            for (int m = 0; m < 4; ++m) { const int row = row0 + ai * 128 + m * 16; u32x4 w;
#pragma unroll
                for (int bj = 0; bj < 2; ++bj) { int d0 = 0, d1 = 0;
                    d0 = __builtin_amdgcn_cvt_pk_fp8_f32(acc[ai][bj][m][0][0] * YD, acc[ai][bj][m][0][1] * YD, d0, false); d0 = __builtin_amdgcn_cvt_pk_fp8_f32(acc[ai][bj][m][0][2] * YD, acc[ai][bj][m][0][3] * YD, d0, true);
                    d1 = __builtin_amdgcn_cvt_pk_fp8_f32(acc[ai][bj][m][1][0] * YD, acc[ai][bj][m][1][1] * YD, d1, false); d1 = __builtin_amdgcn_cvt_pk_fp8_f32(acc[ai][bj][m][1][2] * YD, acc[ai][bj][m][1][3] * YD, d1, true);
                    if (bj == 0) { w.x = (unsigned)d0; w.y = (unsigned)d1; } else { w.z = (unsigned)d0; w.w = (unsigned)d1; } }
                *(u32x4*)(Y + (size_t)row * 1024 + col0) = w; }
    }
};
struct EpiComb {
    static constexpr bool PERM = true;
    float* O; const unsigned char* Y; const int* POS; const float* mod; int rtiles;
    __device__ __forceinline__ void operator()(const f32x4 (&acc)[2][2][4][2], const pg8::Unit& u, int wr, int wc, int fr, int fq) const {
        const int row0 = (u.pm - rtiles) * 256 + wr * 64 + fr, ct = u.pn & 3, col0 = ct * 256 + wc * 32 + fq * 8;
#pragma unroll
        for (int ai = 0; ai < 2; ++ai)
#pragma unroll
            for (int m = 0; m < 4; ++m) { const int row = row0 + ai * 128 + m * 16, b = row >> 14;
                const i32x4 p0 = *(const i32x4*)(POS + (size_t)row * 8), p1 = *(const i32x4*)(POS + (size_t)row * 8 + 4);
                f32x2 t[8] = {{0.f, 0.f}, {0.f, 0.f}, {0.f, 0.f}, {0.f, 0.f}, {0.f, 0.f}, {0.f, 0.f}, {0.f, 0.f}, {0.f, 0.f}};
#pragma unroll
                for (int k = 0; k < 8; ++k) { const int pos = k < 4 ? p0[k & 3] : p1[k & 3]; const u32x4 y = *(const u32x4*)(Y + (size_t)pos * 1024 + ct * 256 + (wc * 4 + fq) * 16);
                    t[0] += __builtin_amdgcn_cvt_pk_f32_fp8((int)y.x, false); t[1] += __builtin_amdgcn_cvt_pk_f32_fp8((int)y.x, true);
                    t[2] += __builtin_amdgcn_cvt_pk_f32_fp8((int)y.y, false); t[3] += __builtin_amdgcn_cvt_pk_f32_fp8((int)y.y, true);
                    t[4] += __builtin_amdgcn_cvt_pk_f32_fp8((int)y.z, false); t[5] += __builtin_amdgcn_cvt_pk_f32_fp8((int)y.z, true);
                    t[6] += __builtin_amdgcn_cvt_pk_f32_fp8((int)y.w, false); t[7] += __builtin_amdgcn_cvt_pk_f32_fp8((int)y.w, true); }
#pragma unroll
                for (int bj = 0; bj < 2; ++bj) {
                    const int col = col0 + bj * 128; float* op = O + (size_t)row * D + col;
#pragma unroll
                    for (int n = 0; n < 2; ++n) { const f32x4 g = *(const f32x4*)(mod + b * 6144 + 5120 + col + 4 * n), xv = *(const f32x4*)(op + 4 * n);
                        const f32x4 sv = acc[ai][bj][m][n] * (1.f / (ACT_SCALE * WDN_SCALE)) + (f32x4){t[bj * 4 + 2 * n].x, t[bj * 4 + 2 * n].y, t[bj * 4 + 2 * n + 1].x, t[bj * 4 + 2 * n + 1].y} * (1.f / Y_SCALE);
                        *(f32x4*)(op + 4 * n) = xv + g * sv; } } }
    }
};

constexpr int NPHASE = 12;
__global__ void __launch_bounds__(NTHREADS, 2) fwd_kernel(Args args) {
    extern __shared__ __attribute__((aligned(16))) unsigned char lds[];
    Frame F;
    F.lds = (LAS unsigned char*)lds;
    F.tid = threadIdx.x; F.lane = F.tid & 63; F.wave = __builtin_amdgcn_readfirstlane(F.tid >> 6);
    F.G = gridDim.x; { const int bx = blockIdx.x; F.vcu = (F.G % 8 == 0) ? (bx % 8) * (F.G / 8) + bx / 8 : bx; }
    F.ws = args.ws; F.out = args.out;
    F.ka = (const __attribute__((address_space(4))) unsigned char*)__builtin_amdgcn_kernarg_segment_ptr();
    volatile LAS unsigned* MISC = (volatile LAS unsigned*)(F.lds + MISC_OFF);
    if (F.tid < 64) MISC[F.tid] = 0u;
    __syncthreads();
    const int lo = args.ph_lo, hi = args.ph_hi;
    unsigned* barw = (unsigned*)(F.ws + WS_CTL) + CW_BAR;
    XcdBarrier bar; bar.bar = barw; bar.x = 0; bar.st = nullptr;
    if (hi - lo > 1) bar = xcd_barrier_post(barw, MISC + 8);
#ifndef ONLY_PHASE
#define ONLY_PHASE -1
#endif
#define HASP(k) (ONLY_PHASE < 0 || ONLY_PHASE == (k) || (ONLY_PHASE == 100 && (k) == 10) || (ONLY_PHASE == 101 && (k) == 11))
#define IN(k) (HASP(k) && lo <= (k) && (k) < hi)
#ifndef DBG_REP
#define DBG_REP -1
#endif
#ifndef DBG_REPN
#define DBG_REPN 2
#endif
#define REPS(k) for (int rep_ = 0; rep_ < ((DBG_REP == (k)) ? DBG_REPN : 1); (void)({ asm volatile("" ::: "memory"); 0; }), ++rep_)
#define SEAM(k) do { if (IN(k) && IN((k) + 1)) xcd_barrier(bar); } while (0)
    bf16* const H = (bf16*)F.out;

    if (IN(0)) { REPS(0) phase0(F); } SEAM(0);
    if (IN(1)) { REPS(1) phase1(F); } SEAM(1);
    if (IN(2)) REPS(2) {
        pg8::Gemm g{H, (const bf16*)(F.ws + WS_WIN), T, NIN, D / 2}; pg8::StaticOrder S; S.init(T, NIN, F.G, (int)blockIdx.x);
        EpiIn E{(bf16*)(F.ws + WS_U), (bf16*)(F.ws + WS_Q), (bf16*)(F.ws + WS_K), (bf16*)(F.ws + WS_V), (bf16*)(F.ws + WS_GC), (bf16*)(F.ws + WS_GA), (const float*)(F.ws + WS_ROPE), F.in(I_QNG), F.in(I_KNG), F.lds + EPI_SCR};
        pg8::gemm_phase<EpiIn, pg8::StaticOrder, true, true, false, true>(F.lds, g, S, E);
    } SEAM(2);
    if (IN(3)) { REPS(3) phase3(F); } SEAM(3);
    if (IN(4)) REPS(4) {
        pg8::Gemm g{H, (const bf16*)(F.ws + WS_WPW2), T, D, D / 2}; pg8::StaticOrder S; S.init(T, D, F.G, (int)blockIdx.x);
        EpiPw2 E{(bf16*)(F.ws + WS_U), (const bf16*)(F.ws + WS_GC), F.in(I_BPW2)};
        pg8::gemm_phase<EpiPw2, pg8::StaticOrder, true, true, false, true>(F.lds, g, S, E);
    } SEAM(4);
#ifndef DBG_ATTVAR
#define DBG_ATTVAR 0
#endif
    if (IN(5)) { att::phase5(F, (bf16*)(F.ws + WS_U)); } SEAM(5);
    if (IN(6)) REPS(6) {
        pg8::Gemm g{(const bf16*)(F.ws + WS_U), (const bf16*)(F.ws + WS_WOUT), T, D, D}; pg8::StaticOrder S; S.init(T, D, F.G, (int)blockIdx.x);
        EpiOut E{F.in(I_X), F.out, (const float*)(F.ws + WS_MOD)};
        pg8::gemm_phase<EpiOut, pg8::StaticOrder, true, true, false>(F.lds, g, S, E);
    } SEAM(6);
    if (IN(7)) { REPS(7) phase7(F); } SEAM(7);
    if (IN(8)) { REPS(8) phase8(F); } SEAM(8);
    const int* TE = (const int*)(F.ws + WS_TE); const int* TOK = (const int*)(F.ws + WS_TOK);
    if (IN(9)) REPS(9) {
        const int NTR = ((const int*)(F.ws + WS_META))[0];
        pg8::Gemm g{(const bf16*)(F.ws + WS_U), (const bf16*)(F.ws + WS_WGU), 0, 0, D / 2};
        SchedMoe S{F.G, (int)blockIdx.x, 2 * (NTR + 128), 0, 1, 0, 2, TE, TOK};
        EpiGU E{(unsigned char*)(F.ws + WS_ACT), (const float*)(F.ws + WS_WGT)};
        pg8::gemm_phase<EpiGU, SchedMoe, true, true, true, true>(F.lds, g, S, E);
    } SEAM(9);
    if (IN(10)) REPS(10) { const int NTR = ((const int*)(F.ws + WS_META))[0];
        pg8::Gemm g{(const bf16*)(F.ws + WS_ACT), (const bf16*)(F.ws + WS_WDN), 0, 0, ED / 2};
        SchedMoe S{F.G, (int)blockIdx.x, 4 * NTR, 0, 2, 0, 4, TE, TOK};
        EpiDown E{(unsigned char*)(F.ws + WS_Y)};
#ifndef DBG_P10VAR
#define DBG_P10VAR 0
#endif
        if (DBG_P10VAR == 1) { EpiNull<0> E0{(float*)(F.ws + WS_META) + 8}; pg8::gemm_phase<EpiNull<0>, SchedMoe, true, true, false>(F.lds, g, S, E0); }
        if (DBG_P10VAR == 2) { EpiNull<1> E0{(float*)(F.ws + WS_META) + 8}; pg8::gemm_phase<EpiNull<1>, SchedMoe, true, true, false>(F.lds, g, S, E0); }
        pg8::gemm_phase<EpiDown, SchedMoe, true, true, false, true>(F.lds, g, S, E);
    } SEAM(10);
    if (IN(11)) { const int NTR = ((const int*)(F.ws + WS_META))[0];
        pg8::Gemm g{(const bf16*)(F.ws + WS_ACT), (const bf16*)(F.ws + WS_WDN), 0, 0, ED / 2};
        SchedMoe S{F.G, (int)blockIdx.x, 512, NTR, 2, 0, 4, TE, TOK};
        EpiComb E{F.out, (const unsigned char*)(F.ws + WS_Y), (const int*)(F.ws + WS_POS), (const float*)(F.ws + WS_MOD), NTR};
        pg8::gemm_phase<EpiComb, SchedMoe, true, true, false, true>(F.lds, g, S, E);
    }
#undef IN
#undef SEAM

}

#ifndef DBG_A6
#define DBG_A6 WS_U
#endif
#ifndef DBG_SKIP
#define DBG_SKIP 0
#endif
#ifndef DBG_NPH
#define DBG_NPH NPHASE
#endif
#ifndef N_LAUNCH_MODE
#define N_LAUNCH_MODE 1
#endif
extern "C" void kernel_launch(void* const* d_in, const int* in_sizes, int n_in, void* d_out, int out_size, void* d_ws, size_t ws_size, hipStream_t stream) {
    static int grid = 0;
    if (grid == 0) {
        if (n_in != 28 || out_size != T * D || ws_size < WS_END) { fprintf(stderr, "kernel_launch: unexpected problem (n_in %d out %d ws %zu)\n", n_in, out_size, ws_size); grid = -1; return; }
        int dev = 0, cus = 0, per_cu = 0;
        if (hipGetDevice(&dev) != hipSuccess || hipDeviceGetAttribute(&cus, hipDeviceAttributeMultiprocessorCount, dev) != hipSuccess) { grid = -1; return; }
        if (hipFuncSetAttribute((const void*)fwd_kernel, hipFuncAttributeMaxDynamicSharedMemorySize, LDS_BYTES) != hipSuccess) { grid = -1; return; }
        if (hipOccupancyMaxActiveBlocksPerMultiprocessor(&per_cu, (const void*)fwd_kernel, NTHREADS, LDS_BYTES) != hipSuccess || per_cu < 1) { fprintf(stderr, "kernel_launch: occupancy query says %d\n", per_cu); }
        (void)hipGetLastError();
        grid = cus;
    }
    if (grid < 0) return;
    (void)hipMemsetAsync((char*)d_ws + WS_CTL, 0, CTL_ZERO_BYTES, stream);
    Args a{};
    for (int i = 0; i < 28; ++i) a.in[i] = d_in[i];
    a.out = (float*)d_out; a.ws = (unsigned char*)d_ws;
    if (N_LAUNCH_MODE == 1) { a.ph_lo = 0; a.ph_hi = NPHASE; hipLaunchKernelGGL(fwd_kernel, dim3(grid), dim3(NTHREADS), LDS_BYTES, stream, a); }
    else { for (int p = 0; p < DBG_NPH; ++p) { if ((DBG_SKIP >> p) & 1) continue; a.ph_lo = p; a.ph_hi = p + 1; hipLaunchKernelGGL(fwd_kernel, dim3(grid), dim3(NTHREADS), LDS_BYTES, stream, a); } }
}
```

```cpp
#include <hip/hip_runtime.h>
#include <cstdio>
#include <cstdint>

#define GAS __attribute__((address_space(1)))
#define LAS __attribute__((address_space(3)))
typedef unsigned short bf16;
typedef short bf16x8 __attribute__((ext_vector_type(8)));
typedef short s16x4 __attribute__((ext_vector_type(4)));
typedef float f32x4 __attribute__((ext_vector_type(4)));
typedef float f32x2 __attribute__((ext_vector_type(2)));
typedef float f32x16 __attribute__((ext_vector_type(16)));
typedef unsigned u32x4 __attribute__((ext_vector_type(4)));
typedef unsigned u32x2 __attribute__((ext_vector_type(2)));
typedef int i32x4 __attribute__((ext_vector_type(4)));

constexpr int NB = 2, SEQ = 16384, T = NB * SEQ, D = 1024, NIN = 7168;
constexpr int NE = 64, TOPK = 8, ED = 256, NEX = NE + 1;
constexpr float EPS = 1e-6f;
constexpr float C2 = 0.125f * 1.4426950408889634f;
constexpr float QSC = 4.f, PBIAS = 60.f;
constexpr float LAMBDA_INIT = 0.2f;
constexpr int NWAVES = 8, NTHREADS = 512;

constexpr size_t MiB = 1u << 20;
constexpr size_t WS_CTL = 0, CTL_ZERO_BYTES = 64 * 1024;
constexpr size_t WS_MOD = 1 * MiB;
constexpr size_t WS_ROPE = 1 * MiB + 64 * 1024;
constexpr size_t WS_TKE = 3 * MiB + 256 * 1024;
constexpr size_t WS_TKR = 4 * MiB + 256 * 1024;
constexpr size_t WS_TKW = 5 * MiB + 256 * 1024;
constexpr size_t WS_POS = 6 * MiB + 256 * 1024;
constexpr size_t WS_CNT = 7 * MiB + 256 * 1024;
constexpr size_t WS_TE = WS_CNT + 64 * 1024;
constexpr size_t WS_META = WS_TE + 8 * 1024;
constexpr size_t WS_TOK = 7 * MiB + 512 * 1024;
constexpr size_t WS_WGT = 8 * MiB + 768 * 1024;
constexpr int RMAX = 262144 + 64 * 256 + T;
static_assert(WS_TOK + (size_t)RMAX * 4 <= WS_WGT && WS_WGT + (size_t)RMAX * 4 <= 10 * MiB, "small region");
constexpr size_t WS_WRH = 10 * MiB, WS_WRL = 10 * MiB + 128 * 1024;
constexpr size_t WS_WDN = 11 * MiB;
constexpr size_t WS_WIN = WS_WDN + (size_t)NEX * 1024 * 256 * 2 + MiB / 2;
constexpr size_t WS_WPW2 = WS_WIN + 14 * MiB, WS_WOUT = WS_WPW2 + 2 * MiB;
constexpr size_t WS_WGU = WS_WOUT + 2 * MiB;
constexpr size_t WS_U = 127 * MiB;
constexpr size_t WS_Q = WS_U + 64 * MiB, WS_K = WS_Q + 64 * MiB, WS_V = WS_K + 64 * MiB, WS_GC = WS_V + 64 * MiB, WS_GA = WS_GC + 64 * MiB;
constexpr size_t WS_END = WS_GA + 64 * MiB;
static_assert(WS_WGU + (size_t)NEX * 512 * 1024 * 2 <= WS_U && WS_END <= 512 * MiB, "ws map");
constexpr size_t WS_ACT = 359 * MiB;
constexpr size_t WS_Y = 44 * MiB;
static_assert(WS_ACT + (size_t)RMAX * 512 <= WS_END && WS_Y + (size_t)(262144 + 64 * 256) * 1024 <= WS_ACT && WS_Y >= WS_WDN + (size_t)NEX * 1024 * 256 * 2, "moe overlays");
constexpr int CW_BAR = 1024;

#ifndef DBG_A6
#define DBG_A6 WS_U
#endif
constexpr int RING_BYTES = 131072;
constexpr int LDS_BYTES = 163840;
constexpr int EPI_SCR = RING_BYTES;
constexpr int MISC_OFF = LDS_BYTES - 256;

#define LDS_WAIT() asm volatile("s_waitcnt lgkmcnt(0)" ::: "memory")
#define VM_WAIT() asm volatile("s_waitcnt vmcnt(0)" ::: "memory")
typedef __bf16 bf16x2_t __attribute__((ext_vector_type(2)));
__device__ __forceinline__ unsigned cvt_pk_bf16(float lo, float hi) { const f32x2 v = {lo, hi}; const bf16x2_t b = __builtin_convertvector(v, bf16x2_t); return __builtin_bit_cast(unsigned, b); }
__device__ __forceinline__ float bf_lo(unsigned u) { return __builtin_bit_cast(float, u << 16); }
__device__ __forceinline__ float bf_hi(unsigned u) { return __builtin_bit_cast(float, u & 0xffff0000u); }
__device__ __forceinline__ float sigmoidf_(float x) { return __builtin_amdgcn_rcpf(1.f + __expf(-x)); }
__device__ __forceinline__ float wave_sum(float v) {
#pragma unroll
    for (int o = 1; o < 64; o <<= 1) v += __shfl_xor(v, o);
    return v;
}
__device__ __forceinline__ float wave_max(float v) {
#pragma unroll
    for (int o = 1; o < 64; o <<= 1) v = fmaxf(v, __shfl_xor(v, o));
    return v;
}

namespace pg8 {
typedef int i32x8_t __attribute__((ext_vector_type(8)));
typedef int i32x4_t __attribute__((ext_vector_type(4)));
constexpr int BM = 256, BK = 64, HALF = 128, HTB = HALF * BK * 2, STAGE_BYTES = 8 * HTB, NXCD = 8, WGM = 8;
__host__ __device__ __forceinline__ int lds_byte(int r, int c) { const int st = (r >> 4) * 2 + (c >> 5), rr = r & 15, cc = c & 31, ob = rr * 64 + cc * 2; return st * 1024 + (ob ^ (((ob >> 9) & 1) << 5)); }
__host__ __device__ __forceinline__ void stage_rc(int b, int& R, int& C) { const int st = b / 1024, sb = b % 1024, swz = sb ^ (((sb >> 9) & 1) << 5); R = (st >> 1) * 16 + swz / 64; C = (st & 1) * 32 + (swz % 64) / 2; }
__host__ __device__ __forceinline__ int perm32(int rho) { const int n = rho >> 4, i = rho & 15; return 8 * (i >> 2) + 4 * n + (i & 3); }

struct Unit { int pm, pn; };
struct Gemm { const bf16* A; const bf16* Bt; int M, N, K; };

struct StaticOrder {
    int nM, nN, nwg, G, c;
    const int* tok;
    __host__ __device__ void init(int M, int N, int G_, int c_) { nM = M / BM; nN = N / BM; nwg = nM * nN; G = G_; c = c_; tok = nullptr; }
    __host__ __device__ bool next(int i, Unit& u) const {
        const long L = (long)i * G + c; if (L >= nwg) return false;
        int wgid = (int)L; { const int q = nwg / NXCD, r = nwg % NXCD, xcd = wgid % NXCD, off = wgid / NXCD; wgid = (xcd < r ? xcd * (q + 1) : r * (q + 1) + (xcd - r) * q) + off; }
        const int nig = WGM * nN, gid = wgid / nig, fm = gid * WGM, gsz = (nM - fm) < WGM ? (nM - fm) : WGM;
        u.pm = fm + ((wgid % nig) % gsz); u.pn = (wgid % nig) / gsz; return true;
    }
};

template <class Epi, class Sched, bool ALIGN_EPI, bool SP2, bool GATHER, bool FP8 = false>
__device__ __forceinline__ void gemm_phase(LAS unsigned char* lds, const Gemm g, const Sched& S, const Epi& E) {
    const int tid = threadIdx.x, wid = __builtin_amdgcn_readfirstlane(tid >> 6), lane = tid & 63, wr = wid >> 2, wc = wid & 3, fr = lane & 15, fq = lane >> 4;
    const int K = g.K, nt = K / BK;
    unsigned voffA[2], voffB[2]; int RA[2]; unsigned CA2[2];
#pragma unroll
    for (int i = 0; i < 2; ++i) { int R, C; stage_rc(tid * 16 + i * 8192, R, C); const int Rb = Epi::PERM ? ((R & ~31) + perm32(R & 31)) : R;
        voffA[i] = (unsigned)(R * K + C) * 2u; voffB[i] = (unsigned)(Rb * K + C) * 2u; RA[i] = R; CA2[i] = (unsigned)C * 2u; }
    const size_t kstep = (size_t)(BK * 2);
    const size_t hstep = (size_t)HALF * K * 2;
    const size_t tstep = 2 * hstep;
    const unsigned ldsw = (unsigned)wid * 1024u;
    const int aoff = lds_byte(wr * 64 + fr, fq * 8), boff = lds_byte(wc * 32 + fr, fq * 8);
#define PG8_SA(b, h) (((b) * 2 + (h)) * HTB)
#define PG8_SB(b, h) ((4 + (b) * 2 + (h)) * HTB)
#define PG8_STAGE2(bufoff, gbase, o0, o1) do { \
        __builtin_amdgcn_global_load_lds((const unsigned*)((const char*)(gbase) + (o0)), (LAS unsigned*)(lds + (bufoff) + ldsw), 16, 0, 0); \
        __builtin_amdgcn_global_load_lds((const unsigned*)((const char*)(gbase) + (o1)), (LAS unsigned*)(lds + (bufoff) + ldsw + 8192), 16, 0, 0); } while (0)
#define PG8_STAGEB(bufoff, gbase) PG8_STAGE2(bufoff, gbase, voffB[0], voffB[1])
#define PG8_STAGEA(bufoff, gbase, h, o0, o1) do { if constexpr (GATHER) { PG8_STAGE2(bufoff, gbase, o0, o1); } else { PG8_STAGE2(bufoff, (gbase) + (h) * hstep, voffA[0], voffA[1]); } } while (0)
#define PG8_LD8(p) __builtin_shufflevector(*(const LAS i32x4_t*)(p), *(const LAS i32x4_t*)((p) + 1024), 0, 1, 2, 3, 4, 5, 6, 7)
#define PG8_LDA(dst, b, h) do { if constexpr (FP8) { _Pragma("unroll") for (int m = 0; m < 4; ++m) dst##8[m] = PG8_LD8(lds + PG8_SA(b, h) + aoff + m * 2048); } \
        else { _Pragma("unroll") for (int m = 0; m < 4; ++m) _Pragma("unroll") for (int k = 0; k < 2; ++k) dst[m][k] = *(const LAS bf16x8*)(lds + PG8_SA(b, h) + aoff + m * 2048 + k * 1024); } } while (0)
#define PG8_LDB(dst, b, h) do { if constexpr (FP8) { _Pragma("unroll") for (int n = 0; n < 2; ++n) dst##8[n] = PG8_LD8(lds + PG8_SB(b, h) + boff + n * 2048); } \
        else { _Pragma("unroll") for (int n = 0; n < 2; ++n) _Pragma("unroll") for (int k = 0; k < 2; ++k) dst[n][k] = *(const LAS bf16x8*)(lds + PG8_SB(b, h) + boff + n * 2048 + k * 1024); } } while (0)
#define PG8_CAT(x) __builtin_shufflevector(__builtin_bit_cast(i32x4_t, (x)[0]), __builtin_bit_cast(i32x4_t, (x)[1]), 0, 1, 2, 3, 4, 5, 6, 7)
#define PG8_MMA(ai, bj, At, Bt) do { __builtin_amdgcn_s_setprio(1); \
        if constexpr (FP8) { _Pragma("unroll") for (int m = 0; m < 4; ++m) _Pragma("unroll") for (int n = 0; n < 2; ++n) \
            asm volatile("v_mfma_f32_16x16x128_f8f6f4 %0, %1, %2, %0" : "+v"(acc[ai][bj][m][n]) : "v"(Bt##8[n]), "v"(At##8[m])); }   \
        else { _Pragma("unroll") for (int m = 0; m < 4; ++m) _Pragma("unroll") for (int n = 0; n < 2; ++n) _Pragma("unroll") for (int k = 0; k < 2; ++k) \
            acc[ai][bj][m][n] = __builtin_amdgcn_mfma_f32_16x16x32_bf16(Bt[n][k], At[m][k], acc[ai][bj][m][n], 0, 0, 0); } \
        __builtin_amdgcn_s_setprio(0); } while (0)
#define PG8_WAIT_V(n) asm volatile("s_waitcnt vmcnt(" #n ")" ::: "memory")
#define PG8_WAIT_L(n) asm volatile("s_waitcnt lgkmcnt(" #n ")" ::: "memory")
#define PG8_BAR __builtin_amdgcn_s_barrier()
#define PG8_SCHED __builtin_amdgcn_sched_barrier(0)
#define PG8_SETA(o, u) do { _Pragma("unroll") for (int h_ = 0; h_ < 2; ++h_) _Pragma("unroll") for (int i_ = 0; i_ < 2; ++i_) { \
        if constexpr (GATHER) { int t_ = S.tok[(u).pm * 256 + h_ * 128 + RA[i_]]; t_ = t_ < 0 ? 0 : t_; o[h_][i_] = (unsigned)t_ * (unsigned)(K * 2) + CA2[i_]; } \
        else { o[h_][i_] = (unsigned)(h_ * hstep) + voffA[i_]; } } } while (0)
    Unit cur, nxt; int ui = 0;
    if (!S.next(0, cur)) return;
    f32x4 acc[2][2][4][2];
#pragma unroll
    for (int a = 0; a < 2; ++a)
#pragma unroll
        for (int b = 0; b < 2; ++b)
#pragma unroll
            for (int m = 0; m < 4; ++m)
#pragma unroll
                for (int n = 0; n < 2; ++n) acc[a][b][m][n] = (f32x4){0.f, 0.f, 0.f, 0.f};
    bf16x8 At[4][2], B0[2][2], B1[2][2];
    i32x8_t At8[4], B08[2], B18[2];
    unsigned cO[2][2], nO[2][2];
    if constexpr (GATHER) { PG8_SETA(cO, cur); VM_WAIT(); }
    else { cO[0][0] = cO[0][1] = cO[1][0] = cO[1][1] = 0u; }
    const char* cA = GATHER ? (const char*)g.A : (const char*)g.A + (size_t)cur.pm * tstep; const char* cB = (const char*)g.Bt + (size_t)cur.pn * tstep;
    if constexpr (SP2) {
        PG8_STAGEB(PG8_SB(0, 0), cB); PG8_STAGEB(PG8_SB(0, 1), cB + hstep); PG8_STAGEA(PG8_SA(0, 0), cA, 0, cO[0][0], cO[0][1]); PG8_STAGEA(PG8_SA(0, 1), cA, 1, cO[1][0], cO[1][1]);
        if (wr == 1) PG8_BAR;
        PG8_WAIT_V(2); PG8_BAR;
        PG8_STAGEB(PG8_SB(1, 0), cB + kstep); PG8_STAGEA(PG8_SA(1, 0), cA + kstep, 0, cO[0][0], cO[0][1]); PG8_STAGEB(PG8_SB(1, 1), cB + hstep + kstep);
        PG8_WAIT_V(6); PG8_BAR;
    }
    for (;;) {
        const bool has_next = S.next(ui + 1, nxt);
        if constexpr (!GATHER) { nO[0][0] = nO[0][1] = nO[1][0] = nO[1][1] = 0u; }
        else if (has_next) { PG8_SETA(nO, nxt); } else {
#pragma unroll
            for (int h_ = 0; h_ < 2; ++h_)
#pragma unroll
                for (int i_ = 0; i_ < 2; ++i_) nO[h_][i_] = cO[h_][i_]; }
        const char* nA = GATHER ? (const char*)g.A : (has_next ? (const char*)g.A + (size_t)nxt.pm * tstep : cA);
        const char* nB = has_next ? (const char*)g.Bt + (size_t)nxt.pn * tstep : cB;
#pragma nounroll
        for (int t = 0; t < nt; t += 2) {
            const bool last = (t == nt - 2);
            const char* a1 = cA + (size_t)(t + 1) * kstep;
            const char* a2 = last ? nA : cA + (size_t)(t + 2) * kstep; const char* b2 = last ? nB : cB + (size_t)(t + 2) * kstep;
            const char* a3 = a2 + kstep; const char* b3 = b2 + kstep;
            const unsigned x00 = last ? nO[0][0] : cO[0][0], x01 = last ? nO[0][1] : cO[0][1], x10 = last ? nO[1][0] : cO[1][0], x11 = last ? nO[1][1] : cO[1][1];
            PG8_LDB(B0, 0, 0); PG8_LDB(B1, 0, 1); PG8_SCHED; PG8_LDA(At, 0, 0); PG8_STAGEA(PG8_SA(1, 1), a1, 1, cO[1][0], cO[1][1]);
            PG8_WAIT_V(8); PG8_WAIT_L(0); PG8_BAR; PG8_MMA(0, 0, At, B0); PG8_MMA(0, 1, At, B1); PG8_BAR; PG8_SCHED;
            PG8_LDA(At, 0, 1); PG8_STAGEB(PG8_SB(0, 0), b2); PG8_STAGEB(PG8_SB(0, 1), b2 + hstep); PG8_STAGEA(PG8_SA(0, 0), a2, 0, x00, x01);
            PG8_WAIT_V(8); PG8_WAIT_L(0); PG8_BAR; PG8_MMA(1, 0, At, B0); PG8_MMA(1, 1, At, B1); PG8_BAR; PG8_SCHED;
            PG8_LDB(B0, 1, 0); PG8_LDB(B1, 1, 1); PG8_SCHED; PG8_LDA(At, 1, 0); PG8_STAGEA(PG8_SA(0, 1), a2, 1, x10, x11);
            PG8_WAIT_V(8); PG8_WAIT_L(0); PG8_BAR; PG8_MMA(0, 0, At, B0); PG8_MMA(0, 1, At, B1); PG8_BAR; PG8_SCHED;
            PG8_LDA(At, 1, 1); PG8_STAGEB(PG8_SB(1, 0), b3); PG8_STAGEB(PG8_SB(1, 1), b3 + hstep); PG8_STAGEA(PG8_SA(1, 0), a3, 0, x00, x01);
            PG8_WAIT_V(8); PG8_WAIT_L(0); PG8_BAR; PG8_MMA(1, 0, At, B0); PG8_MMA(1, 1, At, B1); PG8_BAR; PG8_SCHED;
        }
        if constexpr (ALIGN_EPI) { if (wr == 0) PG8_BAR; }
        if constexpr (FP8) asm volatile("s_nop 15\n\ts_nop 15" ::: "memory");
        E(acc, cur, wr, wc, fr, fq);
        if (!has_next) break;
#pragma unroll
        for (int a = 0; a < 2; ++a)
#pragma unroll
            for (int b = 0; b < 2; ++b)
#pragma unroll
                for (int m = 0; m < 4; ++m)
#pragma unroll
                    for (int n = 0; n < 2; ++n) acc[a][b][m][n] = (f32x4){0.f, 0.f, 0.f, 0.f};
        cur = nxt; cA = nA; cB = nB; ++ui;
#pragma unroll
        for (int h_ = 0; h_ < 2; ++h_)
#pragma unroll
            for (int i_ = 0; i_ < 2; ++i_) cO[h_][i_] = nO[h_][i_];
        if constexpr (ALIGN_EPI) { if (wr == 1) PG8_BAR; }
    }
    PG8_WAIT_V(0);
    if constexpr (!ALIGN_EPI) { if (wr == 0) PG8_BAR; }
    PG8_BAR;
#undef PG8_SA
#undef PG8_SB
#undef PG8_STAGE2
#undef PG8_STAGEB
#undef PG8_STAGEA
#undef PG8_LDA
#undef PG8_LD8
#undef PG8_LDB
#undef PG8_MMA
#undef PG8_CAT
#undef PG8_WAIT_V
#undef PG8_WAIT_L
#undef PG8_BAR
#undef PG8_SCHED
#undef PG8_SETA
}
}

#define XB_TMO      128
#define XB_XCNT(j)  (256  + 64 * (j))
#define XB_XSUB(j)  (1280 + 64 * (j))
#define XB_XGEN(j)  (2304 + 64 * (j))
#define XB_TOP      3328
#define XB_TOPGEN   3392
#define XCD_BAR_WORDS 3456
#define XB_SPIN_CAP (1u << 18)
__device__ __forceinline__ unsigned xb_ld(unsigned* p)              { return __hip_atomic_load(p, __ATOMIC_RELAXED, __HIP_MEMORY_SCOPE_AGENT); }
__device__ __forceinline__ unsigned xb_add(unsigned* p, unsigned v) { return __hip_atomic_fetch_add(p, v, __ATOMIC_RELAXED, __HIP_MEMORY_SCOPE_AGENT); }
__device__ __forceinline__ unsigned xb_xcc_id() { return (unsigned)__builtin_amdgcn_s_getreg((3 << 11) | 20) & 0xFu; }
#define XB_SPIN(cond, bar) do { unsigned _sp = 0; while (cond) { __builtin_amdgcn_s_sleep(1); \
    if ((++_sp & 255u) == 0u) { if (xb_ld(&(bar)[XB_TMO])) break; if (_sp > XB_SPIN_CAP) { atomicAdd(&(bar)[XB_TMO], 1u); break; } } } } while (0)
struct XcdBarrier { unsigned* bar; unsigned x; volatile LAS unsigned* st; };
__device__ __forceinline__ XcdBarrier xcd_barrier_post(unsigned* bar, volatile LAS unsigned* st) {
    XcdBarrier b; b.bar = bar; b.x = xb_xcc_id(); b.st = st;
    if (threadIdx.x == 0) (void)xb_add(&bar[XB_XCNT(b.x)], 1u);
    return b;
}
__device__ __forceinline__ void xcd_barrier_complete(unsigned* bar, unsigned x, unsigned& nloc, unsigned& nx) {
    const unsigned G = gridDim.x * gridDim.y * gridDim.z;
    unsigned sum, cnt, mine, sp = 0u;
    for (;;) {
        sum = 0u; cnt = 0u; mine = 0u;
#pragma unroll
        for (unsigned j = 0; j < 16; ++j) { const unsigned c = xb_ld(&bar[XB_XCNT(j)]); sum += c; cnt += (c > 0u) ? 1u : 0u; mine = (j == x) ? c : mine; }
        if (sum == G) break;
        __builtin_amdgcn_s_sleep(1);
        if ((++sp & 255u) == 0u) { if (xb_ld(&bar[XB_TMO])) break; if (sp > XB_SPIN_CAP) { atomicAdd(&bar[XB_TMO], 1u); break; } }
    }
    nloc = mine > 0u ? mine : 1u; nx = cnt > 0u ? cnt : 1u;
}
__device__ __forceinline__ void xcd_barrier(const XcdBarrier& b) {
    asm volatile("s_waitcnt vmcnt(0)" ::: "memory");
    __syncthreads();
    if (threadIdx.x == 0) {
        unsigned* bar = b.bar;
        __builtin_amdgcn_s_waitcnt(0);
        unsigned nloc = b.st[0], nx = b.st[1];
        if (nloc == 0u) { xcd_barrier_complete(bar, b.x, nloc, nx); b.st[0] = nloc; b.st[1] = nx; }
        const unsigned old = xb_add(&bar[XB_XSUB(b.x)], 1u);
        const unsigned gen = old / nloc;
        if (old + 1u == (gen + 1u) * nloc) {
            __builtin_amdgcn_fence(__ATOMIC_RELEASE, "agent");
            asm volatile("s_waitcnt vmcnt(0)" ::: "memory");
            const unsigned og = xb_add(&bar[XB_TOP], 1u);
            const unsigned tg = og / nx;
            if (og + 1u == (tg + 1u) * nx) xb_add(&bar[XB_TOPGEN], 1u);
            else XB_SPIN(xb_ld(&bar[XB_TOPGEN]) == tg, bar);
            __builtin_amdgcn_fence(__ATOMIC_ACQUIRE, "agent");
            xb_add(&bar[XB_XGEN(b.x)], 1u);
            asm volatile("s_waitcnt vmcnt(0)" ::: "memory");
        } else {
            XB_SPIN(xb_ld(&bar[XB_XGEN(b.x)]) == gen, bar);
            __builtin_amdgcn_fence(__ATOMIC_ACQUIRE, "agent");
            asm volatile("s_waitcnt vmcnt(0)" ::: "memory");
        }
    }
    __syncthreads();
}

struct Args { const void* in[28]; float* out; unsigned char* ws; int ph_lo, ph_hi; };
struct Frame {
    LAS unsigned char* lds;
    int tid, lane, wave, vcu, G;
    unsigned char* ws; float* out;
    const __attribute__((address_space(4))) unsigned char* ka;
    __device__ __forceinline__ const float* in(int i) const { return ((const float* const __attribute__((address_space(4)))*)ka)[i]; }
};
enum { I_X = 0, I_C, I_POS, I_WADA, I_BADA, I_N1G, I_WIN, I_CDW, I_CDWB, I_CLNG, I_CLNB, I_WPW2, I_BPW2, I_QNG, I_KNG, I_LQ1, I_LK1, I_LQ2, I_LK2, I_SUBG, I_WOUT, I_N2G, I_WR, I_RB, I_WEGU, I_WEDN, I_WSGU, I_WSDN };

__device__ __forceinline__ int win_map(int n) {
    if (n < 1024) return 256 * (n >> 7) + (n & 127);
    if (n < 2048) { const int j = n - 1024; return 256 * (j >> 7) + 128 + (j & 127); }
    if (n < 4096) { const int qk = (n - 2048) >> 10, j = (n - 2048) & 1023, g = j >> 6, dl = j & 63; const int tile = 8 + 4 * qk + (g >> 2), wc = g & 3;
        int bj, fq, e; if (dl < 8) { bj = 0; fq = 0; e = dl; } else if (dl < 16) { bj = 1; fq = 0; e = dl - 8; } else { const int rho = dl - 16; bj = rho / 24; fq = 1 + (rho % 24) / 8; e = rho & 7; }
        return 256 * tile + 128 * bj + 32 * wc + 8 * fq + e; }
    return n;
}
__device__ __forceinline__ int glu_map(int n) { const int j = n & 255; return 256 * (j >> 7) + ((n >> 8) << 7) + (j & 127); }
__device__ __forceinline__ int qk_dim(int bj, int fq, int e) { return fq == 0 ? bj * 8 + e : 16 + bj * 24 + (fq - 1) * 8 + e; }

template <int MAP>
__device__ __forceinline__ void transpose_item(const float* W, int K, int N, bf16* WT, LAS float* scr, int item, int lane) {
    const int nblk = N / 32, kb = item / nblk, nb = item % nblk, k0 = 64 * kb, n0 = 32 * nb;
    {
        const int rr = lane >> 3, c4 = (lane & 7) * 4; f32x4 t[8];
#pragma unroll
        for (int i = 0; i < 8; ++i) t[i] = __builtin_nontemporal_load((const f32x4*)(W + (size_t)(k0 + 8 * i + rr) * N + n0 + c4));
#pragma unroll
        for (int i = 0; i < 8; ++i) { LAS float* d = scr + (8 * i + rr) * 33 + c4; d[0] = t[i].x; d[1] = t[i].y; d[2] = t[i].z; d[3] = t[i].w; }
    }
    LDS_WAIT(); asm volatile("" ::: "memory");
    const int c = lane & 7;
#pragma unroll
    for (int j = 0; j < 4; ++j) { const int n = (lane >> 3) + 8 * j; const LAS float* s = scr + (8 * c) * 33 + n;
        u32x4 o; o.x = cvt_pk_bf16(s[0 * 33], s[1 * 33]); o.y = cvt_pk_bf16(s[2 * 33], s[3 * 33]); o.z = cvt_pk_bf16(s[4 * 33], s[5 * 33]); o.w = cvt_pk_bf16(s[6 * 33], s[7 * 33]);
        const int nn = n0 + n; const int row = MAP == 1 ? win_map(nn) : (MAP == 2 ? glu_map(nn) : nn);
        *(u32x4*)(WT + (size_t)row * K + k0 + 8 * c) = o; }
    LDS_WAIT(); asm volatile("" ::: "memory");
}

constexpr float WDN_SCALE = 16.f, ACT_SCALE = 8.f;
constexpr float WIN_SCALE = 32.f;
template <int MAP>
__device__ __forceinline__ void transpose_item8(const float* W, int K, int N, unsigned char* WT, LAS float* scr, int item, int lane, float scale = WIN_SCALE) {
    const int nblk = N / 32, kb = item / nblk, nb = item % nblk, k0 = 64 * kb, n0 = 32 * nb;
    {
        const int rr = lane >> 3, c4 = (lane & 7) * 4; f32x4 t[8];
#pragma unroll
        for (int i = 0; i < 8; ++i) t[i] = __builtin_nontemporal_load((const f32x4*)(W + (size_t)(k0 + 8 * i + rr) * N + n0 + c4));
#pragma unroll
        for (int i = 0; i < 8; ++i) { LAS float* d = scr + (8 * i + rr) * 33 + c4; d[0] = t[i].x * scale; d[1] = t[i].y * scale; d[2] = t[i].z * scale; d[3] = t[i].w * scale; }
    }
    LDS_WAIT(); asm volatile("" ::: "memory");
    const int c = lane & 7;
#pragma unroll
    for (int j = 0; j < 4; ++j) { const int n = (lane >> 3) + 8 * j; const LAS float* sp = scr + (8 * c) * 33 + n;
        int d0 = 0, d1 = 0;
        d0 = __builtin_amdgcn_cvt_pk_fp8_f32(sp[0 * 33], sp[1 * 33], d0, false); d0 = __builtin_amdgcn_cvt_pk_fp8_f32(sp[2 * 33], sp[3 * 33], d0, true);
        d1 = __builtin_amdgcn_cvt_pk_fp8_f32(sp[4 * 33], sp[5 * 33], d1, false); d1 = __builtin_amdgcn_cvt_pk_fp8_f32(sp[6 * 33], sp[7 * 33], d1, true);
        const int nn = n0 + n; const int row = MAP == 1 ? win_map(nn) : (MAP == 2 ? glu_map(nn) : nn);
        *(u32x2*)(WT + (size_t)row * K + k0 + 8 * c) = (u32x2){(unsigned)d0, (unsigned)d1}; }
    LDS_WAIT(); asm volatile("" ::: "memory");
}
__device__ __forceinline__ void phase0(Frame& F) {
    if (F.vcu < 96) {
        const int col = F.vcu * 64 + F.lane; const float* c = F.in(I_C); const float* wa = F.in(I_WADA);
        float a0 = 0.f, a1 = 0.f;
        for (int k = F.wave * 128; k < F.wave * 128 + 128; ++k) { const float c0 = c[k], c1 = c[1024 + k]; const float s0 = c0 * sigmoidf_(c0), s1 = c1 * sigmoidf_(c1); const float w = wa[(size_t)k * 6144 + col]; a0 += s0 * w; a1 += s1 * w; }
        LAS float* red = (LAS float*)F.lds;
        red[(F.wave * 2 + 0) * 64 + F.lane] = a0; red[(F.wave * 2 + 1) * 64 + F.lane] = a1;
        __syncthreads();
        if (F.wave == 0) { float s0 = 0.f, s1 = 0.f;
#pragma unroll
            for (int w = 0; w < 8; ++w) { s0 += red[(w * 2 + 0) * 64 + F.lane]; s1 += red[(w * 2 + 1) * 64 + F.lane]; }
            float* mod = (float*)(F.ws + WS_MOD); const float bb = F.in(I_BADA)[col]; mod[col] = s0 + bb; mod[6144 + col] = s1 + bb; }
        __syncthreads();
    }
    LAS float* scr = (LAS float*)(F.lds + F.wave * 16384);
    const int gw = F.vcu * NWAVES + F.wave, NGW = F.G * NWAVES;
    constexpr int I_IN = 16 * (NIN / 32), I_SQ = 16 * 32, I_EGU = 16 * 16, I_EDN = 4 * 32;
    constexpr int NITEMS = I_IN + 2 * I_SQ + NEX * I_EGU + NEX * I_EDN;
    for (int it = gw; it < NITEMS; it += NGW) {
        int r = it;
        if (r < I_IN) { transpose_item8<1>(F.in(I_WIN), 1024, NIN, (unsigned char*)(F.ws + WS_WIN), scr, r, F.lane); continue; } r -= I_IN;
        if (r < I_SQ) { transpose_item8<0>(F.in(I_WPW2), 1024, 1024, (unsigned char*)(F.ws + WS_WPW2), scr, r, F.lane); continue; } r -= I_SQ;
        if (r < I_SQ) { transpose_item<0>(F.in(I_WOUT), 1024, 1024, (bf16*)(F.ws + WS_WOUT), scr, r, F.lane); continue; } r -= I_SQ;
        if (r < NEX * I_EGU) { const int e = r / I_EGU, rr = r % I_EGU; const float* W = e < NE ? F.in(I_WEGU) + (size_t)e * 1024 * 512 : F.in(I_WSGU);
            transpose_item8<2>(W, 1024, 512, (unsigned char*)(F.ws + WS_WGU) + (size_t)e * 512 * 1024, scr, rr, F.lane); continue; } r -= NEX * I_EGU;
        { const int e = r / I_EDN, rr = r % I_EDN; const float* W = e < NE ? F.in(I_WEDN) + (size_t)e * 256 * 1024 : F.in(I_WSDN);
            transpose_item8<0>(W, 256, 1024, (unsigned char*)(F.ws + WS_WDN) + (size_t)e * 1024 * 256, scr, rr, F.lane, WDN_SCALE); }
    }
    {
        const float* wr = F.in(I_WR); bf16* wh = (bf16*)(F.ws + WS_WRH); bf16* wl = (bf16*)(F.ws + WS_WRL);
        for (int idx = F.vcu * NTHREADS + F.tid; idx < 64 * 1024; idx += F.G * NTHREADS) { const int e = idx >> 10, k = idx & 1023; const float w = wr[k * 64 + e];
            const unsigned h = cvt_pk_bf16(w, 0.f) & 0xffffu; const float r = w - bf_lo(h); wh[idx] = (bf16)h; wl[idx] = (bf16)(cvt_pk_bf16(r, 0.f) & 0xffffu); }
    }
    {
        const int* pos = (const int*)F.in(I_POS); float* rope = (float*)(F.ws + WS_ROPE);
        for (int idx = F.vcu * NTHREADS + F.tid; idx < T * 8; idx += F.G * NTHREADS) {
            const int tok = idx >> 3, i = idx & 7;
            const unsigned fb = i == 0 ? 1065353216u : i == 1 ? 1044812719u : i == 2 ? 1025116360u : i == 3 ? 1005516622u : i == 4 ? 985226530u : i == 5 ? 965724408u : i == 6 ? 945754309u : 925697960u;
            const float ang = (float)pos[tok] * __builtin_bit_cast(float, fb);
            double rv = (double)ang * 0.15915494309189535; rv -= floor(rv);
            const float fr_ = (float)rv;
            rope[tok * 16 + i] = __builtin_amdgcn_cosf(fr_); rope[tok * 16 + 8 + i] = __builtin_amdgcn_sinf(fr_);
        }
    }
}

__device__ __forceinline__ void phase1(Frame& F) {
    const float* mod = (const float*)(F.ws + WS_MOD); const float* gn = F.in(I_N1G); bf16* H = (bf16*)F.out;
    const int gw = F.vcu * NWAVES + F.wave, NGW = F.G * NWAVES;
    for (int m = gw; m < T; m += NGW) {
        const int b = m >> 14;
        const f32x4* xr = (const f32x4*)(F.in(I_X) + (size_t)m * D) + F.lane;
        f32x4 v[4]; float s = 0.f;
#pragma unroll
        for (int j = 0; j < 4; ++j) { v[j] = xr[64 * j]; s += (v[j].x * v[j].x + v[j].y * v[j].y) + (v[j].z * v[j].z + v[j].w * v[j].w); }
        const float rstd = __builtin_amdgcn_rsqf(wave_sum(s) * (1.f / D) + EPS);
        unsigned* o4 = (unsigned*)((unsigned char*)H + (size_t)m * D) + F.lane;
#pragma unroll
        for (int j = 0; j < 4; ++j) { const int col = 4 * F.lane + 256 * j;
            const f32x4 g = *(const f32x4*)(gn + col), sc = *(const f32x4*)(mod + b * 6144 + 1024 + col), sh = *(const f32x4*)(mod + b * 6144 + col);
            const f32x4 y = v[j] * rstd * g * (sc + 1.f) + sh;
            int w = 0; w = __builtin_amdgcn_cvt_pk_fp8_f32(y.x, y.y, w, false); w = __builtin_amdgcn_cvt_pk_fp8_f32(y.z, y.w, w, true); o4[64 * j] = (unsigned)w; }
    }
}

struct EpiIn {
    static constexpr bool PERM = true;
    static constexpr float SI = 1.f / WIN_SCALE;
    bf16 *U, *Q, *Kb, *V, *GC, *GA; const float* rope; const float* qg; const float* kg; LAS unsigned char* scr;
    __device__ __forceinline__ void operator()(const f32x4 (&acc)[2][2][4][2], const pg8::Unit& u, int wr, int wc, int fr, int fq) const {
        asm volatile("" : "+v"(fr), "+v"(fq));
        const int pn = u.pn, row0 = u.pm * 256 + wr * 64 + fr;
        if (pn < 8) {
#pragma unroll
            for (int ai = 0; ai < 2; ++ai)
#pragma unroll
                for (int m = 0; m < 4; ++m) { const int row = row0 + ai * 128 + m * 16; float r[8];
#pragma unroll
                    for (int n = 0; n < 2; ++n)
#pragma unroll
                        for (int i = 0; i < 4; ++i) r[4 * n + i] = (acc[ai][0][m][n][i] * SI) * sigmoidf_(acc[ai][1][m][n][i] * SI);
                    u32x4 w; w.x = cvt_pk_bf16(r[0], r[1]); w.y = cvt_pk_bf16(r[2], r[3]); w.z = cvt_pk_bf16(r[4], r[5]); w.w = cvt_pk_bf16(r[6], r[7]);
                    *(u32x4*)(U + (size_t)row * D + pn * 128 + wc * 32 + fq * 8) = w; }
        } else if (pn < 16) {
            const bool isq = pn < 12; const int g = 4 * ((pn - 8) & 3) + wc, h = g >> 1, mp = g & 1;
            const float* gp = isq ? qg : kg; float gn[2][8];
#pragma unroll
            for (int bj = 0; bj < 2; ++bj)
#pragma unroll
                for (int e = 0; e < 8; ++e) gn[bj][e] = gp[qk_dim(bj, fq, e)] * (isq ? C2 * QSC : 1.f);
            bf16* dst = isq ? Q : Kb;
#pragma unroll
            for (int ai = 0; ai < 2; ++ai)
#pragma unroll
                for (int m = 0; m < 4; ++m) { const int row = row0 + ai * 128 + m * 16, b = row >> 14, s = row & (SEQ - 1);
                    float v[2][8]; float ss = 0.f;
#pragma unroll
                    for (int bj = 0; bj < 2; ++bj)
#pragma unroll
                        for (int n = 0; n < 2; ++n)
#pragma unroll
                            for (int i = 0; i < 4; ++i) { const float t = acc[ai][bj][m][n][i] * SI; v[bj][4 * n + i] = t; ss += t * t; }
                    ss += __shfl_xor(ss, 16); ss += __shfl_xor(ss, 32);
                    const float rstd = __builtin_amdgcn_rsqf(ss * (1.f / 64.f) + EPS);
#pragma unroll
                    for (int bj = 0; bj < 2; ++bj)
#pragma unroll
                        for (int e = 0; e < 8; ++e) v[bj][e] = v[bj][e] * rstd * gn[bj][e];
                    if (fq == 0) { const f32x4* rp = (const f32x4*)(rope + (size_t)row * 16); const f32x4 c0 = rp[0], c1 = rp[1], s0 = rp[2], s1 = rp[3];
#pragma unroll
                        for (int e = 0; e < 8; ++e) { const float cs = e < 4 ? c0[e & 3] : c1[e & 3], sn = e < 4 ? s0[e & 3] : s1[e & 3]; const float x1 = v[0][e], x2 = v[1][e];
                            v[0][e] = x1 * cs - x2 * sn; v[1][e] = x2 * cs + x1 * sn; } }
                    unsigned char* rowp = (unsigned char*)dst + ((size_t)((b * 8 + h) * 2 + mp) * SEQ + s) * 64;
                    const int sw = isq ? 0 : ((s >> 2) & 3);
                    u32x4 w;
                    { int d;
                      d = 0; d = __builtin_amdgcn_cvt_pk_fp8_f32(v[0][0], v[0][1], d, false); d = __builtin_amdgcn_cvt_pk_fp8_f32(v[0][2], v[0][3], d, true); w.x = (unsigned)d;
                      d = 0; d = __builtin_amdgcn_cvt_pk_fp8_f32(v[0][4], v[0][5], d, false); d = __builtin_amdgcn_cvt_pk_fp8_f32(v[0][6], v[0][7], d, true); w.y = (unsigned)d;
                      d = 0; d = __builtin_amdgcn_cvt_pk_fp8_f32(v[1][0], v[1][1], d, false); d = __builtin_amdgcn_cvt_pk_fp8_f32(v[1][2], v[1][3], d, true); w.z = (unsigned)d;
                      d = 0; d = __builtin_amdgcn_cvt_pk_fp8_f32(v[1][4], v[1][5], d, false); d = __builtin_amdgcn_cvt_pk_fp8_f32(v[1][6], v[1][7], d, true); w.w = (unsigned)d; }
                    *(u32x4*)(rowp + ((fq ^ sw) << 4)) = w; }
        } else if (pn < 20) {
            LAS unsigned char* wsb = scr + (wr * 4 + wc) * 2048; const int lane_ = fr + 16 * fq;
#pragma unroll
            for (int ai = 0; ai < 2; ++ai)
#pragma unroll
                for (int bj = 0; bj < 2; ++bj) {
#pragma unroll
                    for (int m = 0; m < 4; ++m) { const int kk = 16 * m + fr;
                        const int p = 32 * ((kk >> 2) & 1) + 16 * (kk >> 5) + (kk & 3) + 4 * ((kk & 31) >> 3);
#pragma unroll
                        for (int n = 0; n < 2; ++n) { const unsigned d01 = (unsigned)__builtin_amdgcn_cvt_pk_fp8_f32(acc[ai][bj][m][n][0] * SI, acc[ai][bj][m][n][1] * SI, 0, false);
                            const unsigned d23 = (unsigned)__builtin_amdgcn_cvt_pk_fp8_f32(acc[ai][bj][m][n][2] * SI, acc[ai][bj][m][n][3] * SI, 0, false);
#pragma unroll
                            for (int i = 0; i < 4; ++i) { const int e = 4 * n + i; const unsigned byte = ((i < 2 ? d01 : d23) >> (8 * (i & 1)));
                                const int sw = (2 * fq + (e >> 2)) & 3;
                                wsb[(fq * 8 + e) * 64 + ((((p >> 4) ^ sw) << 4) | (p & 15))] = (unsigned char)byte; } } }
                    LDS_WAIT(); asm volatile("" ::: "memory");
                    const u32x4 t0 = *(const LAS u32x4*)(wsb + lane_ * 32), t1 = *(const LAS u32x4*)(wsb + lane_ * 32 + 16);
                    const int row = u.pm * 256 + ai * 128 + wr * 64, b = row >> 14, s = row & (SEQ - 1), h = 2 * (pn - 16) + bj;
                    unsigned char* tp = (unsigned char*)V + (((size_t)(b * 8 + h) * 256 + (s >> 6)) * 128 + wc * 32) * 64 + lane_ * 32;
                    *(u32x4*)tp = t0; *(u32x4*)(tp + 16) = t1;
                    LDS_WAIT(); asm volatile("" ::: "memory"); }
        } else {
            bf16* dst = pn < 24 ? GC : GA; const int colt = ((pn - 20) & 3) * 256;
#pragma unroll
            for (int ai = 0; ai < 2; ++ai)
#pragma unroll
                for (int m = 0; m < 4; ++m) { const int row = row0 + ai * 128 + m * 16;
#pragma unroll
                    for (int bj = 0; bj < 2; ++bj) { float r[8];
#pragma unroll
                        for (int n = 0; n < 2; ++n)
#pragma unroll
                            for (int i = 0; i < 4; ++i) r[4 * n + i] = sigmoidf_(acc[ai][bj][m][n][i] * SI);
                        u32x4 w; w.x = cvt_pk_bf16(r[0], r[1]); w.y = cvt_pk_bf16(r[2], r[3]); w.z = cvt_pk_bf16(r[4], r[5]); w.w = cvt_pk_bf16(r[6], r[7]);
                        *(u32x4*)(dst + (size_t)row * D + colt + bj * 128 + wc * 32 + fq * 8) = w; } }
        }
    }
};

__device__ __forceinline__ void phase3(Frame& F) {
    const bf16* U = (const bf16*)(F.ws + WS_U); bf16* CV = (bf16*)F.out;
    const int ch = 2 * F.tid;
    float wa[31], wb[31];
#pragma unroll
    for (int j = 0; j < 31; ++j) { const f32x2 w = *(const f32x2*)(F.in(I_CDW) + j * 1024 + ch); wa[j] = w.x; wb[j] = w.y; }
    const f32x2 cb = *(const f32x2*)(F.in(I_CDWB) + ch);
    LAS float* tile = (LAS float*)F.lds;
    for (int unit = F.vcu; unit < T / 64; unit += F.G) {
        const int t0 = unit * 64, s0 = t0 & (SEQ - 1);
        float xa[38], xb[38];
#pragma unroll
        for (int k = 0; k < 30; ++k) { unsigned v = 0u; if (s0 - 30 + k >= 0) v = *(const unsigned*)(U + (size_t)(t0 - 30 + k) * D + ch); xa[k] = bf_lo(v); xb[k] = bf_hi(v); }
        for (int blk = 0; blk < 8; ++blk) {
#pragma unroll
            for (int k = 0; k < 8; ++k) { const unsigned v = *(const unsigned*)(U + (size_t)(t0 + blk * 8 + k) * D + ch); xa[30 + k] = bf_lo(v); xb[30 + k] = bf_hi(v); }
            LAS float* tl = tile + (blk & 1) * 8192;
#pragma unroll
            for (int i = 0; i < 8; ++i) { float a = cb.x, b = cb.y;
#pragma unroll
                for (int j = 0; j < 31; ++j) { a += xa[i + j] * wa[j]; b += xb[i + j] * wb[j]; }
                *(LAS f32x2*)(tl + i * 1024 + ch) = (f32x2){a, b}; }
#pragma unroll
            for (int k = 0; k < 30; ++k) { xa[k] = xa[k + 8]; xb[k] = xb[k + 8]; }
            __syncthreads();
            {
                const LAS float* rowp = tl + F.wave * 1024;
                f32x4 v[4];
#pragma unroll
                for (int jj = 0; jj < 2; ++jj) { v[2 * jj] = *(const LAS f32x4*)(rowp + 512 * jj + 8 * F.lane); v[2 * jj + 1] = *(const LAS f32x4*)(rowp + 512 * jj + 8 * F.lane + 4); }
                float s = 0.f;
#pragma unroll
                for (int q = 0; q < 4; ++q) s += (v[q].x + v[q].y) + (v[q].z + v[q].w);
                const float mean = wave_sum(s) * (1.f / D); float s2 = 0.f;
#pragma unroll
                for (int q = 0; q < 4; ++q) { v[q] = v[q] - mean; s2 += (v[q].x * v[q].x + v[q].y * v[q].y) + (v[q].z * v[q].z + v[q].w * v[q].w); }
                const float rstd = __builtin_amdgcn_rsqf(wave_sum(s2) * (1.f / D) + EPS);
                bf16* op = (bf16*)((unsigned char*)CV + (size_t)(t0 + blk * 8 + F.wave) * D);
#pragma unroll
                for (int jj = 0; jj < 2; ++jj) { const int col = 512 * jj + 8 * F.lane; float r[8];
#pragma unroll
                    for (int q = 0; q < 2; ++q) { const f32x4 g = *(const f32x4*)(F.in(I_CLNG) + col + 4 * q), bb = *(const f32x4*)(F.in(I_CLNB) + col + 4 * q); const f32x4 y = v[2 * jj + q] * rstd * g + bb;
#pragma unroll
                        for (int i = 0; i < 4; ++i) r[4 * q + i] = y[i] * sigmoidf_(y[i]); }
                    int d0 = 0, d1 = 0;
                    d0 = __builtin_amdgcn_cvt_pk_fp8_f32(r[0], r[1], d0, false); d0 = __builtin_amdgcn_cvt_pk_fp8_f32(r[2], r[3], d0, true);
                    d1 = __builtin_amdgcn_cvt_pk_fp8_f32(r[4], r[5], d1, false); d1 = __builtin_amdgcn_cvt_pk_fp8_f32(r[6], r[7], d1, true);
                    *(u32x2*)((unsigned char*)op + col) = (u32x2){(unsigned)d0, (unsigned)d1}; }
            }
        }
        __syncthreads();
    }
}

struct EpiPw2 {
    static constexpr bool PERM = true;
    bf16* O; const bf16* GC; const float* bias;
    __device__ __forceinline__ void operator()(const f32x4 (&acc)[2][2][4][2], const pg8::Unit& u, int wr, int wc, int fr, int fq) const {
        const int row0 = u.pm * 256 + wr * 64 + fr, col0 = u.pn * 256 + wc * 32 + fq * 8;
#pragma unroll
        for (int ai = 0; ai < 2; ++ai)
#pragma unroll
            for (int m = 0; m < 4; ++m) { const int row = row0 + ai * 128 + m * 16;
#pragma unroll
                for (int bj = 0; bj < 2; ++bj) { const int col = col0 + bj * 128; const u32x4 gv = *(const u32x4*)(GC + (size_t)row * D + col);
                    const f32x4 b0 = *(const f32x4*)(bias + col), b1 = *(const f32x4*)(bias + col + 4); float r[8];
#pragma unroll
                    for (int i = 0; i < 4; ++i) { r[i] = acc[ai][bj][m][0][i] * (1.f / WIN_SCALE) + b0[i]; r[4 + i] = acc[ai][bj][m][1][i] * (1.f / WIN_SCALE) + b1[i]; }
                    r[0] *= bf_lo(gv.x); r[1] *= bf_hi(gv.x); r[2] *= bf_lo(gv.y); r[3] *= bf_hi(gv.y); r[4] *= bf_lo(gv.z); r[5] *= bf_hi(gv.z); r[6] *= bf_lo(gv.w); r[7] *= bf_hi(gv.w);
                    u32x4 w; w.x = cvt_pk_bf16(r[0], r[1]); w.y = cvt_pk_bf16(r[2], r[3]); w.z = cvt_pk_bf16(r[4], r[5]); w.w = cvt_pk_bf16(r[6], r[7]);
                    *(u32x4*)(O + (size_t)row * D + col) = w; } }
    }
};

namespace att {
constexpr int SLOT = 32768, NSLOT = 3, XOFF = NSLOT * SLOT;
typedef int i32x8 __attribute__((ext_vector_type(8)));
__device__ __forceinline__ int crow(int r, int hi) { return (r & 3) + 8 * (r >> 2) + 4 * hi; }
__device__ __forceinline__ s16x4 vtr(const LAS char* p) { typedef short v4i16_t __attribute__((ext_vector_type(4))); return __builtin_bit_cast(s16x4, __builtin_amdgcn_ds_read_tr16_b64_v4i16((LAS v4i16_t*)p)); }
#define BUF_DMA16(m0v, voff, srd, soff) asm volatile("s_mov_b32 m0, %0\n\ts_nop 0\n\tbuffer_load_dwordx4 %1, %2, %3 offen lds" :: "s"(m0v), "v"(voff), "s"(srd), "s"(soff) : "m0", "memory")
#define ATT_SB() __builtin_amdgcn_sched_barrier(0)
#ifndef VLA
#define VLA 4
#endif
struct DmaSet { unsigned m0[2], so[2]; };
__device__ __forceinline__ f32x16 zacc() { return (f32x16){0.f, 0.f, 0.f, 0.f, 0.f, 0.f, 0.f, 0.f, 0.f, 0.f, 0.f, 0.f, 0.f, 0.f, 0.f, 0.f}; }
__device__ __forceinline__ f32x16 mfma8(i32x8 a, i32x8 b, f32x16 c) { return __builtin_amdgcn_mfma_scale_f32_32x32x64_f8f6f4(a, b, c, 0, 0, 0, 0, 0, 0); }
#define ATT_KFRAG(kp, blk) ({ const u32x4 lo_ = *(const LAS u32x4*)((kp) + (blk) * 2048 + kc0), hi_ = *(const LAS u32x4*)((kp) + (blk) * 2048 + kc1); \
        (i32x8){(int)lo_.x, (int)lo_.y, (int)lo_.z, (int)lo_.w, (int)hi_.x, (int)hi_.y, (int)hi_.z, (int)hi_.w}; })
template <bool MASK>
__device__ __forceinline__ void shift_mask(f32x16& c0, f32x16& c1, int kb, int qrow, float negM, bool shift) {
    if (shift) {
#pragma unroll
        for (int r = 0; r < 16; ++r) { c0[r] += negM; c1[r] += negM; } }
    if (MASK) {
#pragma unroll
        for (int r = 0; r < 16; ++r) { const int kv = kb + (r & 3) + 8 * (r >> 2); if (kv > qrow) c0[r] = -INFINITY; if (kv + 32 > qrow) c1[r] = -INFINITY; } }
}
#define ATT_VFRAG(dst, i) do { const s16x4 lo_ = vtr(vp + ((i) & 3) * 4096 + ((i) >> 2) * 1024), hh_ = vtr(vp + ((i) & 3) * 4096 + ((i) >> 2) * 1024 + 512); \
        dst = (bf16x8){lo_[0], lo_[1], lo_[2], lo_[3], hh_[0], hh_[1], hh_[2], hh_[3]}; } while (0)
__device__ __forceinline__ int exp2_bf8x4(float a, float b, float c, float d) {
    unsigned w = __builtin_amdgcn_cvt_pk_u8_f32(a, 0u, 0u); w = __builtin_amdgcn_cvt_pk_u8_f32(b, 1u, w); w = __builtin_amdgcn_cvt_pk_u8_f32(c, 2u, w); w = __builtin_amdgcn_cvt_pk_u8_f32(d, 3u, w);
    return (int)w;
}
__device__ __forceinline__ f32x16 mfma_pv(i32x8 p, i32x8 v, f32x16 c) { return __builtin_amdgcn_mfma_scale_f32_32x32x64_f8f6f4(p, v, c, 1, 0, 0, 0, 0, 0); }
template <bool SECOND>
__device__ __forceinline__ void mask16(f32x16& c, int kb, int qrow) {
    int d = qrow - kb; asm volatile("" : "+v"(d));
#pragma unroll
    for (int r = 0; r < 16; ++r) { if ((r & 3) + 8 * (r >> 2) + (SECOND ? 32 : 0) > d) c[r] = -1e30f; }
}
__device__ __forceinline__ void att_step(bool MASK, f32x16 (&o)[4], i32x8 (&kf)[2], const i32x8& qf, const f32x16& cinit, f32x16& lacc, const i32x8& ones, const i32x8& pfp, i32x8& pfc,
                                         const LAS char* vp, const LAS char* kpn, int kc0, int kc1, int kb, int qrow,
                                         const DmaSet& dm, unsigned vdma, __amdgpu_buffer_rsrc_t srdK, __amdgpu_buffer_rsrc_t srdV) {
    i32x8 vf[4]; f32x16 c0, c1;
    vf[0] = ATT_KFRAG(vp, 0); vf[1] = ATT_KFRAG(vp, 1);
    c0 = mfma8(kf[0], qf, cinit);
    vf[2] = ATT_KFRAG(vp, 2); vf[3] = ATT_KFRAG(vp, 3);
    c1 = mfma8(kf[1], qf, cinit);
    ATT_SB();
#pragma unroll
    for (int i = 0; i < 4; ++i) {
        o[i] = mfma_pv(pfp, vf[i], o[i]);
        if (i == 0) BUF_DMA16(dm.m0[0], vdma, srdK, dm.so[0]);
        if (i == 1) kf[0] = ATT_KFRAG(kpn, 0);
        if (i == 2) kf[1] = ATT_KFRAG(kpn, 1);
        if (MASK && i == 0) mask16<false>(c0, kb, qrow);
        if (MASK && i == 2) mask16<true>(c1, kb, qrow);
        { const f32x16& C = i < 2 ? c0 : c1; const int e = 8 * (i & 1);
          int w0 = exp2_bf8x4(C[e], C[e + 1], C[e + 2], C[e + 3]), w1 = exp2_bf8x4(C[e + 4], C[e + 5], C[e + 6], C[e + 7]);
          asm volatile("" : "+v"(w0), "+v"(w1)); pfc[2 * i] = w0; pfc[2 * i + 1] = w1; }
        if (i == 3) BUF_DMA16(dm.m0[1], vdma, srdV, dm.so[1]);
        ATT_SB();
    }
    lacc = mfma_pv(pfp, ones, lacc);
}
__device__ __forceinline__ void att_drain(f32x16 (&o)[4], const i32x8& pf, f32x16& lacc, const i32x8& ones, const LAS char* vp, int kc0, int kc1) {
#pragma unroll
    for (int i = 0; i < 4; ++i) { const i32x8 f = ATT_KFRAG(vp, i); o[i] = mfma_pv(pf, f, o[i]); }
    lacc = mfma_pv(pf, ones, lacc);
}

__device__ __forceinline__ void phase5(Frame& F, bf16* MGout) {
    const bf16* GA = (const bf16*)(F.ws + WS_GA); bf16* MG = (bf16*)(F.ws + WS_U);
    const int lane = F.lane, r32 = lane & 31, hi = lane >> 5, wid = F.wave, rg = wid & 3, mp = wid >> 2;
    float lam;
    {
        const float q1 = F.in(I_LQ1)[lane], k1 = F.in(I_LK1)[lane], q2 = F.in(I_LQ2)[lane], k2 = F.in(I_LK2)[lane];
        lam = __expf(wave_sum(q1 * k1)) - __expf(wave_sum(q2 * k2)) + LAMBDA_INIT;
    }
    f32x16 cinit;
    { float pb = PBIAS; asm volatile("" : "+v"(pb));
#pragma unroll
      for (int r = 0; r < 16; ++r) cinit[r] = pb; }
    const i32x8 ones = {0x38383838, 0x38383838, 0x38383838, 0x38383838, 0x38383838, 0x38383838, 0x38383838, 0x38383838};
    LAS char* ring = (LAS char*)F.lds;
    const unsigned ring0 = (unsigned)(size_t)ring;
    const int voff = r32 * 64;
    const int ksw = (r32 >> 2) & 3;
    const int koff = r32 * 64 + mp * 4096, kc0 = ((2 * hi) ^ ksw) << 4, kc1 = ((2 * hi + 1) ^ ksw) << 4;
    const __amdgpu_buffer_rsrc_t srdK = __builtin_amdgcn_make_buffer_rsrc((void*)(F.ws + WS_K), (short)0, 64 << 20, 0x00020000);
    const __amdgpu_buffer_rsrc_t srdV = __builtin_amdgcn_make_buffer_rsrc((void*)(F.ws + WS_V), (short)0, 64 << 20, 0x00020000);
    const __amdgpu_buffer_rsrc_t srdQ = __builtin_amdgcn_make_buffer_rsrc((void*)(F.ws + WS_Q), (short)0, 64 << 20, 0x00020000);
    const unsigned vdma = (unsigned)(wid * 1024 + lane * 16);
    const unsigned vdmk = (unsigned)((wid & 3) * 1024 + lane * 16);
    const unsigned vq = (unsigned)(r32 * 64 + hi * 32);
    if (wid >= 4) __builtin_amdgcn_s_setprio(1);
#ifndef DBG_ATT2
#define DBG_ATT2 0
#endif
    for (int p_ = F.vcu; p_ < (DBG_ATT2 ? 2048 : 1024); p_ += F.G) {
        const int p = p_ & 1023; bf16* const MGo = (DBG_ATT2 && p_ < 1024) ? (bf16*)F.out : MGout;
        const int bh = p >> 6, j = p & 63;
        for (int half = 0; half < 2; ++half) {
            const int qt = half == 0 ? j : 127 - j;
            const int NT = 2 * (qt + 1);
            const unsigned kxoff = (unsigned)(bh * 2 + (wid >> 2)) * (SEQ * 64u), voffg = (unsigned)bh * (256u * 8192u);
#define ATT_ISSUE_K(tk_, dst_) do { const unsigned tk__ = (unsigned)((tk_) < NT ? (tk_) : NT - 1) * 4096u; BUF_DMA16(ring0 + (dst_) + wid * 1024, vdmk, srdK, kxoff + tk__); } while (0)
#define ATT_ISSUE_V(tv_, dst_) do { const unsigned tv__ = voffg + (unsigned)((tv_) < NT ? (tv_) : NT - 1) * 8192u; BUF_DMA16(ring0 + (dst_) + wid * 1024, vdma, srdV, tv__); } while (0)
            u32x4 q0, q1;
            { const unsigned qs = ((unsigned)(bh * 2 + mp) * SEQ + (unsigned)(qt * 128 + rg * 32)) * 64u;
              asm volatile("buffer_load_dwordx4 %0, %2, %3, %4 offen\n\tbuffer_load_dwordx4 %1, %2, %3, %4 offen offset:16"
                           : "=&v"(q0), "=&v"(q1) : "v"(vq), "s"(srdQ), "s"(qs) : "memory"); }
            ATT_ISSUE_K(0, XOFF); ATT_ISSUE_K(1, XOFF + 16384);
            ATT_ISSUE_K(2, 0); ATT_ISSUE_V(0, 16384);
            ATT_ISSUE_K(3, SLOT); ATT_ISSUE_V(1, SLOT + 16384);
            asm volatile("s_waitcnt vmcnt(4)\n\ts_barrier" : "+v"(q0), "+v"(q1) :: "memory");
            const i32x8 qf = {(int)q0.x, (int)q0.y, (int)q0.z, (int)q0.w, (int)q1.x, (int)q1.y, (int)q1.z, (int)q1.w};
            f32x16 o[4];
#pragma unroll
            for (int vb = 0; vb < 4; ++vb)
#pragma unroll
                for (int r = 0; r < 16; ++r) o[vb][r] = 0.f;
            f32x16 lacc = zacc();
            const int qrow = qt * 128 + rg * 32 + r32;
            i32x8 kf[2], pfA, pfB;
            { const LAS char* kp0 = ring + XOFF + koff; f32x16 c0, c1;
              kf[0] = ATT_KFRAG(kp0, 0); kf[1] = ATT_KFRAG(kp0, 1);
              c0 = mfma8(kf[0], qf, cinit); c1 = mfma8(kf[1], qf, cinit);
              if (NT == 2) { mask16<false>(c0, 4 * hi, qrow); mask16<true>(c1, 4 * hi, qrow); }
#pragma unroll
              for (int d = 0; d < 8; ++d) { const f32x16& C = d < 4 ? c0 : c1; const int e = 4 * (d & 3); pfA[d] = exp2_bf8x4(C[e], C[e + 1], C[e + 2], C[e + 3]); } }
            { const LAS char* kp1 = ring + XOFF + 16384 + koff; kf[0] = ATT_KFRAG(kp1, 0); kf[1] = ATT_KFRAG(kp1, 1); }
            unsigned sl_use = 0, sl_mid = SLOT, sl_new = 2 * SLOT;
#define ATT_STEP(MASKED, PFC, PFP, t_) do { asm volatile("s_waitcnt vmcnt(2) lgkmcnt(0)\n\ts_barrier" ::: "memory"); \
                DmaSet dm; { const unsigned tk__ = (unsigned)(((t_) + 3) < NT ? ((t_) + 3) : NT - 1) * 4096u, tv__ = voffg + (unsigned)(((t_) + 1) < NT ? ((t_) + 1) : NT - 1) * 8192u, d__ = ring0 + sl_new + wid * 1024; \
                    dm.m0[0] = d__; dm.m0[1] = d__ + 16384u; dm.so[0] = kxoff + tk__ - (unsigned)(wid >> 2) * 4096u; dm.so[1] = tv__; }   \
                { const LAS char* vp = ring + sl_use + 16384 + voff; const LAS char* kpn = ring + sl_use + koff; \
                  att_step(MASKED, o, kf, qf, cinit, lacc, ones, PFP, PFC, vp, kpn, kc0, kc1, 64 * (t_) + 4 * hi, qrow, dm, vdma, srdK, srdV); } \
                { const unsigned t__ = sl_use; sl_use = sl_mid; sl_mid = sl_new; sl_new = t__; } } while (0)
            int t = 1;
            for (; t + 1 < NT; t += 2) { ATT_STEP(false, pfB, pfA, t); ATT_STEP((t + 1 >= NT - 2), pfA, pfB, t + 1); }
            ATT_STEP(true, pfB, pfA, NT - 1);
            asm volatile("s_waitcnt vmcnt(0) lgkmcnt(0)\n\ts_barrier" ::: "memory");
            att_drain(o, pfB, lacc, ones, ring + sl_use + 16384 + voff, kc0, kc1);
#undef ATT_STEP
#undef ATT_ISSUE_K
#undef ATT_ISSUE_V
            float rl[16];
#pragma unroll
            for (int r = 0; r < 16; ++r) rl[r] = __builtin_amdgcn_rcpf(lacc[r]);
            asm volatile("s_waitcnt vmcnt(0) lgkmcnt(0)\n\ts_barrier" ::: "memory");
            LAS float* xch = (LAS float*)ring + rg * 4096;
            if (mp == 1) {
#pragma unroll
                for (int vb = 0; vb < 4; ++vb)
#pragma unroll
                    for (int r = 0; r < 16; ++r) xch[(vb * 16 + r) * 64 + lane] = o[vb][r] * rl[r] * lam;
            }
            asm volatile("s_waitcnt lgkmcnt(0)\n\ts_barrier" ::: "memory");
            if (mp == 0) {
                float ssq[16];
#pragma unroll
                for (int r = 0; r < 16; ++r) ssq[r] = 0.f;
#pragma unroll
                for (int vb = 0; vb < 4; ++vb)
#pragma unroll
                    for (int r = 0; r < 16; ++r) { const float d = o[vb][r] * rl[r] - xch[(vb * 16 + r) * 64 + lane]; o[vb][r] = d; ssq[r] += d * d; }
#pragma unroll
                for (int r = 0; r < 16; ++r) { float s = ssq[r];
#pragma unroll
                    for (int off = 1; off < 32; off <<= 1) s += __shfl_xor(s, off);
                    ssq[r] = __builtin_amdgcn_rsqf(s * (1.f / 128.f) + EPS) * (1.f - LAMBDA_INIT); }
#pragma unroll
                for (int vb = 0; vb < 4; ++vb)
#pragma unroll
                    for (int r = 0; r < 16; ++r) xch[(vb * 16 + r) * 64 + lane] = o[vb][r] * ssq[r];
            }
            asm volatile("s_waitcnt lgkmcnt(0)\n\ts_barrier" ::: "memory");
            {
                const int b = bh >> 3, h = bh & 7, q = F.tid >> 2, vb = F.tid & 3, q5 = q & 31;
                const int rr = (q5 & 3) + 4 * (q5 >> 3), hh = (q5 >> 2) & 1;
                const LAS float* src = (const LAS float*)ring + (q >> 5) * 4096 + (vb * 16 + rr) * 64 + hh * 32;
                const size_t idx = ((size_t)b * SEQ + qt * 128 + q) * D + h * 128 + vb * 32;
                const float* sgp = F.in(I_SUBG) + vb * 32; asm volatile("" : "+v"(sgp));
#pragma unroll
                for (int c8 = 0; c8 < 4; ++c8) { const f32x4 y0 = *(const LAS f32x4*)(src + c8 * 8), y1 = *(const LAS f32x4*)(src + c8 * 8 + 4);
                    const f32x4 g0 = *(const f32x4*)(sgp + c8 * 8), g1 = *(const f32x4*)(sgp + c8 * 8 + 4);
                    const u32x4 ga = *(const u32x4*)(GA + idx + c8 * 8), mc = *(const u32x4*)(MG + idx + c8 * 8);
                    u32x4 w;
                    w.x = cvt_pk_bf16(y0[0] * g0[0] * bf_lo(ga.x) + bf_lo(mc.x), y0[1] * g0[1] * bf_hi(ga.x) + bf_hi(mc.x));
                    w.y = cvt_pk_bf16(y0[2] * g0[2] * bf_lo(ga.y) + bf_lo(mc.y), y0[3] * g0[3] * bf_hi(ga.y) + bf_hi(mc.y));
                    w.z = cvt_pk_bf16(y1[0] * g1[0] * bf_lo(ga.z) + bf_lo(mc.z), y1[1] * g1[1] * bf_hi(ga.z) + bf_hi(mc.z));
                    w.w = cvt_pk_bf16(y1[2] * g1[2] * bf_lo(ga.w) + bf_lo(mc.w), y1[3] * g1[3] * bf_hi(ga.w) + bf_hi(mc.w));
                    *(u32x4*)(MGo + idx + c8 * 8) = w; }
            }
            asm volatile("s_waitcnt vmcnt(0) lgkmcnt(0)\n\ts_barrier" ::: "memory");
        }
    }
    __builtin_amdgcn_s_setprio(0);
}
}

struct EpiOut {
    static constexpr bool PERM = true;
    const float* X; float* O; const float* mod;
    __device__ __forceinline__ void operator()(const f32x4 (&acc)[2][2][4][2], const pg8::Unit& u, int wr, int wc, int fr, int fq) const {
        const int row0 = u.pm * 256 + wr * 64 + fr, col0 = u.pn * 256 + wc * 32 + fq * 8;
#pragma unroll
        for (int ai = 0; ai < 2; ++ai)
#pragma unroll
            for (int m = 0; m < 4; ++m) { const int row = row0 + ai * 128 + m * 16, b = row >> 14;
#pragma unroll
                for (int bj = 0; bj < 2; ++bj)
#pragma unroll
                    for (int n = 0; n < 2; ++n) { const int col = col0 + bj * 128 + 4 * n; const f32x4 g = *(const f32x4*)(mod + b * 6144 + 2048 + col), xv = *(const f32x4*)(X + (size_t)row * D + col);
                        *(f32x4*)(O + (size_t)row * D + col) = xv + g * acc[ai][bj][m][n]; } }
    }
};

__device__ __forceinline__ void phase7(Frame& F) {
    const float* X1 = F.out; const float* mod = (const float*)(F.ws + WS_MOD); const float* gn = F.in(I_N2G); bf16* H2 = (bf16*)(F.ws + WS_U);
    constexpr int PITCH = 272;
    LAS char* Ahi = (LAS char*)F.lds;
    LAS char* Alo = Ahi + 128 * PITCH;
    LAS char* Whi = Alo + 128 * PITCH;
    LAS char* Wlo = Whi + 64 * PITCH;
    LAS float* RS = (LAS float*)(F.lds + 104448);
    LAS int* CW = (LAS int*)(F.lds + 104960);
    LAS unsigned char* RK = (LAS unsigned char*)(F.lds + 105472);
    LAS float* LG = (LAS float*)F.lds;
    const int tid = F.tid, lane = F.lane, wid = F.wave, r32 = lane & 31, hi = lane >> 5;
    const bf16* WRH = (const bf16*)(F.ws + WS_WRH); const bf16* WRL = (const bf16*)(F.ws + WS_WRL);
    for (int chunk = F.vcu; chunk < T / 128; chunk += F.G) {
        const int t0 = chunk * 128, b = t0 >> 14;
        for (int i4 = 0; i4 < 16; i4 += 4) {
            f32x4 v[4][4]; float ss[4];
#pragma unroll
            for (int u = 0; u < 4; ++u) { const f32x4* xr = (const f32x4*)(X1 + (size_t)(t0 + wid * 16 + i4 + u) * D) + lane;
#pragma unroll
                for (int j = 0; j < 4; ++j) v[u][j] = xr[64 * j]; }
#pragma unroll
            for (int u = 0; u < 4; ++u) { float s = 0.f;
#pragma unroll
                for (int j = 0; j < 4; ++j) s += (v[u][j].x * v[u][j].x + v[u][j].y * v[u][j].y) + (v[u][j].z * v[u][j].z + v[u][j].w * v[u][j].w);
                ss[u] = s; }
#pragma unroll
            for (int o_ = 1; o_ < 64; o_ <<= 1) {
#pragma unroll
                for (int u = 0; u < 4; ++u) ss[u] += __shfl_xor(ss[u], o_); }
#pragma unroll
            for (int u = 0; u < 4; ++u) { const int m = t0 + wid * 16 + i4 + u; const float rstd = __builtin_amdgcn_rsqf(ss[u] * (1.f / D) + EPS);
                if (lane == 0) RS[wid * 16 + i4 + u] = rstd;
                unsigned* o4 = (unsigned*)((unsigned char*)H2 + (size_t)m * D) + lane;
#pragma unroll
                for (int j = 0; j < 4; ++j) { const int col = 4 * lane + 256 * j;
                    const f32x4 g = *(const f32x4*)(gn + col), sc = *(const f32x4*)(mod + b * 6144 + 4096 + col), sh = *(const f32x4*)(mod + b * 6144 + 3072 + col);
                    const f32x4 y = v[u][j] * rstd * g * (sc + 1.f) + sh;
                    int w = 0; w = __builtin_amdgcn_cvt_pk_fp8_f32(y.x, y.y, w, false); w = __builtin_amdgcn_cvt_pk_fp8_f32(y.z, y.w, w, true); o4[64 * j] = (unsigned)w; } } }
        __syncthreads();
        f32x16 c;
#pragma unroll
        for (int r = 0; r < 16; ++r) c[r] = 0.f;
        const int tb = wid & 3, eb = wid >> 2;
        for (int ks = 0; ks < 8; ++ks) {
            { const int row = tid & 127, seg = tid >> 7; const float rstd = RS[row];
              const float* xp = X1 + (size_t)(t0 + row) * D + ks * 128 + seg * 32;
              unsigned wh[16], wl[16];
#pragma unroll
              for (int q = 0; q < 8; ++q) { const int col = ks * 128 + seg * 32 + 4 * q; const f32x4 xv = *(const f32x4*)(xp + 4 * q);
                  const f32x4 g = *(const f32x4*)(gn + col), sc = *(const f32x4*)(mod + b * 6144 + 4096 + col), sh = *(const f32x4*)(mod + b * 6144 + 3072 + col);
                  const f32x4 y = xv * rstd * g * (sc + 1.f) + sh;
                  const unsigned h0 = cvt_pk_bf16(y.x, y.y), h1 = cvt_pk_bf16(y.z, y.w);
                  wh[2 * q] = h0; wh[2 * q + 1] = h1;
                  wl[2 * q] = cvt_pk_bf16(y.x - bf_lo(h0), y.y - bf_hi(h0)); wl[2 * q + 1] = cvt_pk_bf16(y.z - bf_lo(h1), y.w - bf_hi(h1)); }
#pragma unroll
              for (int q = 0; q < 4; ++q) { *(LAS u32x4*)(Ahi + row * PITCH + seg * 64 + q * 16) = (u32x4){wh[4 * q], wh[4 * q + 1], wh[4 * q + 2], wh[4 * q + 3]};
                  *(LAS u32x4*)(Alo + row * PITCH + seg * 64 + q * 16) = (u32x4){wl[4 * q], wl[4 * q + 1], wl[4 * q + 2], wl[4 * q + 3]}; }
#pragma unroll
              for (int q = 0; q < 2; ++q) { const int cc = tid + 512 * q, e = cc >> 4, kc = cc & 15;
                  *(LAS u32x4*)(Whi + e * PITCH + kc * 16) = *(const u32x4*)(WRH + e * 1024 + ks * 128 + kc * 8);
                  *(LAS u32x4*)(Wlo + e * PITCH + kc * 16) = *(const u32x4*)(WRL + e * 1024 + ks * 128 + kc * 8); } }
            __syncthreads();
#pragma unroll
            for (int st = 0; st < 8; ++st) { const int ao = (tb * 32 + r32) * PITCH + (2 * st + hi) * 16, bo = (eb * 32 + r32) * PITCH + (2 * st + hi) * 16;
                const bf16x8 ah = *(const LAS bf16x8*)(Ahi + ao), al = *(const LAS bf16x8*)(Alo + ao), bh = *(const LAS bf16x8*)(Whi + bo), bl = *(const LAS bf16x8*)(Wlo + bo);
                c = __builtin_amdgcn_mfma_f32_32x32x16_bf16(ah, bh, c, 0, 0, 0); c = __builtin_amdgcn_mfma_f32_32x32x16_bf16(ah, bl, c, 0, 0, 0); c = __builtin_amdgcn_mfma_f32_32x32x16_bf16(al, bh, c, 0, 0, 0); }
            __syncthreads();
        }
#pragma unroll
        for (int r = 0; r < 16; ++r) LG[(tb * 32 + att::crow(r, hi)) * 65 + eb * 32 + r32] = c[r];
        __syncthreads();
        unsigned long long chosen = 0ull; int ek[8]; float sk[8];
        if (tid < 128) {
            LAS float* L = LG + tid * 65;
            float gs[8];
#pragma unroll
            for (int g = 0; g < 8; ++g) { float m1 = -INFINITY, m2 = -INFINITY;
#pragma unroll
                for (int jx = 0; jx < 8; ++jx) { const float sc = sigmoidf_(L[g * 8 + jx]); const float ch = sc + F.in(I_RB)[g * 8 + jx]; L[g * 8 + jx] = ch;
                    if (ch > m1) { m2 = m1; m1 = ch; } else if (ch > m2) m2 = ch; }
                gs[g] = m1 + m2; }
            unsigned gm = 0u;
#pragma unroll
            for (int it = 0; it < 4; ++it) { float best = -INFINITY; int bi = 0;
#pragma unroll
                for (int g = 0; g < 8; ++g) { const bool ok = !((gm >> g) & 1u) && gs[g] > best; best = ok ? gs[g] : best; bi = ok ? g : bi; }
                gm |= 1u << bi; }
            int gsel[4]; float cand[32];
            { unsigned m = gm;
#pragma unroll
              for (int sx = 0; sx < 4; ++sx) { const int g = __builtin_ctz(m); m &= m - 1u; gsel[sx] = g;
#pragma unroll
                  for (int jx = 0; jx < 8; ++jx) cand[sx * 8 + jx] = L[g * 8 + jx]; } }
            float ssum = 0.f;
#pragma unroll
            for (int it = 0; it < 8; ++it) { float best = -INFINITY; int bi = 0;
#pragma unroll
                for (int i = 0; i < 32; ++i) { const bool ok = cand[i] > best; best = ok ? cand[i] : best; bi = ok ? i : bi; }
#pragma unroll
                for (int i = 0; i < 32; ++i) cand[i] = (i == bi) ? -INFINITY : cand[i];
                const int sx = bi >> 3; const int g = sx == 0 ? gsel[0] : sx == 1 ? gsel[1] : sx == 2 ? gsel[2] : gsel[3]; const int e = g * 8 + (bi & 7);
                chosen |= 1ull << e; ek[it] = e; const float sc = best - F.in(I_RB)[e]; sk[it] = sc; ssum += sc; }
            const float inv = 2.5f / ssum;
#pragma unroll
            for (int it = 0; it < 8; ++it) sk[it] *= inv;
        }
        if (wid < 2) {
            for (int e = 0; e < 64; ++e) { const bool f = (chosen >> e) & 1ull; const unsigned long long bm = __ballot(f);
                const int rk = __popcll(bm & ((1ull << lane) - 1ull));
                if (f) RK[tid * 64 + e] = (unsigned char)rk;
                if (lane == 0) CW[wid * 64 + e] = __popcll(bm); }
        }
        __syncthreads();
        if (tid < 128) {
            int* tke = (int*)(F.ws + WS_TKE) + (size_t)(t0 + tid) * 8; int* tkr = (int*)(F.ws + WS_TKR) + (size_t)(t0 + tid) * 8; float* tkw = (float*)(F.ws + WS_TKW) + (size_t)(t0 + tid) * 8;
#pragma unroll
            for (int it = 0; it < 8; ++it) { const int e = ek[it]; tke[it] = e; tkr[it] = (int)RK[tid * 64 + e] + (wid == 1 ? CW[e] : 0); tkw[it] = sk[it]; }
        }
        if (tid < 64) ((int*)(F.ws + WS_CNT))[chunk * 64 + tid] = CW[tid] + CW[64 + tid];
        __syncthreads();
    }
}

__device__ __forceinline__ void phase8(Frame& F) {
    const int* CNT = (const int*)(F.ws + WS_CNT); int* TOK = (int*)(F.ws + WS_TOK); float* WGT = (float*)(F.ws + WS_WGT); int* POS = (int*)(F.ws + WS_POS);
    LAS int* part = (LAS int*)F.lds;
    LAS int* tot = part + 1024;
    LAS int* below = tot + 64;
    LAS int* ebase = below + 64;
    const int tid = F.tid;
    for (int chunk = F.vcu; chunk < T / 128; chunk += F.G) {
        { const int e = tid & 63, pr = tid >> 6; int s = 0, sb = 0;
          for (int c = pr * 32; c < pr * 32 + 32; ++c) { const int v = CNT[c * 64 + e]; s += v; sb += c < chunk ? v : 0; }
          part[(pr * 2 + 0) * 64 + e] = s; part[(pr * 2 + 1) * 64 + e] = sb; }
        __syncthreads();
        if (tid < 64) { int s = 0, sb = 0;
#pragma unroll
            for (int pr = 0; pr < 8; ++pr) { s += part[(pr * 2 + 0) * 64 + tid]; sb += part[(pr * 2 + 1) * 64 + tid]; }
            tot[tid] = s; below[tid] = sb; }
        __syncthreads();
        if (tid == 0) { int a = 0; for (int e = 0; e < 64; ++e) { ebase[e] = a; a += (tot[e] + 255) & ~255; } ebase[64] = a; }
        __syncthreads();
        if (tid < 128) { const int tokn = chunk * 128 + tid;
            const int* tke = (const int*)(F.ws + WS_TKE) + (size_t)tokn * 8; const int* tkr = (const int*)(F.ws + WS_TKR) + (size_t)tokn * 8; const float* tkw = (const float*)(F.ws + WS_TKW) + (size_t)tokn * 8;
#pragma unroll
            for (int k = 0; k < 8; ++k) { const int e = tke[k]; const int pos = ebase[e] + below[e] + tkr[k]; TOK[pos] = tokn; WGT[pos] = tkw[k]; POS[tokn * 8 + k] = pos; } }
        const int RTOT = ebase[64];
        if (chunk < 64) { const int e = chunk; for (int p = ebase[e] + tot[e] + tid; p < ebase[e + 1]; p += NTHREADS) { TOK[p] = -1; WGT[p] = 0.f; } }
        { const int tokn = chunk * 128 + (tid & 127); if (tid < 128) { TOK[RTOT + tokn] = tokn; WGT[RTOT + tokn] = 1.f; } }
        if (chunk == 0) { int* TE = (int*)(F.ws + WS_TE); const int NTR = RTOT >> 8;
            for (int pm = tid; pm < NTR + 128; pm += NTHREADS) { int e = 64; if (pm < NTR) { e = 0; for (int x = 1; x < 64; ++x) e = (pm * 256 >= ebase[x]) ? x : e; } TE[pm] = e; }
            if (tid == 0) ((int*)(F.ws + WS_META))[0] = NTR; }
        __syncthreads();
    }
}

struct SchedMoe {
    int G, c, nunits, pm0, csh, colbase, bmul; const int* te; const int* tok;
    __device__ __forceinline__ bool next(int i, pg8::Unit& u) const {
        int pm, ct;
        if ((G & 7) == 0) { const int x = c & 7, w = c >> 3, W = G >> 3, nrows = nunits >> csh, nloc = (nrows + 7) >> 3;
            const long Lx = (long)i * W + w; const int pl = (int)(Lx >> csh), pr = x * nloc + pl; if (pl >= nloc || pr >= nrows) return false;
            pm = pm0 + pr; ct = colbase + (int)(Lx & ((1 << csh) - 1)); }
        else { const long L = (long)i * G + c; if (L >= nunits) return false; pm = pm0 + (int)(L >> csh); ct = colbase + (int)(L & ((1 << csh) - 1)); }
        u.pm = pm; u.pn = bmul * te[pm] + ct; return true; }
};
template <int MODE> struct EpiNull {
    static constexpr bool PERM = true;
    float* sink;
    __device__ __forceinline__ void operator()(const f32x4 (&acc)[2][2][4][2], const pg8::Unit& u, int wr, int wc, int fr, int fq) const {
        float s = 0.f;
        if (MODE == 1) {
#pragma unroll
            for (int ai = 0; ai < 2; ++ai)
#pragma unroll
                for (int bj = 0; bj < 2; ++bj)
#pragma unroll
                    for (int m = 0; m < 4; ++m)
#pragma unroll
                        for (int n = 0; n < 2; ++n) s += (acc[ai][bj][m][n][0] + acc[ai][bj][m][n][1]) + (acc[ai][bj][m][n][2] + acc[ai][bj][m][n][3]);
        } else s = acc[0][0][0][0][0] + acc[1][1][3][1][3];
        if (s == 12345.678f) sink[0] = s;
    }
};
struct EpiGU {
    static constexpr bool PERM = true;
    unsigned char* ACT; const float* WGT;
    __device__ __forceinline__ void operator()(const f32x4 (&acc)[2][2][4][2], const pg8::Unit& u, int wr, int wc, int fr, int fq) const {
        const int row0 = u.pm * 256 + wr * 64 + fr, ct = u.pn & 1;
#pragma unroll
        for (int ai = 0; ai < 2; ++ai)
#pragma unroll
            for (int m = 0; m < 4; ++m) { const int row = row0 + ai * 128 + m * 16; const float w = WGT[row] * ACT_SCALE; float r[8];
#pragma unroll
                for (int n = 0; n < 2; ++n)
#pragma unroll
                    for (int i = 0; i < 4; ++i) { const float g = acc[ai][0][m][n][i] * (1.f / WIN_SCALE); r[4 * n + i] = g * sigmoidf_(g) * (acc[ai][1][m][n][i] * (1.f / WIN_SCALE)) * w; }
                int d0 = 0, d1 = 0;
                d0 = __builtin_amdgcn_cvt_pk_fp8_f32(r[0], r[1], d0, false); d0 = __builtin_amdgcn_cvt_pk_fp8_f32(r[2], r[3], d0, true);
                d1 = __builtin_amdgcn_cvt_pk_fp8_f32(r[4], r[5], d1, false); d1 = __builtin_amdgcn_cvt_pk_fp8_f32(r[6], r[7], d1, true);
                *(u32x2*)(ACT + (size_t)row * 256 + ct * 128 + wc * 32 + fq * 8) = (u32x2){(unsigned)d0, (unsigned)d1}; }
    }
};
constexpr float Y_SCALE = 16.f;
struct EpiDown {
    static constexpr bool PERM = true;
    static constexpr float YD = Y_SCALE / (ACT_SCALE * WDN_SCALE);
    unsigned char* Y;
    __device__ __forceinline__ void operator()(const f32x4 (&acc)[2][2][4][2], const pg8::Unit& u, int wr, int wc, int fr, int fq) const {
        const int row0 = u.pm * 256 + wr * 64 + fr, col0 = (u.pn & 3) * 256 + (wc * 4 + fq) * 16;
#pragma unroll
        for (int ai = 0; ai < 2; ++ai)
#pragma unroll
            for (int m = 0; m < 4; ++m) { const int row = row0 + ai * 128 + m * 16; u32x4 w;
#pragma unroll
                for (int bj = 0; bj < 2; ++bj) { int d0 = 0, d1 = 0;
                    d0 = __builtin_amdgcn_cvt_pk_fp8_f32(acc[ai][bj][m][0][0] * YD, acc[ai][bj][m][0][1] * YD, d0, false); d0 = __builtin_amdgcn_cvt_pk_fp8_f32(acc[ai][bj][m][0][2] * YD, acc[ai][bj][m][0][3] * YD, d0, true);
                    d1 = __builtin_amdgcn_cvt_pk_fp8_f32(acc[ai][bj][m][1][0] * YD, acc[ai][bj][m][1][1] * YD, d1, false); d1 = __builtin_amdgcn_cvt_pk_fp8_f32(acc[ai][bj][m][1][2] * YD, acc[ai][bj][m][1][3] * YD, d1, true);
                    if (bj == 0) { w.x = (unsigned)d0; w.y = (unsigned)d1; } else { w.z = (unsigned)d0; w.w = (unsigned)d1; } }
                *(u32x4*)(Y + (size_t)row * 1024 + col0) = w; }
    }
};
struct EpiComb {
    static constexpr bool PERM = true;
    float* O; const unsigned char* Y; const int* POS; const float* mod; int rtiles;
    __device__ __forceinline__ void operator()(const f32x4 (&acc)[2][2][4][2], const pg8::Unit& u, int wr, int wc, int fr, int fq) const {
        const int row0 = (u.pm - rtiles) * 256 + wr * 64 + fr, ct = u.pn & 3, col0 = ct * 256 + wc * 32 + fq * 8;
#pragma unroll
        for (int ai = 0; ai < 2; ++ai)
#pragma unroll
            for (int m = 0; m < 4; ++m) { const int row = row0 + ai * 128 + m * 16, b = row >> 14;
                const i32x4 p0 = *(const i32x4*)(POS + (size_t)row * 8), p1 = *(const i32x4*)(POS + (size_t)row * 8 + 4);
                f32x2 t[8] = {{0.f, 0.f}, {0.f, 0.f}, {0.f, 0.f}, {0.f, 0.f}, {0.f, 0.f}, {0.f, 0.f}, {0.f, 0.f}, {0.f, 0.f}};
#pragma unroll
                for (int k = 0; k < 8; ++k) { const int pos = k < 4 ? p0[k & 3] : p1[k & 3]; const u32x4 y = *(const u32x4*)(Y + (size_t)pos * 1024 + ct * 256 + (wc * 4 + fq) * 16);
                    t[0] += __builtin_amdgcn_cvt_pk_f32_fp8((int)y.x, false); t[1] += __builtin_amdgcn_cvt_pk_f32_fp8((int)y.x, true);
                    t[2] += __builtin_amdgcn_cvt_pk_f32_fp8((int)y.y, false); t[3] += __builtin_amdgcn_cvt_pk_f32_fp8((int)y.y, true);
                    t[4] += __builtin_amdgcn_cvt_pk_f32_fp8((int)y.z, false); t[5] += __builtin_amdgcn_cvt_pk_f32_fp8((int)y.z, true);
                    t[6] += __builtin_amdgcn_cvt_pk_f32_fp8((int)y.w, false); t[7] += __builtin_amdgcn_cvt_pk_f32_fp8((int)y.w, true); }
#pragma unroll
                for (int bj = 0; bj < 2; ++bj) {
                    const int col = col0 + bj * 128; float* op = O + (size_t)row * D + col;
#pragma unroll
                    for (int n = 0; n < 2; ++n) { const f32x4 g = *(const f32x4*)(mod + b * 6144 + 5120 + col + 4 * n), xv = *(const f32x4*)(op + 4 * n);
                        const f32x4 sv = acc[ai][bj][m][n] * (1.f / (ACT_SCALE * WDN_SCALE)) + (f32x4){t[bj * 4 + 2 * n].x, t[bj * 4 + 2 * n].y, t[bj * 4 + 2 * n + 1].x, t[bj * 4 + 2 * n + 1].y} * (1.f / Y_SCALE);
                        *(f32x4*)(op + 4 * n) = xv + g * sv; } } }
    }
};

constexpr int NPHASE = 12;
__global__ void __launch_bounds__(NTHREADS, 2) fwd_kernel(Args args) {
    extern __shared__ __attribute__((aligned(16))) unsigned char lds[];
    Frame F;
    F.lds = (LAS unsigned char*)lds;
    F.tid = threadIdx.x; F.lane = F.tid & 63; F.wave = __builtin_amdgcn_readfirstlane(F.tid >> 6);
    F.G = gridDim.x; { const int bx = blockIdx.x; F.vcu = (F.G % 8 == 0) ? (bx % 8) * (F.G / 8) + bx / 8 : bx; }
    F.ws = args.ws; F.out = args.out;
    F.ka = (const __attribute__((address_space(4))) unsigned char*)__builtin_amdgcn_kernarg_segment_ptr();
    volatile LAS unsigned* MISC = (volatile LAS unsigned*)(F.lds + MISC_OFF);
    if (F.tid < 64) MISC[F.tid] = 0u;
    __syncthreads();
    const int lo = args.ph_lo, hi = args.ph_hi;
    unsigned* barw = (unsigned*)(F.ws + WS_CTL) + CW_BAR;
    XcdBarrier bar; bar.bar = barw; bar.x = 0; bar.st = nullptr;
    if (hi - lo > 1) bar = xcd_barrier_post(barw, MISC + 8);
#ifndef ONLY_PHASE
#define ONLY_PHASE -1
#endif
#define HASP(k) (ONLY_PHASE < 0 || ONLY_PHASE == (k) || (ONLY_PHASE == 100 && (k) == 10) || (ONLY_PHASE == 101 && (k) == 11))
#define IN(k) (HASP(k) && lo <= (k) && (k) < hi)
#ifndef DBG_REP
#define DBG_REP -1
#endif
#ifndef DBG_REPN
#define DBG_REPN 2
#endif
#define REPS(k) for (int rep_ = 0; rep_ < ((DBG_REP == (k)) ? DBG_REPN : 1); (void)({ asm volatile("" ::: "memory"); 0; }), ++rep_)
#define SEAM(k) do { if (IN(k) && IN((k) + 1)) xcd_barrier(bar); } while (0)
    bf16* const H = (bf16*)F.out;

    if (IN(0)) { REPS(0) phase0(F); } SEAM(0);
    if (IN(1)) { REPS(1) phase1(F); } SEAM(1);
    if (IN(2)) REPS(2) {
        pg8::Gemm g{H, (const bf16*)(F.ws + WS_WIN), T, NIN, D / 2}; pg8::StaticOrder S; S.init(T, NIN, F.G, (int)blockIdx.x);
        EpiIn E{(bf16*)(F.ws + WS_U), (bf16*)(F.ws + WS_Q), (bf16*)(F.ws + WS_K), (bf16*)(F.ws + WS_V), (bf16*)(F.ws + WS_GC), (bf16*)(F.ws + WS_GA), (const float*)(F.ws + WS_ROPE), F.in(I_QNG), F.in(I_KNG), F.lds + EPI_SCR};
        pg8::gemm_phase<EpiIn, pg8::StaticOrder, true, true, false, true>(F.lds, g, S, E);
    } SEAM(2);
    if (IN(3)) { REPS(3) phase3(F); } SEAM(3);
    if (IN(4)) REPS(4) {
        pg8::Gemm g{H, (const bf16*)(F.ws + WS_WPW2), T, D, D / 2}; pg8::StaticOrder S; S.init(T, D, F.G, (int)blockIdx.x);
        EpiPw2 E{(bf16*)(F.ws + WS_U), (const bf16*)(F.ws + WS_GC), F.in(I_BPW2)};
        pg8::gemm_phase<EpiPw2, pg8::StaticOrder, true, true, false, true>(F.lds, g, S, E);
    } SEAM(4);
#ifndef DBG_ATTVAR
#define DBG_ATTVAR 0
#endif
    if (IN(5)) { att::phase5(F, (bf16*)(F.ws + WS_U)); } SEAM(5);
    if (IN(6)) REPS(6) {
        pg8::Gemm g{(const bf16*)(F.ws + WS_U), (const bf16*)(F.ws + WS_WOUT), T, D, D}; pg8::StaticOrder S; S.init(T, D, F.G, (int)blockIdx.x);
        EpiOut E{F.in(I_X), F.out, (const float*)(F.ws + WS_MOD)};
        pg8::gemm_phase<EpiOut, pg8::StaticOrder, true, true, false>(F.lds, g, S, E);
    } SEAM(6);
    if (IN(7)) { REPS(7) phase7(F); } SEAM(7);
    if (IN(8)) { REPS(8) phase8(F); } SEAM(8);
    const int* TE = (const int*)(F.ws + WS_TE); const int* TOK = (const int*)(F.ws + WS_TOK);
    if (IN(9)) REPS(9) {
        const int NTR = ((const int*)(F.ws + WS_META))[0];
        pg8::Gemm g{(const bf16*)(F.ws + WS_U), (const bf16*)(F.ws + WS_WGU), 0, 0, D / 2};
        SchedMoe S{F.G, (int)blockIdx.x, 2 * (NTR + 128), 0, 1, 0, 2, TE, TOK};
        EpiGU E{(unsigned char*)(F.ws + WS_ACT), (const float*)(F.ws + WS_WGT)};
        pg8::gemm_phase<EpiGU, SchedMoe, true, true, true, true>(F.lds, g, S, E);
    } SEAM(9);
    if (IN(10)) REPS(10) { const int NTR = ((const int*)(F.ws + WS_META))[0];
        pg8::Gemm g{(const bf16*)(F.ws + WS_ACT), (const bf16*)(F.ws + WS_WDN), 0, 0, ED / 2};
        SchedMoe S{F.G, (int)blockIdx.x, 4 * NTR, 0, 2, 0, 4, TE, TOK};
        EpiDown E{(unsigned char*)(F.ws + WS_Y)};
#ifndef DBG_P10VAR
#define DBG_P10VAR 0
#endif
        if (DBG_P10VAR == 1) { EpiNull<0> E0{(float*)(F.ws + WS_META) + 8}; pg8::gemm_phase<EpiNull<0>, SchedMoe, true, true, false>(F.lds, g, S, E0); }
        if (DBG_P10VAR == 2) { EpiNull<1> E0{(float*)(F.ws + WS_META) + 8}; pg8::gemm_phase<EpiNull<1>, SchedMoe, true, true, false>(F.lds, g, S, E0); }
        pg8::gemm_phase<EpiDown, SchedMoe, true, true, false, true>(F.lds, g, S, E);
    } SEAM(10);
    if (IN(11)) { const int NTR = ((const int*)(F.ws + WS_META))[0];
        pg8::Gemm g{(const bf16*)(F.ws + WS_ACT), (const bf16*)(F.ws + WS_WDN), 0, 0, ED / 2};
        SchedMoe S{F.G, (int)blockIdx.x, 512, NTR, 2, 0, 4, TE, TOK};
        EpiComb E{F.out, (const unsigned char*)(F.ws + WS_Y), (const int*)(F.ws + WS_POS), (const float*)(F.ws + WS_MOD), NTR};
        pg8::gemm_phase<EpiComb, SchedMoe, true, true, false, true>(F.lds, g, S, E);
    }
#undef IN
#undef SEAM

}

#ifndef DBG_A6
#define DBG_A6 WS_U
#endif
#ifndef DBG_SKIP
#define DBG_SKIP 0
#endif
#ifndef DBG_NPH
#define DBG_NPH NPHASE
#endif
#ifndef N_LAUNCH_MODE
#define N_LAUNCH_MODE 1
#endif
extern "C" void kernel_launch(void* const* d_in, const int* in_sizes, int n_in, void* d_out, int out_size, void* d_ws, size_t ws_size, hipStream_t stream) {
    static int grid = 0;
    if (grid == 0) {
        if (n_in != 28 || out_size != T * D || ws_size < WS_END) { fprintf(stderr, "kernel_launch: unexpected problem (n_in %d out %d ws %zu)\n", n_in, out_size, ws_size); grid = -1; return; }
        int dev = 0, cus = 0, per_cu = 0;
        if (hipGetDevice(&dev) != hipSuccess || hipDeviceGetAttribute(&cus, hipDeviceAttributeMultiprocessorCount, dev) != hipSuccess) { grid = -1; return; }
        if (hipFuncSetAttribute((const void*)fwd_kernel, hipFuncAttributeMaxDynamicSharedMemorySize, LDS_BYTES) != hipSuccess) { grid = -1; return; }
        if (hipOccupancyMaxActiveBlocksPerMultiprocessor(&per_cu, (const void*)fwd_kernel, NTHREADS, LDS_BYTES) != hipSuccess || per_cu < 1) { fprintf(stderr, "kernel_launch: occupancy query says %d\n", per_cu); }
        (void)hipGetLastError();
        grid = cus;
    }
    if (grid < 0) return;
    (void)hipMemsetAsync((char*)d_ws + WS_CTL, 0, CTL_ZERO_BYTES, stream);
    Args a{};
    for (int i = 0; i < 28; ++i) a.in[i] = d_in[i];
    a.out = (float*)d_out; a.ws = (unsigned char*)d_ws;
    if (N_LAUNCH_MODE == 1) { a.ph_lo = 0; a.ph_hi = NPHASE; hipLaunchKernelGGL(fwd_kernel, dim3(grid), dim3(NTHREADS), LDS_BYTES, stream, a); }
    else { for (int p = 0; p < DBG_NPH; ++p) { if ((DBG_SKIP >> p) & 1) continue; a.ph_lo = p; a.ph_hi = p + 1; hipLaunchKernelGGL(fwd_kernel, dim3(grid), dim3(NTHREADS), LDS_BYTES, stream, a); } }
}
```

```cpp
#include <hip/hip_runtime.h>
#include <cstdio>
#include <cstdint>

#define GAS __attribute__((address_space(1)))
#define LAS __attribute__((address_space(3)))
typedef unsigned short bf16;
typedef short bf16x8 __attribute__((ext_vector_type(8)));
typedef short s16x4 __attribute__((ext_vector_type(4)));
typedef float f32x4 __attribute__((ext_vector_type(4)));
typedef float f32x2 __attribute__((ext_vector_type(2)));
typedef float f32x16 __attribute__((ext_vector_type(16)));
typedef unsigned u32x4 __attribute__((ext_vector_type(4)));
typedef unsigned u32x2 __attribute__((ext_vector_type(2)));
typedef int i32x4 __attribute__((ext_vector_type(4)));

constexpr int NB = 2, SEQ = 16384, T = NB * SEQ, D = 1024, NIN = 7168;
constexpr int NE = 64, TOPK = 8, ED = 256, NEX = NE + 1;
constexpr float EPS = 1e-6f;
constexpr float C2 = 0.125f * 1.4426950408889634f;
constexpr float QSC = 4.f, PBIAS = 60.f;
constexpr float LAMBDA_INIT = 0.2f;
constexpr int NWAVES = 8, NTHREADS = 512;

constexpr size_t MiB = 1u << 20;
constexpr size_t WS_CTL = 0, CTL_ZERO_BYTES = 64 * 1024;
constexpr size_t WS_MOD = 1 * MiB;
constexpr size_t WS_ROPE = 1 * MiB + 64 * 1024;
constexpr size_t WS_TKE = 3 * MiB + 256 * 1024;
constexpr size_t WS_TKR = 4 * MiB + 256 * 1024;
constexpr size_t WS_TKW = 5 * MiB + 256 * 1024;
constexpr size_t WS_POS = 6 * MiB + 256 * 1024;
constexpr size_t WS_CNT = 7 * MiB + 256 * 1024;
constexpr size_t WS_TE = WS_CNT + 64 * 1024;
constexpr size_t WS_META = WS_TE + 8 * 1024;
constexpr size_t WS_TOK = 7 * MiB + 512 * 1024;
constexpr size_t WS_WGT = 8 * MiB + 768 * 1024;
constexpr int RMAX = 262144 + 64 * 256 + T;
static_assert(WS_TOK + (size_t)RMAX * 4 <= WS_WGT && WS_WGT + (size_t)RMAX * 4 <= 10 * MiB, "small region");
constexpr size_t WS_WRH = 10 * MiB, WS_WRL = 10 * MiB + 128 * 1024;
constexpr size_t WS_WDN = 11 * MiB;
constexpr size_t WS_WIN = WS_WDN + (size_t)NEX * 1024 * 256 * 2 + MiB / 2;
constexpr size_t WS_WPW2 = WS_WIN + 14 * MiB, WS_WOUT = WS_WPW2 + 2 * MiB;
constexpr size_t WS_WGU = WS_WOUT + 2 * MiB;
constexpr size_t WS_U = 127 * MiB;
constexpr size_t WS_Q = WS_U + 64 * MiB, WS_K = WS_Q + 64 * MiB, WS_V = WS_K + 64 * MiB, WS_GC = WS_V + 64 * MiB, WS_GA = WS_GC + 64 * MiB;
constexpr size_t WS_END = WS_GA + 64 * MiB;
static_assert(WS_WGU + (size_t)NEX * 512 * 1024 * 2 <= WS_U && WS_END <= 512 * MiB, "ws map");
constexpr size_t WS_ACT = 359 * MiB;
constexpr size_t WS_Y = 44 * MiB;
static_assert(WS_ACT + (size_t)RMAX * 512 <= WS_END && WS_Y + (size_t)(262144 + 64 * 256) * 1024 <= WS_ACT && WS_Y >= WS_WDN + (size_t)NEX * 1024 * 256 * 2, "moe overlays");
constexpr int CW_BAR = 1024;

#ifndef DBG_A6
#define DBG_A6 WS_U
#endif
constexpr int RING_BYTES = 131072;
constexpr int LDS_BYTES = 163840;
constexpr int EPI_SCR = RING_BYTES;
constexpr int MISC_OFF = LDS_BYTES - 256;

#define LDS_WAIT() asm volatile("s_waitcnt lgkmcnt(0)" ::: "memory")
#define VM_WAIT() asm volatile("s_waitcnt vmcnt(0)" ::: "memory")
typedef __bf16 bf16x2_t __attribute__((ext_vector_type(2)));
__device__ __forceinline__ unsigned cvt_pk_bf16(float lo, float hi) { const f32x2 v = {lo, hi}; const bf16x2_t b = __builtin_convertvector(v, bf16x2_t); return __builtin_bit_cast(unsigned, b); }
__device__ __forceinline__ float bf_lo(unsigned u) { return __builtin_bit_cast(float, u << 16); }
__device__ __forceinline__ float bf_hi(unsigned u) { return __builtin_bit_cast(float, u & 0xffff0000u); }
__device__ __forceinline__ float sigmoidf_(float x) { return __builtin_amdgcn_rcpf(1.f + __expf(-x)); }
__device__ __forceinline__ float wave_sum(float v) {
#pragma unroll
    for (int o = 1; o < 64; o <<= 1) v += __shfl_xor(v, o);
    return v;
}
__device__ __forceinline__ float wave_max(float v) {
#pragma unroll
    for (int o = 1; o < 64; o <<= 1) v = fmaxf(v, __shfl_xor(v, o));
    return v;
}

namespace pg8 {
typedef int i32x8_t __attribute__((ext_vector_type(8)));
typedef int i32x4_t __attribute__((ext_vector_type(4)));
constexpr int BM = 256, BK = 64, HALF = 128, HTB = HALF * BK * 2, STAGE_BYTES = 8 * HTB, NXCD = 8, WGM = 8;
__host__ __device__ __forceinline__ int lds_byte(int r, int c) { const int st = (r >> 4) * 2 + (c >> 5), rr = r & 15, cc = c & 31, ob = rr * 64 + cc * 2; return st * 1024 + (ob ^ (((ob >> 9) & 1) << 5)); }
__host__ __device__ __forceinline__ void stage_rc(int b, int& R, int& C) { const int st = b / 1024, sb = b % 1024, swz = sb ^ (((sb >> 9) & 1) << 5); R = (st >> 1) * 16 + swz / 64; C = (st & 1) * 32 + (swz % 64) / 2; }
__host__ __device__ __forceinline__ int perm32(int rho) { const int n = rho >> 4, i = rho & 15; return 8 * (i >> 2) + 4 * n + (i & 3); }

struct Unit { int pm, pn; };
struct Gemm { const bf16* A; const bf16* Bt; int M, N, K; };

struct StaticOrder {
    int nM, nN, nwg, G, c;
    const int* tok;
    __host__ __device__ void init(int M, int N, int G_, int c_) { nM = M / BM; nN = N / BM; nwg = nM * nN; G = G_; c = c_; tok = nullptr; }
    __host__ __device__ bool next(int i, Unit& u) const {
        const long L = (long)i * G + c; if (L >= nwg) return false;
        int wgid = (int)L; { const int q = nwg / NXCD, r = nwg % NXCD, xcd = wgid % NXCD, off = wgid / NXCD; wgid = (xcd < r ? xcd * (q + 1) : r * (q + 1) + (xcd - r) * q) + off; }
        const int nig = WGM * nN, gid = wgid / nig, fm = gid * WGM, gsz = (nM - fm) < WGM ? (nM - fm) : WGM;
        u.pm = fm + ((wgid % nig) % gsz); u.pn = (wgid % nig) / gsz; return true;
    }
};

template <class Epi, class Sched, bool ALIGN_EPI, bool SP2, bool GATHER, bool FP8 = false>
__device__ __forceinline__ void gemm_phase(LAS unsigned char* lds, const Gemm g, const Sched& S, const Epi& E) {
    const int tid = threadIdx.x, wid = __builtin_amdgcn_readfirstlane(tid >> 6), lane = tid & 63, wr = wid >> 2, wc = wid & 3, fr = lane & 15, fq = lane >> 4;
    const int K = g.K, nt = K / BK;
    unsigned voffA[2], voffB[2]; int RA[2]; unsigned CA2[2];
#pragma unroll
    for (int i = 0; i < 2; ++i) { int R, C; stage_rc(tid * 16 + i * 8192, R, C); const int Rb = Epi::PERM ? ((R & ~31) + perm32(R & 31)) : R;
        voffA[i] = (unsigned)(R * K + C) * 2u; voffB[i] = (unsigned)(Rb * K + C) * 2u; RA[i] = R; CA2[i] = (unsigned)C * 2u; }
    const size_t kstep = (size_t)(BK * 2);
    const size_t hstep = (size_t)HALF * K * 2;
    const size_t tstep = 2 * hstep;
    const unsigned ldsw = (unsigned)wid * 1024u;
    const int aoff = lds_byte(wr * 64 + fr, fq * 8), boff = lds_byte(wc * 32 + fr, fq * 8);
#define PG8_SA(b, h) (((b) * 2 + (h)) * HTB)
#define PG8_SB(b, h) ((4 + (b) * 2 + (h)) * HTB)
#define PG8_STAGE2(bufoff, gbase, o0, o1) do { \
        __builtin_amdgcn_global_load_lds((const unsigned*)((const char*)(gbase) + (o0)), (LAS unsigned*)(lds + (bufoff) + ldsw), 16, 0, 0); \
        __builtin_amdgcn_global_load_lds((const unsigned*)((const char*)(gbase) + (o1)), (LAS unsigned*)(lds + (bufoff) + ldsw + 8192), 16, 0, 0); } while (0)
#define PG8_STAGEB(bufoff, gbase) PG8_STAGE2(bufoff, gbase, voffB[0], voffB[1])
#define PG8_STAGEA(bufoff, gbase, h, o0, o1) do { if constexpr (GATHER) { PG8_STAGE2(bufoff, gbase, o0, o1); } else { PG8_STAGE2(bufoff, (gbase) + (h) * hstep, voffA[0], voffA[1]); } } while (0)
#define PG8_LD8(p) __builtin_shufflevector(*(const LAS i32x4_t*)(p), *(const LAS i32x4_t*)((p) + 1024), 0, 1, 2, 3, 4, 5, 6, 7)
#define PG8_LDA(dst, b, h) do { if constexpr (FP8) { _Pragma("unroll") for (int m = 0; m < 4; ++m) dst##8[m] = PG8_LD8(lds + PG8_SA(b, h) + aoff + m * 2048); } \
        else { _Pragma("unroll") for (int m = 0; m < 4; ++m) _Pragma("unroll") for (int k = 0; k < 2; ++k) dst[m][k] = *(const LAS bf16x8*)(lds + PG8_SA(b, h) + aoff + m * 2048 + k * 1024); } } while (0)
#define PG8_LDB(dst, b, h) do { if constexpr (FP8) { _Pragma("unroll") for (int n = 0; n < 2; ++n) dst##8[n] = PG8_LD8(lds + PG8_SB(b, h) + boff + n * 2048); } \
        else { _Pragma("unroll") for (int n = 0; n < 2; ++n) _Pragma("unroll") for (int k = 0; k < 2; ++k) dst[n][k] = *(const LAS bf16x8*)(lds + PG8_SB(b, h) + boff + n * 2048 + k * 1024); } } while (0)
#define PG8_CAT(x) __builtin_shufflevector(__builtin_bit_cast(i32x4_t, (x)[0]), __builtin_bit_cast(i32x4_t, (x)[1]), 0, 1, 2, 3, 4, 5, 6, 7)
#define PG8_MMA(ai, bj, At, Bt) do { __builtin_amdgcn_s_setprio(1); \
        if constexpr (FP8) { _Pragma("unroll") for (int m = 0; m < 4; ++m) _Pragma("unroll") for (int n = 0; n < 2; ++n) \
            asm volatile("v_mfma_f32_16x16x128_f8f6f4 %0, %1, %2, %0" : "+v"(acc[ai][bj][m][n]) : "v"(Bt##8[n]), "v"(At##8[m])); }   \
        else { _Pragma("unroll") for (int m = 0; m < 4; ++m) _Pragma("unroll") for (int n = 0; n < 2; ++n) _Pragma("unroll") for (int k = 0; k < 2; ++k) \
            acc[ai][bj][m][n] = __builtin_amdgcn_mfma_f32_16x16x32_bf16(Bt[n][k], At[m][k], acc[ai][bj][m][n], 0, 0, 0); } \
        __builtin_amdgcn_s_setprio(0); } while (0)
#define PG8_WAIT_V(n) asm volatile("s_waitcnt vmcnt(" #n ")" ::: "memory")
#define PG8_WAIT_L(n) asm volatile("s_waitcnt lgkmcnt(" #n ")" ::: "memory")
#define PG8_BAR __builtin_amdgcn_s_barrier()
#define PG8_SCHED __builtin_amdgcn_sched_barrier(0)
#define PG8_SETA(o, u) do { _Pragma("unroll") for (int h_ = 0; h_ < 2; ++h_) _Pragma("unroll") for (int i_ = 0; i_ < 2; ++i_) { \
        if constexpr (GATHER) { int t_ = S.tok[(u).pm * 256 + h_ * 128 + RA[i_]]; t_ = t_ < 0 ? 0 : t_; o[h_][i_] = (unsigned)t_ * (unsigned)(K * 2) + CA2[i_]; } \
        else { o[h_][i_] = (unsigned)(h_ * hstep) + voffA[i_]; } } } while (0)
    Unit cur, nxt; int ui = 0;
    if (!S.next(0, cur)) return;
    f32x4 acc[2][2][4][2];
#pragma unroll
    for (int a = 0; a < 2; ++a)
#pragma unroll
        for (int b = 0; b < 2; ++b)
#pragma unroll
            for (int m = 0; m < 4; ++m)
#pragma unroll
                for (int n = 0; n < 2; ++n) acc[a][b][m][n] = (f32x4){0.f, 0.f, 0.f, 0.f};
    bf16x8 At[4][2], B0[2][2], B1[2][2];
    i32x8_t At8[4], B08[2], B18[2];
    unsigned cO[2][2], nO[2][2];
    if constexpr (GATHER) { PG8_SETA(cO, cur); VM_WAIT(); }
    else { cO[0][0] = cO[0][1] = cO[1][0] = cO[1][1] = 0u; }
    const char* cA = GATHER ? (const char*)g.A : (const char*)g.A + (size_t)cur.pm * tstep; const char* cB = (const char*)g.Bt + (size_t)cur.pn * tstep;
    if constexpr (SP2) {
        PG8_STAGEB(PG8_SB(0, 0), cB); PG8_STAGEB(PG8_SB(0, 1), cB + hstep); PG8_STAGEA(PG8_SA(0, 0), cA, 0, cO[0][0], cO[0][1]); PG8_STAGEA(PG8_SA(0, 1), cA, 1, cO[1][0], cO[1][1]);
        if (wr == 1) PG8_BAR;
        PG8_WAIT_V(2); PG8_BAR;
        PG8_STAGEB(PG8_SB(1, 0), cB + kstep); PG8_STAGEA(PG8_SA(1, 0), cA + kstep, 0, cO[0][0], cO[0][1]); PG8_STAGEB(PG8_SB(1, 1), cB + hstep + kstep);
        PG8_WAIT_V(6); PG8_BAR;
    }
    for (;;) {
        const bool has_next = S.next(ui + 1, nxt);
        if constexpr (!GATHER) { nO[0][0] = nO[0][1] = nO[1][0] = nO[1][1] = 0u; }
        else if (has_next) { PG8_SETA(nO, nxt); } else {
#pragma unroll
            for (int h_ = 0; h_ < 2; ++h_)
#pragma unroll
                for (int i_ = 0; i_ < 2; ++i_) nO[h_][i_] = cO[h_][i_]; }
        const char* nA = GATHER ? (const char*)g.A : (has_next ? (const char*)g.A + (size_t)nxt.pm * tstep : cA);
        const char* nB = has_next ? (const char*)g.Bt + (size_t)nxt.pn * tstep : cB;
#pragma nounroll
        for (int t = 0; t < nt; t += 2) {
            const bool last = (t == nt - 2);
            const char* a1 = cA + (size_t)(t + 1) * kstep;
            const char* a2 = last ? nA : cA + (size_t)(t + 2) * kstep; const char* b2 = last ? nB : cB + (size_t)(t + 2) * kstep;
            const char* a3 = a2 + kstep; const char* b3 = b2 + kstep;
            const unsigned x00 = last ? nO[0][0] : cO[0][0], x01 = last ? nO[0][1] : cO[0][1], x10 = last ? nO[1][0] : cO[1][0], x11 = last ? nO[1][1] : cO[1][1];
            PG8_LDB(B0, 0, 0); PG8_LDB(B1, 0, 1); PG8_SCHED; PG8_LDA(At, 0, 0); PG8_STAGEA(PG8_SA(1, 1), a1, 1, cO[1][0], cO[1][1]);
            PG8_WAIT_V(8); PG8_WAIT_L(0); PG8_BAR; PG8_MMA(0, 0, At, B0); PG8_MMA(0, 1, At, B1); PG8_BAR; PG8_SCHED;
            PG8_LDA(At, 0, 1); PG8_STAGEB(PG8_SB(0, 0), b2); PG8_STAGEB(PG8_SB(0, 1), b2 + hstep); PG8_STAGEA(PG8_SA(0, 0), a2, 0, x00, x01);
            PG8_WAIT_V(8); PG8_WAIT_L(0); PG8_BAR; PG8_MMA(1, 0, At, B0); PG8_MMA(1, 1, At, B1); PG8_BAR; PG8_SCHED;
            PG8_LDB(B0, 1, 0); PG8_LDB(B1, 1, 1); PG8_SCHED; PG8_LDA(At, 1, 0); PG8_STAGEA(PG8_SA(0, 1), a2, 1, x10, x11);
            PG8_WAIT_V(8); PG8_WAIT_L(0); PG8_BAR; PG8_MMA(0, 0, At, B0); PG8_MMA(0, 1, At, B1); PG8_BAR; PG8_SCHED;
            PG8_LDA(At, 1, 1); PG8_STAGEB(PG8_SB(1, 0), b3); PG8_STAGEB(PG8_SB(1, 1), b3 + hstep); PG8_STAGEA(PG8_SA(1, 0), a3, 0, x00, x01);
            PG8_WAIT_V(8); PG8_WAIT_L(0); PG8_BAR; PG8_MMA(1, 0, At, B0); PG8_MMA(1, 1, At, B1); PG8_BAR; PG8_SCHED;
        }
        if constexpr (ALIGN_EPI) { if (wr == 0) PG8_BAR; }
        if constexpr (FP8) asm volatile("s_nop 15\n\ts_nop 15" ::: "memory");
        E(acc, cur, wr, wc, fr, fq);
        if (!has_next) break;
#pragma unroll
        for (int a = 0; a < 2; ++a)
#pragma unroll
            for (int b = 0; b < 2; ++b)
#pragma unroll
                for (int m = 0; m < 4; ++m)
#pragma unroll
                    for (int n = 0; n < 2; ++n) acc[a][b][m][n] = (f32x4){0.f, 0.f, 0.f, 0.f};
        cur = nxt; cA = nA; cB = nB; ++ui;
#pragma unroll
        for (int h_ = 0; h_ < 2; ++h_)
#pragma unroll
            for (int i_ = 0; i_ < 2; ++i_) cO[h_][i_] = nO[h_][i_];
        if constexpr (ALIGN_EPI) { if (wr == 1) PG8_BAR; }
    }
    PG8_WAIT_V(0);
    if constexpr (!ALIGN_EPI) { if (wr == 0) PG8_BAR; }
    PG8_BAR;
#undef PG8_SA
#undef PG8_SB
#undef PG8_STAGE2
#undef PG8_STAGEB
#undef PG8_STAGEA
#undef PG8_LDA
#undef PG8_LD8
#undef PG8_LDB
#undef PG8_MMA
#undef PG8_CAT
#undef PG8_WAIT_V
#undef PG8_WAIT_L
#undef PG8_BAR
#undef PG8_SCHED
#undef PG8_SETA
}
}

#define XB_TMO      128
#define XB_XCNT(j)  (256  + 64 * (j))
#define XB_XSUB(j)  (1280 + 64 * (j))
#define XB_XGEN(j)  (2304 + 64 * (j))
#define XB_TOP      3328
#define XB_TOPGEN   3392
#define XCD_BAR_WORDS 3456
#define XB_SPIN_CAP (1u << 18)
__device__ __forceinline__ unsigned xb_ld(unsigned* p)              { return __hip_atomic_load(p, __ATOMIC_RELAXED, __HIP_MEMORY_SCOPE_AGENT); }
__device__ __forceinline__ unsigned xb_add(unsigned* p, unsigned v) { return __hip_atomic_fetch_add(p, v, __ATOMIC_RELAXED, __HIP_MEMORY_SCOPE_AGENT); }
__device__ __forceinline__ unsigned xb_xcc_id() { return (unsigned)__builtin_amdgcn_s_getreg((3 << 11) | 20) & 0xFu; }
#define XB_SPIN(cond, bar) do { unsigned _sp = 0; while (cond) { __builtin_amdgcn_s_sleep(1); \
    if ((++_sp & 255u) == 0u) { if (xb_ld(&(bar)[XB_TMO])) break; if (_sp > XB_SPIN_CAP) { atomicAdd(&(bar)[XB_TMO], 1u); break; } } } } while (0)
struct XcdBarrier { unsigned* bar; unsigned x; volatile LAS unsigned* st; };
__device__ __forceinline__ XcdBarrier xcd_barrier_post(unsigned* bar, volatile LAS unsigned* st) {
    XcdBarrier b; b.bar = bar; b.x = xb_xcc_id(); b.st = st;
    if (threadIdx.x == 0) (void)xb_add(&bar[XB_XCNT(b.x)], 1u);
    return b;
}
__device__ __forceinline__ void xcd_barrier_complete(unsigned* bar, unsigned x, unsigned& nloc, unsigned& nx) {
    const unsigned G = gridDim.x * gridDim.y * gridDim.z;
    unsigned sum, cnt, mine, sp = 0u;
    for (;;) {
        sum = 0u; cnt = 0u; mine = 0u;
#pragma unroll
        for (unsigned j = 0; j < 16; ++j) { const unsigned c = xb_ld(&bar[XB_XCNT(j)]); sum += c; cnt += (c > 0u) ? 1u : 0u; mine = (j == x) ? c : mine; }
        if (sum == G) break;
        __builtin_amdgcn_s_sleep(1);
        if ((++sp & 255u) == 0u) { if (xb_ld(&bar[XB_TMO])) break; if (sp > XB_SPIN_CAP) { atomicAdd(&bar[XB_TMO], 1u); break; } }
    }
    nloc = mine > 0u ? mine : 1u; nx = cnt > 0u ? cnt : 1u;
}
__device__ __forceinline__ void xcd_barrier(const XcdBarrier& b) {
    asm volatile("s_waitcnt vmcnt(0)" ::: "memory");
    __syncthreads();
    if (threadIdx.x == 0) {
        unsigned* bar = b.bar;
        __builtin_amdgcn_s_waitcnt(0);
        unsigned nloc = b.st[0], nx = b.st[1];
        if (nloc == 0u) { xcd_barrier_complete(bar, b.x, nloc, nx); b.st[0] = nloc; b.st[1] = nx; }
        const unsigned old = xb_add(&bar[XB_XSUB(b.x)], 1u);
        const unsigned gen = old / nloc;
        if (old + 1u == (gen + 1u) * nloc) {
            __builtin_amdgcn_fence(__ATOMIC_RELEASE, "agent");
            asm volatile("s_waitcnt vmcnt(0)" ::: "memory");
            const unsigned og = xb_add(&bar[XB_TOP], 1u);
            const unsigned tg = og / nx;
            if (og + 1u == (tg + 1u) * nx) xb_add(&bar[XB_TOPGEN], 1u);
            else XB_SPIN(xb_ld(&bar[XB_TOPGEN]) == tg, bar);
            __builtin_amdgcn_fence(__ATOMIC_ACQUIRE, "agent");
            xb_add(&bar[XB_XGEN(b.x)], 1u);
            asm volatile("s_waitcnt vmcnt(0)" ::: "memory");
        } else {
            XB_SPIN(xb_ld(&bar[XB_XGEN(b.x)]) == gen, bar);
            __builtin_amdgcn_fence(__ATOMIC_ACQUIRE, "agent");
            asm volatile("s_waitcnt vmcnt(0)" ::: "memory");
        }
    }
    __syncthreads();
}

struct Args { const void* in[28]; float* out; unsigned char* ws; int ph_lo, ph_hi; };
struct Frame {
    LAS unsigned char* lds;
    int tid, lane, wave, vcu, G;
    unsigned char* ws; float* out;
    const __attribute__((address_space(4))) unsigned char* ka;
    __device__ __forceinline__ const float* in(int i) const { return ((const float* const __attribute__((address_space(4)))*)ka)[i]; }
};
enum { I_X = 0, I_C, I_POS, I_WADA, I_BADA, I_N1G, I_WIN, I_CDW, I_CDWB, I_CLNG, I_CLNB, I_WPW2, I_BPW2, I_QNG, I_KNG, I_LQ1, I_LK1, I_LQ2, I_LK2, I_SUBG, I_WOUT, I_N2G, I_WR, I_RB, I_WEGU, I_WEDN, I_WSGU, I_WSDN };

__device__ __forceinline__ int win_map(int n) {
    if (n < 1024) return 256 * (n >> 7) + (n & 127);
    if (n < 2048) { const int j = n - 1024; return 256 * (j >> 7) + 128 + (j & 127); }
    if (n < 4096) { const int qk = (n - 2048) >> 10, j = (n - 2048) & 1023, g = j >> 6, dl = j & 63; const int tile = 8 + 4 * qk + (g >> 2), wc = g & 3;
        int bj, fq, e; if (dl < 8) { bj = 0; fq = 0; e = dl; } else if (dl < 16) { bj = 1; fq = 0; e = dl - 8; } else { const int rho = dl - 16; bj = rho / 24; fq = 1 + (rho % 24) / 8; e = rho & 7; }
        return 256 * tile + 128 * bj + 32 * wc + 8 * fq + e; }
    return n;
}
__device__ __forceinline__ int glu_map(int n) { const int j = n & 255; return 256 * (j >> 7) + ((n >> 8) << 7) + (j & 127); }
__device__ __forceinline__ int qk_dim(int bj, int fq, int e) { return fq == 0 ? bj * 8 + e : 16 + bj * 24 + (fq - 1) * 8 + e; }

template <int MAP>
__device__ __forceinline__ void transpose_item(const float* W, int K, int N, bf16* WT, LAS float* scr, int item, int lane) {
    const int nblk = N / 32, kb = item / nblk, nb = item % nblk, k0 = 64 * kb, n0 = 32 * nb;
    {
        const int rr = lane >> 3, c4 = (lane & 7) * 4; f32x4 t[8];
#pragma unroll
        for (int i = 0; i < 8; ++i) t[i] = __builtin_nontemporal_load((const f32x4*)(W + (size_t)(k0 + 8 * i + rr) * N + n0 + c4));
#pragma unroll
        for (int i = 0; i < 8; ++i) { LAS float* d = scr + (8 * i + rr) * 33 + c4; d[0] = t[i].x; d[1] = t[i].y; d[2] = t[i].z; d[3] = t[i].w; }
    }
    LDS_WAIT(); asm volatile("" ::: "memory");
    const int c = lane & 7;
#pragma unroll
    for (int j = 0; j < 4; ++j) { const int n = (lane >> 3) + 8 * j; const LAS float* s = scr + (8 * c) * 33 + n;
        u32x4 o; o.x = cvt_pk_bf16(s[0 * 33], s[1 * 33]); o.y = cvt_pk_bf16(s[2 * 33], s[3 * 33]); o.z = cvt_pk_bf16(s[4 * 33], s[5 * 33]); o.w = cvt_pk_bf16(s[6 * 33], s[7 * 33]);
        const int nn = n0 + n; const int row = MAP == 1 ? win_map(nn) : (MAP == 2 ? glu_map(nn) : nn);
        *(u32x4*)(WT + (size_t)row * K + k0 + 8 * c) = o; }
    LDS_WAIT(); asm volatile("" ::: "memory");
}

constexpr float WDN_SCALE = 16.f, ACT_SCALE = 8.f;
constexpr float WIN_SCALE = 32.f;
template <int MAP>
__device__ __forceinline__ void transpose_item8(const float* W, int K, int N, unsigned char* WT, LAS float* scr, int item, int lane, float scale = WIN_SCALE) {
    const int nblk = N / 32, kb = item / nblk, nb = item % nblk, k0 = 64 * kb, n0 = 32 * nb;
    {
        const int rr = lane >> 3, c4 = (lane & 7) * 4; f32x4 t[8];
#pragma unroll
        for (int i = 0; i < 8; ++i) t[i] = __builtin_nontemporal_load((const f32x4*)(W + (size_t)(k0 + 8 * i + rr) * N + n0 + c4));
#pragma unroll
        for (int i = 0; i < 8; ++i) { LAS float* d = scr + (8 * i + rr) * 33 + c4; d[0] = t[i].x * scale; d[1] = t[i].y * scale; d[2] = t[i].z * scale; d[3] = t[i].w * scale; }
    }
    LDS_WAIT(); asm volatile("" ::: "memory");
    const int c = lane & 7;
#pragma unroll
    for (int j = 0; j < 4; ++j) { const int n = (lane >> 3) + 8 * j; const LAS float* sp = scr + (8 * c) * 33 + n;
        int d0 = 0, d1 = 0;
        d0 = __builtin_amdgcn_cvt_pk_fp8_f32(sp[0 * 33], sp[1 * 33], d0, false); d0 = __builtin_amdgcn_cvt_pk_fp8_f32(sp[2 * 33], sp[3 * 33], d0, true);
        d1 = __builtin_amdgcn_cvt_pk_fp8_f32(sp[4 * 33], sp[5 * 33], d1, false); d1 = __builtin_amdgcn_cvt_pk_fp8_f32(sp[6 * 33], sp[7 * 33], d1, true);
        const int nn = n0 + n; const int row = MAP == 1 ? win_map(nn) : (MAP == 2 ? glu_map(nn) : nn);
        *(u32x2*)(WT + (size_t)row * K + k0 + 8 * c) = (u32x2){(unsigned)d0, (unsigned)d1}; }
    LDS_WAIT(); asm volatile("" ::: "memory");
}
__device__ __forceinline__ void phase0(Frame& F) {
    if (F.vcu < 96) {
        const int col = F.vcu * 64 + F.lane; const float* c = F.in(I_C); const float* wa = F.in(I_WADA);
        float a0 = 0.f, a1 = 0.f;
        for (int k = F.wave * 128; k < F.wave * 128 + 128; ++k) { const float c0 = c[k], c1 = c[1024 + k]; const float s0 = c0 * sigmoidf_(c0), s1 = c1 * sigmoidf_(c1); const float w = wa[(size_t)k * 6144 + col]; a0 += s0 * w; a1 += s1 * w; }
        LAS float* red = (LAS float*)F.lds;
        red[(F.wave * 2 + 0) * 64 + F.lane] = a0; red[(F.wave * 2 + 1) * 64 + F.lane] = a1;
        __syncthreads();
        if (F.wave == 0) { float s0 = 0.f, s1 = 0.f;
#pragma unroll
            for (int w = 0; w < 8; ++w) { s0 += red[(w * 2 + 0) * 64 + F.lane]; s1 += red[(w * 2 + 1) * 64 + F.lane]; }
            float* mod = (float*)(F.ws + WS_MOD); const float bb = F.in(I_BADA)[col]; mod[col] = s0 + bb; mod[6144 + col] = s1 + bb; }
        __syncthreads();
    }
    LAS float* scr = (LAS float*)(F.lds + F.wave * 16384);
    const int gw = F.vcu * NWAVES + F.wave, NGW = F.G * NWAVES;
    constexpr int I_IN = 16 * (NIN / 32), I_SQ = 16 * 32, I_EGU = 16 * 16, I_EDN = 4 * 32;
    constexpr int NITEMS = I_IN + 2 * I_SQ + NEX * I_EGU + NEX * I_EDN;
    for (int it = gw; it < NITEMS; it += NGW) {
        int r = it;
        if (r < I_IN) { transpose_item8<1>(F.in(I_WIN), 1024, NIN, (unsigned char*)(F.ws + WS_WIN), scr, r, F.lane); continue; } r -= I_IN;
        if (r < I_SQ) { transpose_item8<0>(F.in(I_WPW2), 1024, 1024, (unsigned char*)(F.ws + WS_WPW2), scr, r, F.lane); continue; } r -= I_SQ;
        if (r < I_SQ) { transpose_item<0>(F.in(I_WOUT), 1024, 1024, (bf16*)(F.ws + WS_WOUT), scr, r, F.lane); continue; } r -= I_SQ;
        if (r < NEX * I_EGU) { const int e = r / I_EGU, rr = r % I_EGU; const float* W = e < NE ? F.in(I_WEGU) + (size_t)e * 1024 * 512 : F.in(I_WSGU);
            transpose_item8<2>(W, 1024, 512, (unsigned char*)(F.ws + WS_WGU) + (size_t)e * 512 * 1024, scr, rr, F.lane); continue; } r -= NEX * I_EGU;
        { const int e = r / I_EDN, rr = r % I_EDN; const float* W = e < NE ? F.in(I_WEDN) + (size_t)e * 256 * 1024 : F.in(I_WSDN);
            transpose_item8<0>(W, 256, 1024, (unsigned char*)(F.ws + WS_WDN) + (size_t)e * 1024 * 256, scr, rr, F.lane, WDN_SCALE); }
    }
    {
        const float* wr = F.in(I_WR); bf16* wh = (bf16*)(F.ws + WS_WRH); bf16* wl = (bf16*)(F.ws + WS_WRL);
        for (int idx = F.vcu * NTHREADS + F.tid; idx < 64 * 1024; idx += F.G * NTHREADS) { const int e = idx >> 10, k = idx & 1023; const float w = wr[k * 64 + e];
            const unsigned h = cvt_pk_bf16(w, 0.f) & 0xffffu; const float r = w - bf_lo(h); wh[idx] = (bf16)h; wl[idx] = (bf16)(cvt_pk_bf16(r, 0.f) & 0xffffu); }
    }
    {
        const int* pos = (const int*)F.in(I_POS); float* rope = (float*)(F.ws + WS_ROPE);
        for (int idx = F.vcu * NTHREADS + F.tid; idx < T * 8; idx += F.G * NTHREADS) {
            const int tok = idx >> 3, i = idx & 7;
            const unsigned fb = i == 0 ? 1065353216u : i == 1 ? 1044812719u : i == 2 ? 1025116360u : i == 3 ? 1005516622u : i == 4 ? 985226530u : i == 5 ? 965724408u : i == 6 ? 945754309u : 925697960u;
            const float ang = (float)pos[tok] * __builtin_bit_cast(float, fb);
            double rv = (double)ang * 0.15915494309189535; rv -= floor(rv);
            const float fr_ = (float)rv;
            rope[tok * 16 + i] = __builtin_amdgcn_cosf(fr_); rope[tok * 16 + 8 + i] = __builtin_amdgcn_sinf(fr_);
        }
    }
}

__device__ __forceinline__ void phase1(Frame& F) {
    const float* mod = (const float*)(F.ws + WS_MOD); const float* gn = F.in(I_N1G); bf16* H = (bf16*)F.out;
    const int gw = F.vcu * NWAVES + F.wave, NGW = F.G * NWAVES;
    for (int m = gw; m < T; m += NGW) {
        const int b = m >> 14;
        const f32x4* xr = (const f32x4*)(F.in(I_X) + (size_t)m * D) + F.lane;
        f32x4 v[4]; float s = 0.f;
#pragma unroll
        for (int j = 0; j < 4; ++j) { v[j] = xr[64 * j]; s += (v[j].x * v[j].x + v[j].y * v[j].y) + (v[j].z * v[j].z + v[j].w * v[j].w); }
        const float rstd = __builtin_amdgcn_rsqf(wave_sum(s) * (1.f / D) + EPS);
        unsigned* o4 = (unsigned*)((unsigned char*)H + (size_t)m * D) + F.lane;
#pragma unroll
        for (int j = 0; j < 4; ++j) { const int col = 4 * F.lane + 256 * j;
            const f32x4 g = *(const f32x4*)(gn + col), sc = *(const f32x4*)(mod + b * 6144 + 1024 + col), sh = *(const f32x4*)(mod + b * 6144 + col);
            const f32x4 y = v[j] * rstd * g * (sc + 1.f) + sh;
            int w = 0; w = __builtin_amdgcn_cvt_pk_fp8_f32(y.x, y.y, w, false); w = __builtin_amdgcn_cvt_pk_fp8_f32(y.z, y.w, w, true); o4[64 * j] = (unsigned)w; }
    }
}

struct EpiIn {
    static constexpr bool PERM = true;
    static constexpr float SI = 1.f / WIN_SCALE;
    bf16 *U, *Q, *Kb, *V, *GC, *GA; const float* rope; const float* qg; const float* kg; LAS unsigned char* scr;
    __device__ __forceinline__ void operator()(const f32x4 (&acc)[2][2][4][2], const pg8::Unit& u, int wr, int wc, int fr, int fq) const {
        asm volatile("" : "+v"(fr), "+v"(fq));
        const int pn = u.pn, row0 = u.pm * 256 + wr * 64 + fr;
        if (pn < 8) {
#pragma unroll
            for (int ai = 0; ai < 2; ++ai)
#pragma unroll
                for (int m = 0; m < 4; ++m) { const int row = row0 + ai * 128 + m * 16; float r[8];
#pragma unroll
                    for (int n = 0; n < 2; ++n)
#pragma unroll
                        for (int i = 0; i < 4; ++i) r[4 * n + i] = (acc[ai][0][m][n][i] * SI) * sigmoidf_(acc[ai][1][m][n][i] * SI);
                    u32x4 w; w.x = cvt_pk_bf16(r[0], r[1]); w.y = cvt_pk_bf16(r[2], r[3]); w.z = cvt_pk_bf16(r[4], r[5]); w.w = cvt_pk_bf16(r[6], r[7]);
                    *(u32x4*)(U + (size_t)row * D + pn * 128 + wc * 32 + fq * 8) = w; }
        } else if (pn < 16) {
            const bool isq = pn < 12; const int g = 4 * ((pn - 8) & 3) + wc, h = g >> 1, mp = g & 1;
            const float* gp = isq ? qg : kg; float gn[2][8];
#pragma unroll
            for (int bj = 0; bj < 2; ++bj)
#pragma unroll
                for (int e = 0; e < 8; ++e) gn[bj][e] = gp[qk_dim(bj, fq, e)] * (isq ? C2 * QSC : 1.f);
            bf16* dst = isq ? Q : Kb;
#pragma unroll
            for (int ai = 0; ai < 2; ++ai)
#pragma unroll
                for (int m = 0; m < 4; ++m) { const int row = row0 + ai * 128 + m * 16, b = row >> 14, s = row & (SEQ - 1);
                    float v[2][8]; float ss = 0.f;
#pragma unroll
                    for (int bj = 0; bj < 2; ++bj)
#pragma unroll
                        for (int n = 0; n < 2; ++n)
#pragma unroll
                            for (int i = 0; i < 4; ++i) { const float t = acc[ai][bj][m][n][i] * SI; v[bj][4 * n + i] = t; ss += t * t; }
                    ss += __shfl_xor(ss, 16); ss += __shfl_xor(ss, 32);
                    const float rstd = __builtin_amdgcn_rsqf(ss * (1.f / 64.f) + EPS);
#pragma unroll
                    for (int bj = 0; bj < 2; ++bj)
#pragma unroll
                        for (int e = 0; e < 8; ++e) v[bj][e] = v[bj][e] * rstd * gn[bj][e];
                    if (fq == 0) { const f32x4* rp = (const f32x4*)(rope + (size_t)row * 16); const f32x4 c0 = rp[0], c1 = rp[1], s0 = rp[2], s1 = rp[3];
#pragma unroll
                        for (int e = 0; e < 8; ++e) { const float cs = e < 4 ? c0[e & 3] : c1[e & 3], sn = e < 4 ? s0[e & 3] : s1[e & 3]; const float x1 = v[0][e], x2 = v[1][e];
                            v[0][e] = x1 * cs - x2 * sn; v[1][e] = x2 * cs + x1 * sn; } }
                    unsigned char* rowp = (unsigned char*)dst + ((size_t)((b * 8 + h) * 2 + mp) * SEQ + s) * 64;
                    const int sw = isq ? 0 : ((s >> 2) & 3);
                    u32x4 w;
                    { int d;
                      d = 0; d = __builtin_amdgcn_cvt_pk_fp8_f32(v[0][0], v[0][1], d, false); d = __builtin_amdgcn_cvt_pk_fp8_f32(v[0][2], v[0][3], d, true); w.x = (unsigned)d;
                      d = 0; d = __builtin_amdgcn_cvt_pk_fp8_f32(v[0][4], v[0][5], d, false); d = __builtin_amdgcn_cvt_pk_fp8_f32(v[0][6], v[0][7], d, true); w.y = (unsigned)d;
                      d = 0; d = __builtin_amdgcn_cvt_pk_fp8_f32(v[1][0], v[1][1], d, false); d = __builtin_amdgcn_cvt_pk_fp8_f32(v[1][2], v[1][3], d, true); w.z = (unsigned)d;
                      d = 0; d = __builtin_amdgcn_cvt_pk_fp8_f32(v[1][4], v[1][5], d, false); d = __builtin_amdgcn_cvt_pk_fp8_f32(v[1][6], v[1][7], d, true); w.w = (unsigned)d; }
                    *(u32x4*)(rowp + ((fq ^ sw) << 4)) = w; }
        } else if (pn < 20) {
            LAS unsigned char* wsb = scr + (wr * 4 + wc) * 2048; const int lane_ = fr + 16 * fq;
#pragma unroll
            for (int ai = 0; ai < 2; ++ai)
#pragma unroll
                for (int bj = 0; bj < 2; ++bj) {
#pragma unroll
                    for (int m = 0; m < 4; ++m) { const int kk = 16 * m + fr;
                        const int p = 32 * ((kk >> 2) & 1) + 16 * (kk >> 5) + (kk & 3) + 4 * ((kk & 31) >> 3);
#pragma unroll
                        for (int n = 0; n < 2; ++n) { const unsigned d01 = (unsigned)__builtin_amdgcn_cvt_pk_fp8_f32(acc[ai][bj][m][n][0] * SI, acc[ai][bj][m][n][1] * SI, 0, false);
                            const unsigned d23 = (unsigned)__builtin_amdgcn_cvt_pk_fp8_f32(acc[ai][bj][m][n][2] * SI, acc[ai][bj][m][n][3] * SI, 0, false);
#pragma unroll
                            for (int i = 0; i < 4; ++i) { const int e = 4 * n + i; const unsigned byte = ((i < 2 ? d01 : d23) >> (8 * (i & 1)));
                                const int sw = (2 * fq + (e >> 2)) & 3;
                                wsb[(fq * 8 + e) * 64 + ((((p >> 4) ^ sw) << 4) | (p & 15))] = (unsigned char)byte; } } }
                    LDS_WAIT(); asm volatile("" ::: "memory");
                    const u32x4 t0 = *(const LAS u32x4*)(wsb + lane_ * 32), t1 = *(const LAS u32x4*)(wsb + lane_ * 32 + 16);
                    const int row = u.pm * 256 + ai * 128 + wr * 64, b = row >> 14, s = row & (SEQ - 1), h = 2 * (pn - 16) + bj;
                    unsigned char* tp = (unsigned char*)V + (((size_t)(b * 8 + h) * 256 + (s >> 6)) * 128 + wc * 32) * 64 + lane_ * 32;
                    *(u32x4*)tp = t0; *(u32x4*)(tp + 16) = t1;
                    LDS_WAIT(); asm volatile("" ::: "memory"); }
        } else {
            bf16* dst = pn < 24 ? GC : GA; const int colt = ((pn - 20) & 3) * 256;
#pragma unroll
            for (int ai = 0; ai < 2; ++ai)
#pragma unroll
                for (int m = 0; m < 4; ++m) { const int row = row0 + ai * 128 + m * 16;
#pragma unroll
                    for (int bj = 0; bj < 2; ++bj) { float r[8];
#pragma unroll
                        for (int n = 0; n < 2; ++n)
#pragma unroll
                            for (int i = 0; i < 4; ++i) r[4 * n + i] = sigmoidf_(acc[ai][bj][m][n][i] * SI);
                        u32x4 w; w.x = cvt_pk_bf16(r[0], r[1]); w.y = cvt_pk_bf16(r[2], r[3]); w.z = cvt_pk_bf16(r[4], r[5]); w.w = cvt_pk_bf16(r[6], r[7]);
                        *(u32x4*)(dst + (size_t)row * D + colt + bj * 128 + wc * 32 + fq * 8) = w; } }
        }
    }
};

__device__ __forceinline__ void phase3(Frame& F) {
    const bf16* U = (const bf16*)(F.ws + WS_U); bf16* CV = (bf16*)F.out;
    const int ch = 2 * F.tid;
    float wa[31], wb[31];
#pragma unroll
    for (int j = 0; j < 31; ++j) { const f32x2 w = *(const f32x2*)(F.in(I_CDW) + j * 1024 + ch); wa[j] = w.x; wb[j] = w.y; }
    const f32x2 cb = *(const f32x2*)(F.in(I_CDWB) + ch);
    LAS float* tile = (LAS float*)F.lds;
    for (int unit = F.vcu; unit < T / 64; unit += F.G) {
        const int t0 = unit * 64, s0 = t0 & (SEQ - 1);
        float xa[38], xb[38];
#pragma unroll
        for (int k = 0; k < 30; ++k) { unsigned v = 0u; if (s0 - 30 + k >= 0) v = *(const unsigned*)(U + (size_t)(t0 - 30 + k) * D + ch); xa[k] = bf_lo(v); xb[k] = bf_hi(v); }
        for (int blk = 0; blk < 8; ++blk) {
#pragma unroll
            for (int k = 0; k < 8; ++k) { const unsigned v = *(const unsigned*)(U + (size_t)(t0 + blk * 8 + k) * D + ch); xa[30 + k] = bf_lo(v); xb[30 + k] = bf_hi(v); }
            LAS float* tl = tile + (blk & 1) * 8192;
#pragma unroll
            for (int i = 0; i < 8; ++i) { float a = cb.x, b = cb.y;
#pragma unroll
                for (int j = 0; j < 31; ++j) { a += xa[i + j] * wa[j]; b += xb[i + j] * wb[j]; }
                *(LAS f32x2*)(tl + i * 1024 + ch) = (f32x2){a, b}; }
#pragma unroll
            for (int k = 0; k < 30; ++k) { xa[k] = xa[k + 8]; xb[k] = xb[k + 8]; }
            __syncthreads();
            {
                const LAS float* rowp = tl + F.wave * 1024;
                f32x4 v[4];
#pragma unroll
                for (int jj = 0; jj < 2; ++jj) { v[2 * jj] = *(const LAS f32x4*)(rowp + 512 * jj + 8 * F.lane); v[2 * jj + 1] = *(const LAS f32x4*)(rowp + 512 * jj + 8 * F.lane + 4); }
                float s = 0.f;
#pragma unroll
                for (int q = 0; q < 4; ++q) s += (v[q].x + v[q].y) + (v[q].z + v[q].w);
                const float mean = wave_sum(s) * (1.f / D); float s2 = 0.f;
#pragma unroll
                for (int q = 0; q < 4; ++q) { v[q] = v[q] - mean; s2 += (v[q].x * v[q].x + v[q].y * v[q].y) + (v[q].z * v[q].z + v[q].w * v[q].w); }
                const float rstd = __builtin_amdgcn_rsqf(wave_sum(s2) * (1.f / D) + EPS);
                bf16* op = (bf16*)((unsigned char*)CV + (size_t)(t0 + blk * 8 + F.wave) * D);
#pragma unroll
                for (int jj = 0; jj < 2; ++jj) { const int col = 512 * jj + 8 * F.lane; float r[8];
#pragma unroll
                    for (int q = 0; q < 2; ++q) { const f32x4 g = *(const f32x4*)(F.in(I_CLNG) + col + 4 * q), bb = *(const f32x4*)(F.in(I_CLNB) + col + 4 * q); const f32x4 y = v[2 * jj + q] * rstd * g + bb;
#pragma unroll
                        for (int i = 0; i < 4; ++i) r[4 * q + i] = y[i] * sigmoidf_(y[i]); }
                    int d0 = 0, d1 = 0;
                    d0 = __builtin_amdgcn_cvt_pk_fp8_f32(r[0], r[1], d0, false); d0 = __builtin_amdgcn_cvt_pk_fp8_f32(r[2], r[3], d0, true);
                    d1 = __builtin_amdgcn_cvt_pk_fp8_f32(r[4], r[5], d1, false); d1 = __builtin_amdgcn_cvt_pk_fp8_f32(r[6], r[7], d1, true);
                    *(u32x2*)((unsigned char*)op + col) = (u32x2){(unsigned)d0, (unsigned)d1}; }
            }
        }
        __syncthreads();
    }
}

struct EpiPw2 {
    static constexpr bool PERM = true;
    bf16* O; const bf16* GC; const float* bias;
    __device__ __forceinline__ void operator()(const f32x4 (&acc)[2][2][4][2], const pg8::Unit& u, int wr, int wc, int fr, int fq) const {
        const int row0 = u.pm * 256 + wr * 64 + fr, col0 = u.pn * 256 + wc * 32 + fq * 8;
#pragma unroll
        for (int ai = 0; ai < 2; ++ai)
#pragma unroll
            for (int m = 0; m < 4; ++m) { const int row = row0 + ai * 128 + m * 16;
#pragma unroll
                for (int bj = 0; bj < 2; ++bj) { const int col = col0 + bj * 128; const u32x4 gv = *(const u32x4*)(GC + (size_t)row * D + col);
                    const f32x4 b0 = *(const f32x4*)(bias + col), b1 = *(const f32x4*)(bias + col + 4); float r[8];
#pragma unroll
                    for (int i = 0; i < 4; ++i) { r[i] = acc[ai][bj][m][0][i] * (1.f / WIN_SCALE) + b0[i]; r[4 + i] = acc[ai][bj][m][1][i] * (1.f / WIN_SCALE) + b1[i]; }
                    r[0] *= bf_lo(gv.x); r[1] *= bf_hi(gv.x); r[2] *= bf_lo(gv.y); r[3] *= bf_hi(gv.y); r[4] *= bf_lo(gv.z); r[5] *= bf_hi(gv.z); r[6] *= bf_lo(gv.w); r[7] *= bf_hi(gv.w);
                    u32x4 w; w.x = cvt_pk_bf16(r[0], r[1]); w.y = cvt_pk_bf16(r[2], r[3]); w.z = cvt_pk_bf16(r[4], r[5]); w.w = cvt_pk_bf16(r[6], r[7]);
                    *(u32x4*)(O + (size_t)row * D + col) = w; } }
    }
};

namespace att {
constexpr int SLOT = 32768, NSLOT = 3, XOFF = NSLOT * SLOT;
typedef int i32x8 __attribute__((ext_vector_type(8)));
__device__ __forceinline__ int crow(int r, int hi) { return (r & 3) + 8 * (r >> 2) + 4 * hi; }
__device__ __forceinline__ s16x4 vtr(const LAS char* p) { typedef short v4i16_t __attribute__((ext_vector_type(4))); return __builtin_bit_cast(s16x4, __builtin_amdgcn_ds_read_tr16_b64_v4i16((LAS v4i16_t*)p)); }
#define BUF_DMA16(m0v, voff, srd, soff) asm volatile("s_mov_b32 m0, %0\n\ts_nop 0\n\tbuffer_load_dwordx4 %1, %2, %3 offen lds" :: "s"(m0v), "v"(voff), "s"(srd), "s"(soff) : "m0", "memory")
#define ATT_SB() __builtin_amdgcn_sched_barrier(0)
#ifndef VLA
#define VLA 4
#endif
struct DmaSet { unsigned m0[2], so[2]; };
__device__ __forceinline__ f32x16 zacc() { return (f32x16){0.f, 0.f, 0.f, 0.f, 0.f, 0.f, 0.f, 0.f, 0.f, 0.f, 0.f, 0.f, 0.f, 0.f, 0.f, 0.f}; }
__device__ __forceinline__ f32x16 mfma8(i32x8 a, i32x8 b, f32x16 c) { return __builtin_amdgcn_mfma_scale_f32_32x32x64_f8f6f4(a, b, c, 0, 0, 0, 0, 0, 0); }
#define ATT_KFRAG(kp, blk) ({ const u32x4 lo_ = *(const LAS u32x4*)((kp) + (blk) * 2048 + kc0), hi_ = *(const LAS u32x4*)((kp) + (blk) * 2048 + kc1); \
        (i32x8){(int)lo_.x, (int)lo_.y, (int)lo_.z, (int)lo_.w, (int)hi_.x, (int)hi_.y, (int)hi_.z, (int)hi_.w}; })
template <bool MASK>
__device__ __forceinline__ void shift_mask(f32x16& c0, f32x16& c1, int kb, int qrow, float negM, bool shift) {
    if (shift) {
#pragma unroll
        for (int r = 0; r < 16; ++r) { c0[r] += negM; c1[r] += negM; } }
    if (MASK) {
#pragma unroll
        for (int r = 0; r < 16; ++r) { const int kv = kb + (r & 3) + 8 * (r >> 2); if (kv > qrow) c0[r] = -INFINITY; if (kv + 32 > qrow) c1[r] = -INFINITY; } }
}
#define ATT_VFRAG(dst, i) do { const s16x4 lo_ = vtr(vp + ((i) & 3) * 4096 + ((i) >> 2) * 1024), hh_ = vtr(vp + ((i) & 3) * 4096 + ((i) >> 2) * 1024 + 512); \
        dst = (bf16x8){lo_[0], lo_[1], lo_[2], lo_[3], hh_[0], hh_[1], hh_[2], hh_[3]}; } while (0)
__device__ __forceinline__ int exp2_bf8x4(float a, float b, float c, float d) {
    unsigned w = __builtin_amdgcn_cvt_pk_u8_f32(a, 0u, 0u); w = __builtin_amdgcn_cvt_pk_u8_f32(b, 1u, w); w = __builtin_amdgcn_cvt_pk_u8_f32(c, 2u, w); w = __builtin_amdgcn_cvt_pk_u8_f32(d, 3u, w);
    return (int)w;
}
__device__ __forceinline__ f32x16 mfma_pv(i32x8 p, i32x8 v, f32x16 c) { return __builtin_amdgcn_mfma_scale_f32_32x32x64_f8f6f4(p, v, c, 1, 0, 0, 0, 0, 0); }
__device__ __forceinline__ f32x4 mfma_sum(i32x8 p, i32x8 sel, f32x4 c) { return __builtin_amdgcn_mfma_scale_f32_16x16x128_f8f6f4(p, sel, c, 1, 0, 0, 0, 0, 0); }
template <bool SECOND>
__device__ __forceinline__ void mask16(f32x16& c, int kb, int qrow) {
    int d = qrow - kb; asm volatile("" : "+v"(d));
#pragma unroll
    for (int r = 0; r < 16; ++r) { if ((r & 3) + 8 * (r >> 2) + (SECOND ? 32 : 0) > d) c[r] = -1e30f; }
}
__device__ __forceinline__ void att_step(bool MASK, f32x16 (&o)[4], i32x8 (&kf)[2], const i32x8& qf, const f32x16& cinit, f32x4& lacc, const i32x8& ones, const i32x8& pfp, i32x8& pfc,
                                         const LAS char* vp, const LAS char* kpn, int kc0, int kc1, int kb, int qrow,
                                         const DmaSet& dm, unsigned vdma, __amdgpu_buffer_rsrc_t srdK, __amdgpu_buffer_rsrc_t srdV) {
    i32x8 vf[4]; f32x16 c0, c1;
    vf[0] = ATT_KFRAG(vp, 0); vf[1] = ATT_KFRAG(vp, 1);
    c0 = mfma8(kf[0], qf, cinit);
    vf[2] = ATT_KFRAG(vp, 2); vf[3] = ATT_KFRAG(vp, 3);
    c1 = mfma8(kf[1], qf, cinit);
    ATT_SB();
#pragma unroll
    for (int i = 0; i < 4; ++i) {
        o[i] = mfma_pv(pfp, vf[i], o[i]);
        if (i == 0) BUF_DMA16(dm.m0[0], vdma, srdK, dm.so[0]);
        if (i == 1) kf[0] = ATT_KFRAG(kpn, 0);
        if (i == 2) kf[1] = ATT_KFRAG(kpn, 1);
        if (MASK && i == 0) mask16<false>(c0, kb, qrow);
        if (MASK && i == 2) mask16<true>(c1, kb, qrow);
        { const f32x16& C = i < 2 ? c0 : c1; const int e = 8 * (i & 1);
          int w0 = exp2_bf8x4(C[e], C[e + 1], C[e + 2], C[e + 3]), w1 = exp2_bf8x4(C[e + 4], C[e + 5], C[e + 6], C[e + 7]);
          asm volatile("" : "+v"(w0), "+v"(w1)); pfc[2 * i] = w0; pfc[2 * i + 1] = w1; }
        if (i == 3) BUF_DMA16(dm.m0[1], vdma, srdV, dm.so[1]);
        ATT_SB();
    }
    lacc = mfma_sum(pfp, ones, lacc);
}
__device__ __forceinline__ void att_drain(f32x16 (&o)[4], const i32x8& pf, f32x4& lacc, const i32x8& ones, const LAS char* vp, int kc0, int kc1) {
#pragma unroll
    for (int i = 0; i < 4; ++i) { const i32x8 f = ATT_KFRAG(vp, i); o[i] = mfma_pv(pf, f, o[i]); }
    lacc = mfma_sum(pf, ones, lacc);
}

__device__ __forceinline__ void phase5(Frame& F, bf16* MGout) {
    const bf16* GA = (const bf16*)(F.ws + WS_GA); bf16* MG = (bf16*)(F.ws + WS_U);
    const int lane = F.lane, r32 = lane & 31, hi = lane >> 5, wid = F.wave, rg = wid & 3, mp = wid >> 2;
    float lam;
    {
        const float q1 = F.in(I_LQ1)[lane], k1 = F.in(I_LK1)[lane], q2 = F.in(I_LQ2)[lane], k2 = F.in(I_LK2)[lane];
        lam = __expf(wave_sum(q1 * k1)) - __expf(wave_sum(q2 * k2)) + LAMBDA_INIT;
    }
    f32x16 cinit;
    { float pb = PBIAS; asm volatile("" : "+v"(pb));
#pragma unroll
      for (int r = 0; r < 16; ++r) cinit[r] = pb; }
    const int one4 = (lane & 15) == ((lane >> 4) & 1) ? 0x38383838 : 0;
    const i32x8 ones = {one4, one4, one4, one4, one4, one4, one4, one4};
    LAS char* ring = (LAS char*)F.lds;
    const unsigned ring0 = (unsigned)(size_t)ring;
    const int voff = r32 * 64;
    const int ksw = (r32 >> 2) & 3;
    const int koff = r32 * 64 + mp * 4096, kc0 = ((2 * hi) ^ ksw) << 4, kc1 = ((2 * hi + 1) ^ ksw) << 4;
    const __amdgpu_buffer_rsrc_t srdK = __builtin_amdgcn_make_buffer_rsrc((void*)(F.ws + WS_K), (short)0, 64 << 20, 0x00020000);
    const __amdgpu_buffer_rsrc_t srdV = __builtin_amdgcn_make_buffer_rsrc((void*)(F.ws + WS_V), (short)0, 64 << 20, 0x00020000);
    const __amdgpu_buffer_rsrc_t srdQ = __builtin_amdgcn_make_buffer_rsrc((void*)(F.ws + WS_Q), (short)0, 64 << 20, 0x00020000);
    const unsigned vdma = (unsigned)(wid * 1024 + lane * 16);
    const unsigned vdmk = (unsigned)((wid & 3) * 1024 + lane * 16);
    const unsigned vq = (unsigned)(r32 * 64 + hi * 32);
    if (wid >= 4) __builtin_amdgcn_s_setprio(1);
#ifndef DBG_ATT2
#define DBG_ATT2 0
#endif
    for (int p_ = F.vcu; p_ < (DBG_ATT2 ? 2048 : 1024); p_ += F.G) {
        const int p = p_ & 1023; bf16* const MGo = (DBG_ATT2 && p_ < 1024) ? (bf16*)F.out : MGout;
        const int bh = p >> 6, j = p & 63;
        for (int half = 0; half < 2; ++half) {
            const int qt = half == 0 ? j : 127 - j;
            const int NT = 2 * (qt + 1);
            const unsigned kxoff = (unsigned)(bh * 2 + (wid >> 2)) * (SEQ * 64u), voffg = (unsigned)bh * (256u * 8192u);
#define ATT_ISSUE_K(tk_, dst_) do { const unsigned tk__ = (unsigned)((tk_) < NT ? (tk_) : NT - 1) * 4096u; BUF_DMA16(ring0 + (dst_) + wid * 1024, vdmk, srdK, kxoff + tk__); } while (0)
#define ATT_ISSUE_V(tv_, dst_) do { const unsigned tv__ = voffg + (unsigned)((tv_) < NT ? (tv_) : NT - 1) * 8192u; BUF_DMA16(ring0 + (dst_) + wid * 1024, vdma, srdV, tv__); } while (0)
            u32x4 q0, q1;
            { const unsigned qs = ((unsigned)(bh * 2 + mp) * SEQ + (unsigned)(qt * 128 + rg * 32)) * 64u;
              asm volatile("buffer_load_dwordx4 %0, %2, %3, %4 offen\n\tbuffer_load_dwordx4 %1, %2, %3, %4 offen offset:16"
                           : "=&v"(q0), "=&v"(q1) : "v"(vq), "s"(srdQ), "s"(qs) : "memory"); }
            ATT_ISSUE_K(0, XOFF); ATT_ISSUE_K(1, XOFF + 16384);
            ATT_ISSUE_K(2, 0); ATT_ISSUE_V(0, 16384);
            ATT_ISSUE_K(3, SLOT); ATT_ISSUE_V(1, SLOT + 16384);
            asm volatile("s_waitcnt vmcnt(4)\n\ts_barrier" : "+v"(q0), "+v"(q1) :: "memory");
            const i32x8 qf = {(int)q0.x, (int)q0.y, (int)q0.z, (int)q0.w, (int)q1.x, (int)q1.y, (int)q1.z, (int)q1.w};
            f32x16 o[4];
#pragma unroll
            for (int vb = 0; vb < 4; ++vb)
#pragma unroll
                for (int r = 0; r < 16; ++r) o[vb][r] = 0.f;
            f32x4 lacc = {0.f, 0.f, 0.f, 0.f};
            const int qrow = qt * 128 + rg * 32 + r32;
            i32x8 kf[2], pfA, pfB;
            { const LAS char* kp0 = ring + XOFF + koff; f32x16 c0, c1;
              kf[0] = ATT_KFRAG(kp0, 0); kf[1] = ATT_KFRAG(kp0, 1);
              c0 = mfma8(kf[0], qf, cinit); c1 = mfma8(kf[1], qf, cinit);
              if (NT == 2) { mask16<false>(c0, 4 * hi, qrow); mask16<true>(c1, 4 * hi, qrow); }
#pragma unroll
              for (int d = 0; d < 8; ++d) { const f32x16& C = d < 4 ? c0 : c1; const int e = 4 * (d & 3); pfA[d] = exp2_bf8x4(C[e], C[e + 1], C[e + 2], C[e + 3]); } }
            { const LAS char* kp1 = ring + XOFF + 16384 + koff; kf[0] = ATT_KFRAG(kp1, 0); kf[1] = ATT_KFRAG(kp1, 1); }
            unsigned sl_use = 0, sl_mid = SLOT, sl_new = 2 * SLOT;
#define ATT_STEP(MASKED, PFC, PFP, t_) do { asm volatile("s_waitcnt vmcnt(2) lgkmcnt(0)\n\ts_barrier" ::: "memory"); \
                DmaSet dm; { const unsigned tk__ = (unsigned)(((t_) + 3) < NT ? ((t_) + 3) : NT - 1) * 4096u, tv__ = voffg + (unsigned)(((t_) + 1) < NT ? ((t_) + 1) : NT - 1) * 8192u, d__ = ring0 + sl_new + wid * 1024; \
                    dm.m0[0] = d__; dm.m0[1] = d__ + 16384u; dm.so[0] = kxoff + tk__ - (unsigned)(wid >> 2) * 4096u; dm.so[1] = tv__; }   \
                { const LAS char* vp = ring + sl_use + 16384 + voff; const LAS char* kpn = ring + sl_use + koff; \
                  att_step(MASKED, o, kf, qf, cinit, lacc, ones, PFP, PFC, vp, kpn, kc0, kc1, 64 * (t_) + 4 * hi, qrow, dm, vdma, srdK, srdV); } \
                { const unsigned t__ = sl_use; sl_use = sl_mid; sl_mid = sl_new; sl_new = t__; } } while (0)
            int t = 1;
            for (; t + 1 < NT; t += 2) { ATT_STEP(false, pfB, pfA, t); ATT_STEP((t + 1 >= NT - 2), pfA, pfB, t + 1); }
            ATT_STEP(true, pfB, pfA, NT - 1);
            const size_t eidx = ((size_t)(bh >> 3) * SEQ + qt * 128 + (F.tid >> 2)) * D + (bh & 7) * 128 + (F.tid & 3) * 32;
            u32x4 gaP[4], mcP[4];
#pragma unroll
            for (int c8 = 0; c8 < 4; ++c8) { gaP[c8] = *(const u32x4*)(GA + eidx + c8 * 8); mcP[c8] = *(const u32x4*)(MG + eidx + c8 * 8); }
            f32x4 sgP[8];
            { const float* sgp = F.in(I_SUBG) + (F.tid & 3) * 32; asm volatile("" : "+v"(sgp));
#pragma unroll
              for (int c4 = 0; c4 < 8; ++c4) sgP[c4] = *(const __attribute__((address_space(1))) f32x4*)(sgp + c4 * 4); }
            asm volatile("s_waitcnt vmcnt(16) lgkmcnt(0)\n\ts_barrier" ::: "memory");
            att_drain(o, pfB, lacc, ones, ring + sl_use + 16384 + voff, kc0, kc1);
#undef ATT_STEP
#undef ATT_ISSUE_K
#undef ATT_ISSUE_V
            float rl[16];
            { int hi_e = hi; asm volatile("" : "+v"(hi_e));
#pragma unroll
              for (int r = 0; r < 16; ++r) rl[r] = __builtin_amdgcn_rcpf(__shfl(lacc[r & 3], 16 * (2 * ((r >> 2) & 1) + hi_e) + (r >> 3))); }
            asm volatile("s_waitcnt lgkmcnt(0)\n\ts_barrier" ::: "memory");
            LAS float* xch = (LAS float*)ring + rg * 4096;
            if (mp == 1) {
#pragma unroll
                for (int vb = 0; vb < 4; ++vb)
#pragma unroll
                    for (int r = 0; r < 16; ++r) xch[(vb * 16 + r) * 64 + lane] = o[vb][r] * rl[r] * lam;
            }
            asm volatile("s_waitcnt lgkmcnt(0)\n\ts_barrier" ::: "memory");
            if (mp == 0) {
                float ssq[16];
#pragma unroll
                for (int r = 0; r < 16; ++r) ssq[r] = 0.f;
#pragma unroll
                for (int vb = 0; vb < 4; ++vb)
#pragma unroll
                    for (int r = 0; r < 16; ++r) { const float d = o[vb][r] * rl[r] - xch[(vb * 16 + r) * 64 + lane]; o[vb][r] = d; ssq[r] += d * d; }
#pragma unroll
                for (int r = 0; r < 16; ++r) { float s = ssq[r];
#pragma unroll
                    for (int off = 1; off < 32; off <<= 1) s += __shfl_xor(s, off);
                    ssq[r] = __builtin_amdgcn_rsqf(s * (1.f / 128.f) + EPS) * (1.f - LAMBDA_INIT); }
#pragma unroll
                for (int vb = 0; vb < 4; ++vb)
#pragma unroll
                    for (int r = 0; r < 16; ++r) xch[(vb * 16 + r) * 64 + lane] = o[vb][r] * ssq[r];
            }
            asm volatile("s_waitcnt lgkmcnt(0)\n\ts_barrier" ::: "memory");
            {
                const int b = bh >> 3, h = bh & 7, q = F.tid >> 2, vb = F.tid & 3, q5 = q & 31;
                const int rr = (q5 & 3) + 4 * (q5 >> 3), hh = (q5 >> 2) & 1;
                const LAS float* src = (const LAS float*)ring + (q >> 5) * 4096 + (vb * 16 + rr) * 64 + hh * 32;
                const size_t idx = eidx; (void)b; (void)h;
#pragma unroll
                for (int c8 = 0; c8 < 4; ++c8) { const f32x4 y0 = *(const LAS f32x4*)(src + c8 * 8), y1 = *(const LAS f32x4*)(src + c8 * 8 + 4);
                    const f32x4 g0 = sgP[2 * c8], g1 = sgP[2 * c8 + 1];
                    const u32x4 ga = gaP[c8], mc = mcP[c8];
                    u32x4 w;
                    w.x = cvt_pk_bf16(y0[0] * g0[0] * bf_lo(ga.x) + bf_lo(mc.x), y0[1] * g0[1] * bf_hi(ga.x) + bf_hi(mc.x));
                    w.y = cvt_pk_bf16(y0[2] * g0[2] * bf_lo(ga.y) + bf_lo(mc.y), y0[3] * g0[3] * bf_hi(ga.y) + bf_hi(mc.y));
                    w.z = cvt_pk_bf16(y1[0] * g1[0] * bf_lo(ga.z) + bf_lo(mc.z), y1[1] * g1[1] * bf_hi(ga.z) + bf_hi(mc.z));
                    w.w = cvt_pk_bf16(y1[2] * g1[2] * bf_lo(ga.w) + bf_lo(mc.w), y1[3] * g1[3] * bf_hi(ga.w) + bf_hi(mc.w));
                    *(u32x4*)(MGo + idx + c8 * 8) = w; }
            }
            asm volatile("s_waitcnt lgkmcnt(0)\n\ts_barrier" ::: "memory");
        }
    }
    __builtin_amdgcn_s_setprio(0);
}
}

struct EpiOut {
    static constexpr bool PERM = true;
    const float* X; float* O; const float* mod;
    __device__ __forceinline__ void operator()(const f32x4 (&acc)[2][2][4][2], const pg8::Unit& u, int wr, int wc, int fr, int fq) const {
        const int row0 = u.pm * 256 + wr * 64 + fr, col0 = u.pn * 256 + wc * 32 + fq * 8;
#pragma unroll
        for (int ai = 0; ai < 2; ++ai)
#pragma unroll
            for (int m = 0; m < 4; ++m) { const int row = row0 + ai * 128 + m * 16, b = row >> 14;
#pragma unroll
                for (int bj = 0; bj < 2; ++bj)
#pragma unroll
                    for (int n = 0; n < 2; ++n) { const int col = col0 + bj * 128 + 4 * n; const f32x4 g = *(const f32x4*)(mod + b * 6144 + 2048 + col), xv = *(const f32x4*)(X + (size_t)row * D + col);
                        *(f32x4*)(O + (size_t)row * D + col) = xv + g * acc[ai][bj][m][n]; } }
    }
};

__device__ __forceinline__ void phase7(Frame& F) {
    const float* X1 = F.out; const float* mod = (const float*)(F.ws + WS_MOD); const float* gn = F.in(I_N2G); bf16* H2 = (bf16*)(F.ws + WS_U);
    constexpr int PITCH = 272;
    LAS char* Ahi = (LAS char*)F.lds;
    LAS char* Alo = Ahi + 128 * PITCH;
    LAS char* Whi = Alo + 128 * PITCH;
    LAS char* Wlo = Whi + 64 * PITCH;
    LAS float* RS = (LAS float*)(F.lds + 104448);
    LAS int* CW = (LAS int*)(F.lds + 104960);
    LAS unsigned char* RK = (LAS unsigned char*)(F.lds + 105472);
    LAS float* LG = (LAS float*)F.lds;
    const int tid = F.tid, lane = F.lane, wid = F.wave, r32 = lane & 31, hi = lane >> 5;
    const bf16* WRH = (const bf16*)(F.ws + WS_WRH); const bf16* WRL = (const bf16*)(F.ws + WS_WRL);
    for (int chunk = F.vcu; chunk < T / 128; chunk += F.G) {
        const int t0 = chunk * 128, b = t0 >> 14;
        for (int i4 = 0; i4 < 16; i4 += 4) {
            f32x4 v[4][4]; float ss[4];
#pragma unroll
            for (int u = 0; u < 4; ++u) { const f32x4* xr = (const f32x4*)(X1 + (size_t)(t0 + wid * 16 + i4 + u) * D) + lane;
#pragma unroll
                for (int j = 0; j < 4; ++j) v[u][j] = xr[64 * j]; }
#pragma unroll
            for (int u = 0; u < 4; ++u) { float s = 0.f;
#pragma unroll
                for (int j = 0; j < 4; ++j) s += (v[u][j].x * v[u][j].x + v[u][j].y * v[u][j].y) + (v[u][j].z * v[u][j].z + v[u][j].w * v[u][j].w);
                ss[u] = s; }
#pragma unroll
            for (int o_ = 1; o_ < 64; o_ <<= 1) {
#pragma unroll
                for (int u = 0; u < 4; ++u) ss[u] += __shfl_xor(ss[u], o_); }
#pragma unroll
            for (int u = 0; u < 4; ++u) { const int m = t0 + wid * 16 + i4 + u; const float rstd = __builtin_amdgcn_rsqf(ss[u] * (1.f / D) + EPS);
                if (lane == 0) RS[wid * 16 + i4 + u] = rstd;
                unsigned* o4 = (unsigned*)((unsigned char*)H2 + (size_t)m * D) + lane;
#pragma unroll
                for (int j = 0; j < 4; ++j) { const int col = 4 * lane + 256 * j;
                    const f32x4 g = *(const f32x4*)(gn + col), sc = *(const f32x4*)(mod + b * 6144 + 4096 + col), sh = *(const f32x4*)(mod + b * 6144 + 3072 + col);
                    const f32x4 y = v[u][j] * rstd * g * (sc + 1.f) + sh;
                    int w = 0; w = __builtin_amdgcn_cvt_pk_fp8_f32(y.x, y.y, w, false); w = __builtin_amdgcn_cvt_pk_fp8_f32(y.z, y.w, w, true); o4[64 * j] = (unsigned)w; } } }
        __syncthreads();
        f32x16 c;
#pragma unroll
        for (int r = 0; r < 16; ++r) c[r] = 0.f;
        const int tb = wid & 3, eb = wid >> 2;
        for (int ks = 0; ks < 8; ++ks) {
            { const int row = tid & 127, seg = tid >> 7; const float rstd = RS[row];
              const float* xp = X1 + (size_t)(t0 + row) * D + ks * 128 + seg * 32;
              unsigned wh[16], wl[16];
#pragma unroll
              for (int q = 0; q < 8; ++q) { const int col = ks * 128 + seg * 32 + 4 * q; const f32x4 xv = *(const f32x4*)(xp + 4 * q);
                  const f32x4 g = *(const f32x4*)(gn + col), sc = *(const f32x4*)(mod + b * 6144 + 4096 + col), sh = *(const f32x4*)(mod + b * 6144 + 3072 + col);
                  const f32x4 y = xv * rstd * g * (sc + 1.f) + sh;
                  const unsigned h0 = cvt_pk_bf16(y.x, y.y), h1 = cvt_pk_bf16(y.z, y.w);
                  wh[2 * q] = h0; wh[2 * q + 1] = h1;
                  wl[2 * q] = cvt_pk_bf16(y.x - bf_lo(h0), y.y - bf_hi(h0)); wl[2 * q + 1] = cvt_pk_bf16(y.z - bf_lo(h1), y.w - bf_hi(h1)); }
#pragma unroll
              for (int q = 0; q < 4; ++q) { *(LAS u32x4*)(Ahi + row * PITCH + seg * 64 + q * 16) = (u32x4){wh[4 * q], wh[4 * q + 1], wh[4 * q + 2], wh[4 * q + 3]};
                  *(LAS u32x4*)(Alo + row * PITCH + seg * 64 + q * 16) = (u32x4){wl[4 * q], wl[4 * q + 1], wl[4 * q + 2], wl[4 * q + 3]}; }
#pragma unroll
              for (int q = 0; q < 2; ++q) { const int cc = tid + 512 * q, e = cc >> 4, kc = cc & 15;
                  *(LAS u32x4*)(Whi + e * PITCH + kc * 16) = *(const u32x4*)(WRH + e * 1024 + ks * 128 + kc * 8);
                  *(LAS u32x4*)(Wlo + e * PITCH + kc * 16) = *(const u32x4*)(WRL + e * 1024 + ks * 128 + kc * 8); } }
            __syncthreads();
#pragma unroll
            for (int st = 0; st < 8; ++st) { const int ao = (tb * 32 + r32) * PITCH + (2 * st + hi) * 16, bo = (eb * 32 + r32) * PITCH + (2 * st + hi) * 16;
                const bf16x8 ah = *(const LAS bf16x8*)(Ahi + ao), al = *(const LAS bf16x8*)(Alo + ao), bh = *(const LAS bf16x8*)(Whi + bo), bl = *(const LAS bf16x8*)(Wlo + bo);
                c = __builtin_amdgcn_mfma_f32_32x32x16_bf16(ah, bh, c, 0, 0, 0); c = __builtin_amdgcn_mfma_f32_32x32x16_bf16(ah, bl, c, 0, 0, 0); c = __builtin_amdgcn_mfma_f32_32x32x16_bf16(al, bh, c, 0, 0, 0); }
            __syncthreads();
        }
#pragma unroll
        for (int r = 0; r < 16; ++r) LG[(tb * 32 + att::crow(r, hi)) * 65 + eb * 32 + r32] = c[r];
        __syncthreads();
        unsigned long long chosen = 0ull; int ek[8]; float sk[8];
        if (tid < 128) {
            LAS float* L = LG + tid * 65;
            float gs[8];
#pragma unroll
            for (int g = 0; g < 8; ++g) { float m1 = -INFINITY, m2 = -INFINITY;
#pragma unroll
                for (int jx = 0; jx < 8; ++jx) { const float sc = sigmoidf_(L[g * 8 + jx]); const float ch = sc + F.in(I_RB)[g * 8 + jx]; L[g * 8 + jx] = ch;
                    if (ch > m1) { m2 = m1; m1 = ch; } else if (ch > m2) m2 = ch; }
                gs[g] = m1 + m2; }
            unsigned gm = 0u;
#pragma unroll
            for (int it = 0; it < 4; ++it) { float best = -INFINITY; int bi = 0;
#pragma unroll
                for (int g = 0; g < 8; ++g) { const bool ok = !((gm >> g) & 1u) && gs[g] > best; best = ok ? gs[g] : best; bi = ok ? g : bi; }
                gm |= 1u << bi; }
            int gsel[4]; float cand[32];
            { unsigned m = gm;
#pragma unroll
              for (int sx = 0; sx < 4; ++sx) { const int g = __builtin_ctz(m); m &= m - 1u; gsel[sx] = g;
#pragma unroll
                  for (int jx = 0; jx < 8; ++jx) cand[sx * 8 + jx] = L[g * 8 + jx]; } }
            float ssum = 0.f;
#pragma unroll
            for (int it = 0; it < 8; ++it) { float best = -INFINITY; int bi = 0;
#pragma unroll
                for (int i = 0; i < 32; ++i) { const bool ok = cand[i] > best; best = ok ? cand[i] : best; bi = ok ? i : bi; }
#pragma unroll
                for (int i = 0; i < 32; ++i) cand[i] = (i == bi) ? -INFINITY : cand[i];
                const int sx = bi >> 3; const int g = sx == 0 ? gsel[0] : sx == 1 ? gsel[1] : sx == 2 ? gsel[2] : gsel[3]; const int e = g * 8 + (bi & 7);
                chosen |= 1ull << e; ek[it] = e; const float sc = best - F.in(I_RB)[e]; sk[it] = sc; ssum += sc; }
            const float inv = 2.5f / ssum;
#pragma unroll
            for (int it = 0; it < 8; ++it) sk[it] *= inv;
        }
        if (wid < 2) {
            for (int e = 0; e < 64; ++e) { const bool f = (chosen >> e) & 1ull; const unsigned long long bm = __ballot(f);
                const int rk = __popcll(bm & ((1ull << lane) - 1ull));
                if (f) RK[tid * 64 + e] = (unsigned char)rk;
                if (lane == 0) CW[wid * 64 + e] = __popcll(bm); }
        }
        __syncthreads();
        if (tid < 128) {
            int* tke = (int*)(F.ws + WS_TKE) + (size_t)(t0 + tid) * 8; int* tkr = (int*)(F.ws + WS_TKR) + (size_t)(t0 + tid) * 8; float* tkw = (float*)(F.ws + WS_TKW) + (size_t)(t0 + tid) * 8;
#pragma unroll
            for (int it = 0; it < 8; ++it) { const int e = ek[it]; tke[it] = e; tkr[it] = (int)RK[tid * 64 + e] + (wid == 1 ? CW[e] : 0); tkw[it] = sk[it]; }
        }
        if (tid < 64) ((int*)(F.ws + WS_CNT))[chunk * 64 + tid] = CW[tid] + CW[64 + tid];
        __syncthreads();
    }
}

__device__ __forceinline__ void phase8(Frame& F) {
    const int* CNT = (const int*)(F.ws + WS_CNT); int* TOK = (int*)(F.ws + WS_TOK); float* WGT = (float*)(F.ws + WS_WGT); int* POS = (int*)(F.ws + WS_POS);
    LAS int* part = (LAS int*)F.lds;
    LAS int* tot = part + 1024;
    LAS int* below = tot + 64;
    LAS int* ebase = below + 64;
    const int tid = F.tid;
    for (int chunk = F.vcu; chunk < T / 128; chunk += F.G) {
        { const int e = tid & 63, pr = tid >> 6; int s = 0, sb = 0;
          for (int c = pr * 32; c < pr * 32 + 32; ++c) { const int v = CNT[c * 64 + e]; s += v; sb += c < chunk ? v : 0; }
          part[(pr * 2 + 0) * 64 + e] = s; part[(pr * 2 + 1) * 64 + e] = sb; }
        __syncthreads();
        if (tid < 64) { int s = 0, sb = 0;
#pragma unroll
            for (int pr = 0; pr < 8; ++pr) { s += part[(pr * 2 + 0) * 64 + tid]; sb += part[(pr * 2 + 1) * 64 + tid]; }
            tot[tid] = s; below[tid] = sb; }
        __syncthreads();
        if (tid == 0) { int a = 0; for (int e = 0; e < 64; ++e) { ebase[e] = a; a += (tot[e] + 255) & ~255; } ebase[64] = a; }
        __syncthreads();
        if (tid < 128) { const int tokn = chunk * 128 + tid;
            const int* tke = (const int*)(F.ws + WS_TKE) + (size_t)tokn * 8; const int* tkr = (const int*)(F.ws + WS_TKR) + (size_t)tokn * 8; const float* tkw = (const float*)(F.ws + WS_TKW) + (size_t)tokn * 8;
#pragma unroll
            for (int k = 0; k < 8; ++k) { const int e = tke[k]; const int pos = ebase[e] + below[e] + tkr[k]; TOK[pos] = tokn; WGT[pos] = tkw[k]; POS[tokn * 8 + k] = pos; } }
        const int RTOT = ebase[64];
        if (chunk < 64) { const int e = chunk; for (int p = ebase[e] + tot[e] + tid; p < ebase[e + 1]; p += NTHREADS) { TOK[p] = -1; WGT[p] = 0.f; } }
        { const int tokn = chunk * 128 + (tid & 127); if (tid < 128) { TOK[RTOT + tokn] = tokn; WGT[RTOT + tokn] = 1.f; } }
        if (chunk == 0) { int* TE = (int*)(F.ws + WS_TE); const int NTR = RTOT >> 8;
            for (int pm = tid; pm < NTR + 128; pm += NTHREADS) { int e = 64; if (pm < NTR) { e = 0; for (int x = 1; x < 64; ++x) e = (pm * 256 >= ebase[x]) ? x : e; } TE[pm] = e; }
            if (tid == 0) ((int*)(F.ws + WS_META))[0] = NTR; }
        __syncthreads();
    }
}

struct SchedMoe {
    int G, c, nunits, pm0, csh, colbase, bmul; const int* te; const int* tok;
    __device__ __forceinline__ bool next(int i, pg8::Unit& u) const {
        int pm, ct;
        if ((G & 7) == 0) { const int x = c & 7, w = c >> 3, W = G >> 3, nrows = nunits >> csh, nloc = (nrows + 7) >> 3;
            const long Lx = (long)i * W + w; const int pl = (int)(Lx >> csh), pr = x * nloc + pl; if (pl >= nloc || pr >= nrows) return false;
            pm = pm0 + pr; ct = colbase + (int)(Lx & ((1 << csh) - 1)); }
        else { const long L = (long)i * G + c; if (L >= nunits) return false; pm = pm0 + (int)(L >> csh); ct = colbase + (int)(L & ((1 << csh) - 1)); }
        u.pm = pm; u.pn = bmul * te[pm] + ct; return true; }
};
template <int MODE> struct EpiNull {
    static constexpr bool PERM = true;
    float* sink;
    __device__ __forceinline__ void operator()(const f32x4 (&acc)[2][2][4][2], const pg8::Unit& u, int wr, int wc, int fr, int fq) const {
        float s = 0.f;
        if (MODE == 1) {
#pragma unroll
            for (int ai = 0; ai < 2; ++ai)
#pragma unroll
                for (int bj = 0; bj < 2; ++bj)
#pragma unroll
                    for (int m = 0; m < 4; ++m)
#pragma unroll
                        for (int n = 0; n < 2; ++n) s += (acc[ai][bj][m][n][0] + acc[ai][bj][m][n][1]) + (acc[ai][bj][m][n][2] + acc[ai][bj][m][n][3]);
        } else s = acc[0][0][0][0][0] + acc[1][1][3][1][3];
        if (s == 12345.678f) sink[0] = s;
    }
};
struct EpiGU {
    static constexpr bool PERM = true;
    unsigned char* ACT; const float* WGT;
    __device__ __forceinline__ void operator()(const f32x4 (&acc)[2][2][4][2], const pg8::Unit& u, int wr, int wc, int fr, int fq) const {
        const int row0 = u.pm * 256 + wr * 64 + fr, ct = u.pn & 1;
#pragma unroll
        for (int ai = 0; ai < 2; ++ai)
#pragma unroll
            for (int m = 0; m < 4; ++m) { const int row = row0 + ai * 128 + m * 16; const float w = WGT[row] * ACT_SCALE; float r[8];
#pragma unroll
                for (int n = 0; n < 2; ++n)
#pragma unroll
                    for (int i = 0; i < 4; ++i) { const float g = acc[ai][0][m][n][i] * (1.f / WIN_SCALE); r[4 * n + i] = g * sigmoidf_(g) * (acc[ai][1][m][n][i] * (1.f / WIN_SCALE)) * w; }
                int d0 = 0, d1 = 0;
                d0 = __builtin_amdgcn_cvt_pk_fp8_f32(r[0], r[1], d0, false); d0 = __builtin_amdgcn_cvt_pk_fp8_f32(r[2], r[3], d0, true);
                d1 = __builtin_amdgcn_cvt_pk_fp8_f32(r[4], r[5], d1, false); d1 = __builtin_amdgcn_cvt_pk_fp8_f32(r[6], r[7], d1, true);
                *(u32x2*)(ACT + (size_t)row * 256 + ct * 128 + wc * 32 + fq * 8) = (u32x2){(unsigned)d0, (unsigned)d1}; }
    }
};
constexpr float Y_SCALE = 16.f;
struct EpiDown {
    static constexpr bool PERM = true;
    static constexpr float YD = Y_SCALE / (ACT_SCALE * WDN_SCALE);
    unsigned char* Y;
    __device__ __forceinline__ void operator()(const f32x4 (&acc)[2][2][4][2], const pg8::Unit& u, int wr, int wc, int fr, int fq) const {
        const int row0 = u.pm * 256 + wr * 64 + fr, col0 = (u.pn & 3) * 256 + (wc * 4 + fq) * 16;
#pragma unroll
        for (int ai = 0; ai < 2; ++ai)
#pragma unroll
            for (int m = 0; m < 4; ++m) { const int row = row0 + ai * 128 + m * 16; u32x4 w;
#pragma unroll
                for (int bj = 0; bj < 2; ++bj) { int d0 = 0, d1 = 0;
                    d0 = __builtin_amdgcn_cvt_pk_fp8_f32(acc[ai][bj][m][0][0] * YD, acc[ai][bj][m][0][1] * YD, d0, false); d0 = __builtin_amdgcn_cvt_pk_fp8_f32(acc[ai][bj][m][0][2] * YD, acc[ai][bj][m][0][3] * YD, d0, true);
                    d1 = __builtin_amdgcn_cvt_pk_fp8_f32(acc[ai][bj][m][1][0] * YD, acc[ai][bj][m][1][1] * YD, d1, false); d1 = __builtin_amdgcn_cvt_pk_fp8_f32(acc[ai][bj][m][1][2] * YD, acc[ai][bj][m][1][3] * YD, d1, true);
                    if (bj == 0) { w.x = (unsigned)d0; w.y = (unsigned)d1; } else { w.z = (unsigned)d0; w.w = (unsigned)d1; } }
                *(u32x4*)(Y + (size_t)row * 1024 + col0) = w; }
    }
};
struct EpiComb {
    static constexpr bool PERM = true;
    float* O; const unsigned char* Y; const int* POS; const float* mod; int rtiles;
    __device__ __forceinline__ void operator()(const f32x4 (&acc)[2][2][4][2], const pg8::Unit& u, int wr, int wc, int fr, int fq) const {
        const int row0 = (u.pm - rtiles) * 256 + wr * 64 + fr, ct = u.pn & 3, col0 = ct * 256 + wc * 32 + fq * 8;
#pragma unroll
        for (int ai = 0; ai < 2; ++ai)
#pragma unroll
            for (int m = 0; m < 4; ++m) { const int row = row0 + ai * 128 + m * 16, b = row >> 14;
                const i32x4 p0 = *(const i32x4*)(POS + (size_t)row * 8), p1 = *(const i32x4*)(POS + (size_t)row * 8 + 4);
                f32x2 t[8] = {{0.f, 0.f}, {0.f, 0.f}, {0.f, 0.f}, {0.f, 0.f}, {0.f, 0.f}, {0.f, 0.f}, {0.f, 0.f}, {0.f, 0.f}};
#pragma unroll
                for (int k = 0; k < 8; ++k) { const int pos = k < 4 ? p0[k & 3] : p1[k & 3]; const u32x4 y = *(const u32x4*)(Y + (size_t)pos * 1024 + ct * 256 + (wc * 4 + fq) * 16);
                    t[0] += __builtin_amdgcn_cvt_pk_f32_fp8((int)y.x, false); t[1] += __builtin_amdgcn_cvt_pk_f32_fp8((int)y.x, true);
                    t[2] += __builtin_amdgcn_cvt_pk_f32_fp8((int)y.y, false); t[3] += __builtin_amdgcn_cvt_pk_f32_fp8((int)y.y, true);
                    t[4] += __builtin_amdgcn_cvt_pk_f32_fp8((int)y.z, false); t[5] += __builtin_amdgcn_cvt_pk_f32_fp8((int)y.z, true);
                    t[6] += __builtin_amdgcn_cvt_pk_f32_fp8((int)y.w, false); t[7] += __builtin_amdgcn_cvt_pk_f32_fp8((int)y.w, true); }
#pragma unroll
                for (int bj = 0; bj < 2; ++bj) {
                    const int col = col0 + bj * 128; float* op = O + (size_t)row * D + col;
#pragma unroll
                    for (int n = 0; n < 2; ++n) { const f32x4 g = *(const f32x4*)(mod + b * 6144 + 5120 + col + 4 * n), xv = *(const f32x4*)(op + 4 * n);
                        const f32x4 sv = acc[ai][bj][m][n] * (1.f / (ACT_SCALE * WDN_SCALE)) + (f32x4){t[bj * 4 + 2 * n].x, t[bj * 4 + 2 * n].y, t[bj * 4 + 2 * n + 1].x, t[bj * 4 + 2 * n + 1].y} * (1.f / Y_SCALE);
                        *(f32x4*)(op + 4 * n) = xv + g * sv; } } }
    }
};

constexpr int NPHASE = 12;
__global__ void __launch_bounds__(NTHREADS, 2) fwd_kernel(Args args) {
    extern __shared__ __attribute__((aligned(16))) unsigned char lds[];
    Frame F;
    F.lds = (LAS unsigned char*)lds;
    F.tid = threadIdx.x; F.lane = F.tid & 63; F.wave = __builtin_amdgcn_readfirstlane(F.tid >> 6);
    F.G = gridDim.x; { const int bx = blockIdx.x; F.vcu = (F.G % 8 == 0) ? (bx % 8) * (F.G / 8) + bx / 8 : bx; }
    F.ws = args.ws; F.out = args.out;
    F.ka = (const __attribute__((address_space(4))) unsigned char*)__builtin_amdgcn_kernarg_segment_ptr();
    volatile LAS unsigned* MISC = (volatile LAS unsigned*)(F.lds + MISC_OFF);
    if (F.tid < 64) MISC[F.tid] = 0u;
    __syncthreads();
    const int lo = args.ph_lo, hi = args.ph_hi;
    unsigned* barw = (unsigned*)(F.ws + WS_CTL) + CW_BAR;
    XcdBarrier bar; bar.bar = barw; bar.x = 0; bar.st = nullptr;
    if (hi - lo > 1) bar = xcd_barrier_post(barw, MISC + 8);
#ifndef ONLY_PHASE
#define ONLY_PHASE -1
#endif
#define HASP(k) (ONLY_PHASE < 0 || ONLY_PHASE == (k) || (ONLY_PHASE == 100 && (k) == 10) || (ONLY_PHASE == 101 && (k) == 11))
#define IN(k) (HASP(k) && lo <= (k) && (k) < hi)
#ifndef DBG_REP
#define DBG_REP -1
#endif
#ifndef DBG_REPN
#define DBG_REPN 2
#endif
#define REPS(k) for (int rep_ = 0; rep_ < ((DBG_REP == (k)) ? DBG_REPN : 1); (void)({ asm volatile("" ::: "memory"); 0; }), ++rep_)
#define SEAM(k) do { if (IN(k) && IN((k) + 1)) xcd_barrier(bar); } while (0)
    bf16* const H = (bf16*)F.out;

    if (IN(0)) { REPS(0) phase0(F); } SEAM(0);
    if (IN(1)) { REPS(1) phase1(F); } SEAM(1);
    if (IN(2)) REPS(2) {
        pg8::Gemm g{H, (const bf16*)(F.ws + WS_WIN), T, NIN, D / 2}; pg8::StaticOrder S; S.init(T, NIN, F.G, (int)blockIdx.x);
        EpiIn E{(bf16*)(F.ws + WS_U), (bf16*)(F.ws + WS_Q), (bf16*)(F.ws + WS_K), (bf16*)(F.ws + WS_V), (bf16*)(F.ws + WS_GC), (bf16*)(F.ws + WS_GA), (const float*)(F.ws + WS_ROPE), F.in(I_QNG), F.in(I_KNG), F.lds + EPI_SCR};
        pg8::gemm_phase<EpiIn, pg8::StaticOrder, true, true, false, true>(F.lds, g, S, E);
    } SEAM(2);
    if (IN(3)) { REPS(3) phase3(F); } SEAM(3);
    if (IN(4)) REPS(4) {
        pg8::Gemm g{H, (const bf16*)(F.ws + WS_WPW2), T, D, D / 2}; pg8::StaticOrder S; S.init(T, D, F.G, (int)blockIdx.x);
        EpiPw2 E{(bf16*)(F.ws + WS_U), (const bf16*)(F.ws + WS_GC), F.in(I_BPW2)};
        pg8::gemm_phase<EpiPw2, pg8::StaticOrder, true, true, false, true>(F.lds, g, S, E);
    } SEAM(4);
#ifndef DBG_ATTVAR
#define DBG_ATTVAR 0
#endif
    if (IN(5)) { att::phase5(F, (bf16*)(F.ws + WS_U)); } SEAM(5);
    if (IN(6)) REPS(6) {
        pg8::Gemm g{(const bf16*)(F.ws + WS_U), (const bf16*)(F.ws + WS_WOUT), T, D, D}; pg8::StaticOrder S; S.init(T, D, F.G, (int)blockIdx.x);
        EpiOut E{F.in(I_X), F.out, (const float*)(F.ws + WS_MOD)};
        pg8::gemm_phase<EpiOut, pg8::StaticOrder, true, true, false>(F.lds, g, S, E);
    } SEAM(6);
    if (IN(7)) { REPS(7) phase7(F); } SEAM(7);
    if (IN(8)) { REPS(8) phase8(F); } SEAM(8);
    const int* TE = (const int*)(F.ws + WS_TE); const int* TOK = (const int*)(F.ws + WS_TOK);
    if (IN(9)) REPS(9) {
        const int NTR = ((const int*)(F.ws + WS_META))[0];
        pg8::Gemm g{(const bf16*)(F.ws + WS_U), (const bf16*)(F.ws + WS_WGU), 0, 0, D / 2};
        SchedMoe S{F.G, (int)blockIdx.x, 2 * (NTR + 128), 0, 1, 0, 2, TE, TOK};
        EpiGU E{(unsigned char*)(F.ws + WS_ACT), (const float*)(F.ws + WS_WGT)};
        pg8::gemm_phase<EpiGU, SchedMoe, true, true, true, true>(F.lds, g, S, E);
    } SEAM(9);
    if (IN(10)) REPS(10) { const int NTR = ((const int*)(F.ws + WS_META))[0];
        pg8::Gemm g{(const bf16*)(F.ws + WS_ACT), (const bf16*)(F.ws + WS_WDN), 0, 0, ED / 2};
        SchedMoe S{F.G, (int)blockIdx.x, 4 * NTR, 0, 2, 0, 4, TE, TOK};
        EpiDown E{(unsigned char*)(F.ws + WS_Y)};
#ifndef DBG_P10VAR
#define DBG_P10VAR 0
#endif
        if (DBG_P10VAR == 1) { EpiNull<0> E0{(float*)(F.ws + WS_META) + 8}; pg8::gemm_phase<EpiNull<0>, SchedMoe, true, true, false>(F.lds, g, S, E0); }
        if (DBG_P10VAR == 2) { EpiNull<1> E0{(float*)(F.ws + WS_META) + 8}; pg8::gemm_phase<EpiNull<1>, SchedMoe, true, true, false>(F.lds, g, S, E0); }
        pg8::gemm_phase<EpiDown, SchedMoe, true, true, false, true>(F.lds, g, S, E);
    } SEAM(10);
    if (IN(11)) { const int NTR = ((const int*)(F.ws + WS_META))[0];
        pg8::Gemm g{(const bf16*)(F.ws + WS_ACT), (const bf16*)(F.ws + WS_WDN), 0, 0, ED / 2};
        SchedMoe S{F.G, (int)blockIdx.x, 512, NTR, 2, 0, 4, TE, TOK};
        EpiComb E{F.out, (const unsigned char*)(F.ws + WS_Y), (const int*)(F.ws + WS_POS), (const float*)(F.ws + WS_MOD), NTR};
        pg8::gemm_phase<EpiComb, SchedMoe, true, true, false, true>(F.lds, g, S, E);
    }
#undef IN
#undef SEAM

}

#ifndef DBG_A6
#define DBG_A6 WS_U
#endif
#ifndef DBG_SKIP
#define DBG_SKIP 0
#endif
#ifndef DBG_NPH
#define DBG_NPH NPHASE
#endif
#ifndef N_LAUNCH_MODE
#define N_LAUNCH_MODE 1
#endif
extern "C" void kernel_launch(void* const* d_in, const int* in_sizes, int n_in, void* d_out, int out_size, void* d_ws, size_t ws_size, hipStream_t stream) {
    static int grid = 0;
    if (grid == 0) {
        if (n_in != 28 || out_size != T * D || ws_size < WS_END) { fprintf(stderr, "kernel_launch: unexpected problem (n_in %d out %d ws %zu)\n", n_in, out_size, ws_size); grid = -1; return; }
        int dev = 0, cus = 0, per_cu = 0;
        if (hipGetDevice(&dev) != hipSuccess || hipDeviceGetAttribute(&cus, hipDeviceAttributeMultiprocessorCount, dev) != hipSuccess) { grid = -1; return; }
        if (hipFuncSetAttribute((const void*)fwd_kernel, hipFuncAttributeMaxDynamicSharedMemorySize, LDS_BYTES) != hipSuccess) { grid = -1; return; }
        if (hipOccupancyMaxActiveBlocksPerMultiprocessor(&per_cu, (const void*)fwd_kernel, NTHREADS, LDS_BYTES) != hipSuccess || per_cu < 1) { fprintf(stderr, "kernel_launch: occupancy query says %d\n", per_cu); }
        (void)hipGetLastError();
        grid = cus;
    }
    if (grid < 0) return;
    (void)hipMemsetAsync((char*)d_ws + WS_CTL, 0, CTL_ZERO_BYTES, stream);
    Args a{};
    for (int i = 0; i < 28; ++i) a.in[i] = d_in[i];
    a.out = (float*)d_out; a.ws = (unsigned char*)d_ws;
    if (N_LAUNCH_MODE == 1) { a.ph_lo = 0; a.ph_hi = NPHASE; hipLaunchKernelGGL(fwd_kernel, dim3(grid), dim3(NTHREADS), LDS_BYTES, stream, a); }
    else { for (int p = 0; p < DBG_NPH; ++p) { if ((DBG_SKIP >> p) & 1) continue; a.ph_lo = p; a.ph_hi = p + 1; hipLaunchKernelGGL(fwd_kernel, dim3(grid), dim3(NTHREADS), LDS_BYTES, stream, a); } }
}
```

```cpp
#include <hip/hip_runtime.h>
#include <cstdio>
#include <cstdint>

#define GAS __attribute__((address_space(1)))
#define LAS __attribute__((address_space(3)))
typedef unsigned short bf16;
typedef short bf16x8 __attribute__((ext_vector_type(8)));
typedef short s16x4 __attribute__((ext_vector_type(4)));
typedef float f32x4 __attribute__((ext_vector_type(4)));
typedef float f32x2 __attribute__((ext_vector_type(2)));
typedef float f32x16 __attribute__((ext_vector_type(16)));
typedef unsigned u32x4 __attribute__((ext_vector_type(4)));
typedef unsigned u32x2 __attribute__((ext_vector_type(2)));
typedef int i32x4 __attribute__((ext_vector_type(4)));

constexpr int NB = 2, SEQ = 16384, T = NB * SEQ, D = 1024, NIN = 7168;
constexpr int NE = 64, TOPK = 8, ED = 256, NEX = NE + 1;
constexpr float EPS = 1e-6f;
constexpr float C2 = 0.125f * 1.4426950408889634f;
constexpr float QSC = 4.f, PBIAS = 60.f;
constexpr float LAMBDA_INIT = 0.2f;
constexpr int NWAVES = 8, NTHREADS = 512;

constexpr size_t MiB = 1u << 20;
constexpr size_t WS_CTL = 0, CTL_ZERO_BYTES = 64 * 1024;
constexpr size_t WS_MOD = 1 * MiB;
constexpr size_t WS_ROPE = 1 * MiB + 64 * 1024;
constexpr size_t WS_TKE = 3 * MiB + 256 * 1024;
constexpr size_t WS_TKR = 4 * MiB + 256 * 1024;
constexpr size_t WS_TKW = 5 * MiB + 256 * 1024;
constexpr size_t WS_POS = 6 * MiB + 256 * 1024;
constexpr size_t WS_CNT = 7 * MiB + 256 * 1024;
constexpr size_t WS_TE = WS_CNT + 64 * 1024;
constexpr size_t WS_META = WS_TE + 8 * 1024;
constexpr size_t WS_TOK = 7 * MiB + 512 * 1024;
constexpr size_t WS_WGT = 8 * MiB + 768 * 1024;
constexpr int RMAX = 262144 + 64 * 256 + T;
static_assert(WS_TOK + (size_t)RMAX * 4 <= WS_WGT && WS_WGT + (size_t)RMAX * 4 <= 10 * MiB, "small region");
constexpr size_t WS_WRH = 10 * MiB, WS_WRL = 10 * MiB + 128 * 1024;
constexpr size_t WS_WDN = 11 * MiB;
constexpr size_t WS_WIN = WS_WDN + (size_t)NEX * 1024 * 256 * 2 + MiB / 2;
constexpr size_t WS_WPW2 = WS_WIN + 14 * MiB, WS_WOUT = WS_WPW2 + 2 * MiB;
constexpr size_t WS_WGU = WS_WOUT + 2 * MiB;
constexpr size_t WS_U = 127 * MiB;
constexpr size_t WS_Q = WS_U + 64 * MiB, WS_K = WS_Q + 64 * MiB, WS_V = WS_K + 64 * MiB, WS_GC = WS_V + 64 * MiB, WS_GA = WS_GC + 64 * MiB;
constexpr size_t WS_END = WS_GA + 64 * MiB;
static_assert(WS_WGU + (size_t)NEX * 512 * 1024 * 2 <= WS_U && WS_END <= 512 * MiB, "ws map");
constexpr size_t WS_ACT = 359 * MiB;
constexpr size_t WS_Y = 44 * MiB;
static_assert(WS_ACT + (size_t)RMAX * 512 <= WS_END && WS_Y + (size_t)(262144 + 64 * 256) * 1024 <= WS_ACT && WS_Y >= WS_WDN + (size_t)NEX * 1024 * 256 * 2, "moe overlays");
constexpr int CW_BAR = 1024;

#ifndef DBG_A6
#define DBG_A6 WS_U
#endif
constexpr int RING_BYTES = 131072;
constexpr int LDS_BYTES = 163840;
constexpr int EPI_SCR = RING_BYTES;
constexpr int MISC_OFF = LDS_BYTES - 256;

#define LDS_WAIT() asm volatile("s_waitcnt lgkmcnt(0)" ::: "memory")
#define VM_WAIT() asm volatile("s_waitcnt vmcnt(0)" ::: "memory")
typedef __bf16 bf16x2_t __attribute__((ext_vector_type(2)));
__device__ __forceinline__ unsigned cvt_pk_bf16(float lo, float hi) { const f32x2 v = {lo, hi}; const bf16x2_t b = __builtin_convertvector(v, bf16x2_t); return __builtin_bit_cast(unsigned, b); }
__device__ __forceinline__ float bf_lo(unsigned u) { return __builtin_bit_cast(float, u << 16); }
__device__ __forceinline__ float bf_hi(unsigned u) { return __builtin_bit_cast(float, u & 0xffff0000u); }
__device__ __forceinline__ float sigmoidf_(float x) { return __builtin_amdgcn_rcpf(1.f + __expf(-x)); }
__device__ __forceinline__ float wave_sum(float v) {
#pragma unroll
    for (int o = 1; o < 64; o <<= 1) v += __shfl_xor(v, o);
    return v;
}
__device__ __forceinline__ float wave_max(float v) {
#pragma unroll
    for (int o = 1; o < 64; o <<= 1) v = fmaxf(v, __shfl_xor(v, o));
    return v;
}

namespace pg8 {
typedef int i32x8_t __attribute__((ext_vector_type(8)));
typedef int i32x4_t __attribute__((ext_vector_type(4)));
constexpr int BM = 256, BK = 64, HALF = 128, HTB = HALF * BK * 2, STAGE_BYTES = 8 * HTB, NXCD = 8, WGM = 8;
__host__ __device__ __forceinline__ int lds_byte(int r, int c) { const int st = (r >> 4) * 2 + (c >> 5), rr = r & 15, cc = c & 31, ob = rr * 64 + cc * 2; return st * 1024 + (ob ^ (((ob >> 9) & 1) << 5)); }
__host__ __device__ __forceinline__ void stage_rc(int b, int& R, int& C) { const int st = b / 1024, sb = b % 1024, swz = sb ^ (((sb >> 9) & 1) << 5); R = (st >> 1) * 16 + swz / 64; C = (st & 1) * 32 + (swz % 64) / 2; }
__host__ __device__ __forceinline__ int perm32(int rho) { const int n = rho >> 4, i = rho & 15; return 8 * (i >> 2) + 4 * n + (i & 3); }

struct Unit { int pm, pn; };
struct Gemm { const bf16* A; const bf16* Bt; int M, N, K; };

struct StaticOrder {
    int nM, nN, nwg, G, c;
    const int* tok;
    __host__ __device__ void init(int M, int N, int G_, int c_) { nM = M / BM; nN = N / BM; nwg = nM * nN; G = G_; c = c_; tok = nullptr; }
    __host__ __device__ bool next(int i, Unit& u) const {
        const long L = (long)i * G + c; if (L >= nwg) return false;
        int wgid = (int)L; { const int q = nwg / NXCD, r = nwg % NXCD, xcd = wgid % NXCD, off = wgid / NXCD; wgid = (xcd < r ? xcd * (q + 1) : r * (q + 1) + (xcd - r) * q) + off; }
        const int nig = WGM * nN, gid = wgid / nig, fm = gid * WGM, gsz = (nM - fm) < WGM ? (nM - fm) : WGM;
        u.pm = fm + ((wgid % nig) % gsz); u.pn = (wgid % nig) / gsz; return true;
    }
};

template <class Epi, class Sched, bool ALIGN_EPI, bool SP2, bool GATHER, bool FP8 = false>
__device__ __forceinline__ void gemm_phase(LAS unsigned char* lds, const Gemm g, const Sched& S, const Epi& E) {
    const int tid = threadIdx.x, wid = __builtin_amdgcn_readfirstlane(tid >> 6), lane = tid & 63, wr = wid >> 2, wc = wid & 3, fr = lane & 15, fq = lane >> 4;
    const int K = g.K, nt = K / BK;
    unsigned voffA[2], voffB[2]; int RA[2]; unsigned CA2[2];
#pragma unroll
    for (int i = 0; i < 2; ++i) { int R, C; stage_rc(tid * 16 + i * 8192, R, C); const int Rb = Epi::PERM ? ((R & ~31) + perm32(R & 31)) : R;
        voffA[i] = (unsigned)(R * K + C) * 2u; voffB[i] = (unsigned)(Rb * K + C) * 2u; RA[i] = R; CA2[i] = (unsigned)C * 2u; }
    const size_t kstep = (size_t)(BK * 2);
    const size_t hstep = (size_t)HALF * K * 2;
    const size_t tstep = 2 * hstep;
    const unsigned ldsw = (unsigned)wid * 1024u;
    const int aoff = lds_byte(wr * 64 + fr, fq * 8), boff = lds_byte(wc * 32 + fr, fq * 8);
#define PG8_SA(b, h) (((b) * 2 + (h)) * HTB)
#define PG8_SB(b, h) ((4 + (b) * 2 + (h)) * HTB)
#define PG8_STAGE2(bufoff, gbase, o0, o1) do { \
        __builtin_amdgcn_global_load_lds((const unsigned*)((const char*)(gbase) + (o0)), (LAS unsigned*)(lds + (bufoff) + ldsw), 16, 0, 0); \
        __builtin_amdgcn_global_load_lds((const unsigned*)((const char*)(gbase) + (o1)), (LAS unsigned*)(lds + (bufoff) + ldsw + 8192), 16, 0, 0); } while (0)
#define PG8_STAGEB(bufoff, gbase) PG8_STAGE2(bufoff, gbase, voffB[0], voffB[1])
#define PG8_STAGEA(bufoff, gbase, h, o0, o1) do { if constexpr (GATHER) { PG8_STAGE2(bufoff, gbase, o0, o1); } else { PG8_STAGE2(bufoff, (gbase) + (h) * hstep, voffA[0], voffA[1]); } } while (0)
#define PG8_LD8(p) __builtin_shufflevector(*(const LAS i32x4_t*)(p), *(const LAS i32x4_t*)((p) + 1024), 0, 1, 2, 3, 4, 5, 6, 7)
#define PG8_LDA(dst, b, h) do { if constexpr (FP8) { _Pragma("unroll") for (int m = 0; m < 4; ++m) dst##8[m] = PG8_LD8(lds + PG8_SA(b, h) + aoff + m * 2048); } \
        else { _Pragma("unroll") for (int m = 0; m < 4; ++m) _Pragma("unroll") for (int k = 0; k < 2; ++k) dst[m][k] = *(const LAS bf16x8*)(lds + PG8_SA(b, h) + aoff + m * 2048 + k * 1024); } } while (0)
#define PG8_LDB(dst, b, h) do { if constexpr (FP8) { _Pragma("unroll") for (int n = 0; n < 2; ++n) dst##8[n] = PG8_LD8(lds + PG8_SB(b, h) + boff + n * 2048); } \
        else { _Pragma("unroll") for (int n = 0; n < 2; ++n) _Pragma("unroll") for (int k = 0; k < 2; ++k) dst[n][k] = *(const LAS bf16x8*)(lds + PG8_SB(b, h) + boff + n * 2048 + k * 1024); } } while (0)
#define PG8_CAT(x) __builtin_shufflevector(__builtin_bit_cast(i32x4_t, (x)[0]), __builtin_bit_cast(i32x4_t, (x)[1]), 0, 1, 2, 3, 4, 5, 6, 7)
#define PG8_MMA(ai, bj, At, Bt) do { __builtin_amdgcn_s_setprio(1); \
        if constexpr (FP8) { _Pragma("unroll") for (int m = 0; m < 4; ++m) _Pragma("unroll") for (int n = 0; n < 2; ++n) \
            asm volatile("v_mfma_f32_16x16x128_f8f6f4 %0, %1, %2, %0" : "+v"(acc[ai][bj][m][n]) : "v"(Bt##8[n]), "v"(At##8[m])); }   \
        else { _Pragma("unroll") for (int m = 0; m < 4; ++m) _Pragma("unroll") for (int n = 0; n < 2; ++n) _Pragma("unroll") for (int k = 0; k < 2; ++k) \
            acc[ai][bj][m][n] = __builtin_amdgcn_mfma_f32_16x16x32_bf16(Bt[n][k], At[m][k], acc[ai][bj][m][n], 0, 0, 0); } \
        __builtin_amdgcn_s_setprio(0); } while (0)
#define PG8_WAIT_V(n) asm volatile("s_waitcnt vmcnt(" #n ")" ::: "memory")
#define PG8_WAIT_L(n) asm volatile("s_waitcnt lgkmcnt(" #n ")" ::: "memory")
#define PG8_BAR __builtin_amdgcn_s_barrier()
#define PG8_SCHED __builtin_amdgcn_sched_barrier(0)
#define PG8_SETA(o, u) do { _Pragma("unroll") for (int h_ = 0; h_ < 2; ++h_) _Pragma("unroll") for (int i_ = 0; i_ < 2; ++i_) { \
        if constexpr (GATHER) { int t_ = S.tok[(u).pm * 256 + h_ * 128 + RA[i_]]; t_ = t_ < 0 ? 0 : t_; o[h_][i_] = (unsigned)t_ * (unsigned)(K * 2) + CA2[i_]; } \
        else { o[h_][i_] = (unsigned)(h_ * hstep) + voffA[i_]; } } } while (0)
    Unit cur, nxt; int ui = 0;
    if (!S.next(0, cur)) return;
    f32x4 acc[2][2][4][2];
#pragma unroll
    for (int a = 0; a < 2; ++a)
#pragma unroll
        for (int b = 0; b < 2; ++b)
#pragma unroll
            for (int m = 0; m < 4; ++m)
#pragma unroll
                for (int n = 0; n < 2; ++n) acc[a][b][m][n] = (f32x4){0.f, 0.f, 0.f, 0.f};
    bf16x8 At[4][2], B0[2][2], B1[2][2];
    i32x8_t At8[4], B08[2], B18[2];
    unsigned cO[2][2], nO[2][2];
    if constexpr (GATHER) { PG8_SETA(cO, cur); VM_WAIT(); }
    else { cO[0][0] = cO[0][1] = cO[1][0] = cO[1][1] = 0u; }
    const char* cA = GATHER ? (const char*)g.A : (const char*)g.A + (size_t)cur.pm * tstep; const char* cB = (const char*)g.Bt + (size_t)cur.pn * tstep;
    if constexpr (SP2) {
        PG8_STAGEB(PG8_SB(0, 0), cB); PG8_STAGEB(PG8_SB(0, 1), cB + hstep); PG8_STAGEA(PG8_SA(0, 0), cA, 0, cO[0][0], cO[0][1]); PG8_STAGEA(PG8_SA(0, 1), cA, 1, cO[1][0], cO[1][1]);
        if (wr == 1) PG8_BAR;
        PG8_WAIT_V(2); PG8_BAR;
        PG8_STAGEB(PG8_SB(1, 0), cB + kstep); PG8_STAGEA(PG8_SA(1, 0), cA + kstep, 0, cO[0][0], cO[0][1]); PG8_STAGEB(PG8_SB(1, 1), cB + hstep + kstep);
        PG8_WAIT_V(6); PG8_BAR;
    }
    for (;;) {
        const bool has_next = S.next(ui + 1, nxt);
        if constexpr (!GATHER) { nO[0][0] = nO[0][1] = nO[1][0] = nO[1][1] = 0u; }
        else if (has_next) { PG8_SETA(nO, nxt); } else {
#pragma unroll
            for (int h_ = 0; h_ < 2; ++h_)
#pragma unroll
                for (int i_ = 0; i_ < 2; ++i_) nO[h_][i_] = cO[h_][i_]; }
        const char* nA = GATHER ? (const char*)g.A : (has_next ? (const char*)g.A + (size_t)nxt.pm * tstep : cA);
        const char* nB = has_next ? (const char*)g.Bt + (size_t)nxt.pn * tstep : cB;
#pragma nounroll
        for (int t = 0; t < nt; t += 2) {
            const bool last = (t == nt - 2);
            const char* a1 = cA + (size_t)(t + 1) * kstep;
            const char* a2 = last ? nA : cA + (size_t)(t + 2) * kstep; const char* b2 = last ? nB : cB + (size_t)(t + 2) * kstep;
            const char* a3 = a2 + kstep; const char* b3 = b2 + kstep;
            const unsigned x00 = last ? nO[0][0] : cO[0][0], x01 = last ? nO[0][1] : cO[0][1], x10 = last ? nO[1][0] : cO[1][0], x11 = last ? nO[1][1] : cO[1][1];
            PG8_LDB(B0, 0, 0); PG8_LDB(B1, 0, 1); PG8_SCHED; PG8_LDA(At, 0, 0); PG8_STAGEA(PG8_SA(1, 1), a1, 1, cO[1][0], cO[1][1]);
            PG8_WAIT_V(8); PG8_WAIT_L(0); PG8_BAR; PG8_MMA(0, 0, At, B0); PG8_MMA(0, 1, At, B1); PG8_BAR; PG8_SCHED;
            PG8_LDA(At, 0, 1); PG8_STAGEB(PG8_SB(0, 0), b2); PG8_STAGEB(PG8_SB(0, 1), b2 + hstep); PG8_STAGEA(PG8_SA(0, 0), a2, 0, x00, x01);
            PG8_WAIT_V(8); PG8_WAIT_L(0); PG8_BAR; PG8_MMA(1, 0, At, B0); PG8_MMA(1, 1, At, B1); PG8_BAR; PG8_SCHED;
            PG8_LDB(B0, 1, 0); PG8_LDB(B1, 1, 1); PG8_SCHED; PG8_LDA(At, 1, 0); PG8_STAGEA(PG8_SA(0, 1), a2, 1, x10, x11);
            PG8_WAIT_V(8); PG8_WAIT_L(0); PG8_BAR; PG8_MMA(0, 0, At, B0); PG8_MMA(0, 1, At, B1); PG8_BAR; PG8_SCHED;
            PG8_LDA(At, 1, 1); PG8_STAGEB(PG8_SB(1, 0), b3); PG8_STAGEB(PG8_SB(1, 1), b3 + hstep); PG8_STAGEA(PG8_SA(1, 0), a3, 0, x00, x01);
            PG8_WAIT_V(8); PG8_WAIT_L(0); PG8_BAR; PG8_MMA(1, 0, At, B0); PG8_MMA(1, 1, At, B1); PG8_BAR; PG8_SCHED;
        }
        if constexpr (ALIGN_EPI) { if (wr == 0) PG8_BAR; }
        if constexpr (FP8) asm volatile("s_nop 15\n\ts_nop 15" ::: "memory");
        E(acc, cur, wr, wc, fr, fq);
        if (!has_next) break;
#pragma unroll
        for (int a = 0; a < 2; ++a)
#pragma unroll
            for (int b = 0; b < 2; ++b)
#pragma unroll
                for (int m = 0; m < 4; ++m)
#pragma unroll
                    for (int n = 0; n < 2; ++n) acc[a][b][m][n] = (f32x4){0.f, 0.f, 0.f, 0.f};
        cur = nxt; cA = nA; cB = nB; ++ui;
#pragma unroll
        for (int h_ = 0; h_ < 2; ++h_)
#pragma unroll
            for (int i_ = 0; i_ < 2; ++i_) cO[h_][i_] = nO[h_][i_];
        if constexpr (ALIGN_EPI) { if (wr == 1) PG8_BAR; }
    }
    PG8_WAIT_V(0);
    if constexpr (!ALIGN_EPI) { if (wr == 0) PG8_BAR; }
    PG8_BAR;
#undef PG8_SA
#undef PG8_SB
#undef PG8_STAGE2
#undef PG8_STAGEB
#undef PG8_STAGEA
#undef PG8_LDA
#undef PG8_LD8
#undef PG8_LDB
#undef PG8_MMA
#undef PG8_CAT
#undef PG8_WAIT_V
#undef PG8_WAIT_L
#undef PG8_BAR
#undef PG8_SCHED
#undef PG8_SETA
}
}

#define XB_TMO      128
#define XB_XCNT(j)  (256  + 64 * (j))
#define XB_XSUB(j)  (1280 + 64 * (j))
#define XB_XGEN(j)  (2304 + 64 * (j))
#define XB_TOP      3328
#define XB_TOPGEN   3392
#define XCD_BAR_WORDS 3456
#define XB_SPIN_CAP (1u << 18)
__device__ __forceinline__ unsigned xb_ld(unsigned* p)              { return __hip_atomic_load(p, __ATOMIC_RELAXED, __HIP_MEMORY_SCOPE_AGENT); }
__device__ __forceinline__ unsigned xb_add(unsigned* p, unsigned v) { return __hip_atomic_fetch_add(p, v, __ATOMIC_RELAXED, __HIP_MEMORY_SCOPE_AGENT); }
__device__ __forceinline__ unsigned xb_xcc_id() { return (unsigned)__builtin_amdgcn_s_getreg((3 << 11) | 20) & 0xFu; }
#define XB_SPIN(cond, bar) do { unsigned _sp = 0; while (cond) { __builtin_amdgcn_s_sleep(1); \
    if ((++_sp & 255u) == 0u) { if (xb_ld(&(bar)[XB_TMO])) break; if (_sp > XB_SPIN_CAP) { atomicAdd(&(bar)[XB_TMO], 1u); break; } } } } while (0)
struct XcdBarrier { unsigned* bar; unsigned x; volatile LAS unsigned* st; };
__device__ __forceinline__ XcdBarrier xcd_barrier_post(unsigned* bar, volatile LAS unsigned* st) {
    XcdBarrier b; b.bar = bar; b.x = xb_xcc_id(); b.st = st;
    if (threadIdx.x == 0) (void)xb_add(&bar[XB_XCNT(b.x)], 1u);
    return b;
}
__device__ __forceinline__ void xcd_barrier_complete(unsigned* bar, unsigned x, unsigned& nloc, unsigned& nx) {
    const unsigned G = gridDim.x * gridDim.y * gridDim.z;
    unsigned sum, cnt, mine, sp = 0u;
    for (;;) {
        sum = 0u; cnt = 0u; mine = 0u;
#pragma unroll
        for (unsigned j = 0; j < 16; ++j) { const unsigned c = xb_ld(&bar[XB_XCNT(j)]); sum += c; cnt += (c > 0u) ? 1u : 0u; mine = (j == x) ? c : mine; }
        if (sum == G) break;
        __builtin_amdgcn_s_sleep(1);
        if ((++sp & 255u) == 0u) { if (xb_ld(&bar[XB_TMO])) break; if (sp > XB_SPIN_CAP) { atomicAdd(&bar[XB_TMO], 1u); break; } }
    }
    nloc = mine > 0u ? mine : 1u; nx = cnt > 0u ? cnt : 1u;
}
__device__ __forceinline__ void xcd_barrier(const XcdBarrier& b) {
    asm volatile("s_waitcnt vmcnt(0)" ::: "memory");
    __syncthreads();
    if (threadIdx.x == 0) {
        unsigned* bar = b.bar;
        __builtin_amdgcn_s_waitcnt(0);
        unsigned nloc = b.st[0], nx = b.st[1];
        if (nloc == 0u) { xcd_barrier_complete(bar, b.x, nloc, nx); b.st[0] = nloc; b.st[1] = nx; }
        const unsigned old = xb_add(&bar[XB_XSUB(b.x)], 1u);
        const unsigned gen = old / nloc;
        if (old + 1u == (gen + 1u) * nloc) {
            __builtin_amdgcn_fence(__ATOMIC_RELEASE, "agent");
            asm volatile("s_waitcnt vmcnt(0)" ::: "memory");
            const unsigned og = xb_add(&bar[XB_TOP], 1u);
            const unsigned tg = og / nx;
            if (og + 1u == (tg + 1u) * nx) xb_add(&bar[XB_TOPGEN], 1u);
            else XB_SPIN(xb_ld(&bar[XB_TOPGEN]) == tg, bar);
            __builtin_amdgcn_fence(__ATOMIC_ACQUIRE, "agent");
            xb_add(&bar[XB_XGEN(b.x)], 1u);
            asm volatile("s_waitcnt vmcnt(0)" ::: "memory");
        } else {
            XB_SPIN(xb_ld(&bar[XB_XGEN(b.x)]) == gen, bar);
            __builtin_amdgcn_fence(__ATOMIC_ACQUIRE, "agent");
            asm volatile("s_waitcnt vmcnt(0)" ::: "memory");
        }
    }
    __syncthreads();
}

struct Args { const void* in[28]; float* out; unsigned char* ws; int ph_lo, ph_hi; };
struct Frame {
    LAS unsigned char* lds;
    int tid, lane, wave, vcu, G;
    unsigned char* ws; float* out;
    const __attribute__((address_space(4))) unsigned char* ka;
    __device__ __forceinline__ const float* in(int i) const { return ((const float* const __attribute__((address_space(4)))*)ka)[i]; }
};
enum { I_X = 0, I_C, I_POS, I_WADA, I_BADA, I_N1G, I_WIN, I_CDW, I_CDWB, I_CLNG, I_CLNB, I_WPW2, I_BPW2, I_QNG, I_KNG, I_LQ1, I_LK1, I_LQ2, I_LK2, I_SUBG, I_WOUT, I_N2G, I_WR, I_RB, I_WEGU, I_WEDN, I_WSGU, I_WSDN };

__device__ __forceinline__ int win_map(int n) {
    if (n < 1024) return 256 * (n >> 7) + (n & 127);
    if (n < 2048) { const int j = n - 1024; return 256 * (j >> 7) + 128 + (j & 127); }
    if (n < 4096) { const int qk = (n - 2048) >> 10, j = (n - 2048) & 1023, g = j >> 6, dl = j & 63; const int tile = 8 + 4 * qk + (g >> 2), wc = g & 3;
        int bj, fq, e; if (dl < 8) { bj = 0; fq = 0; e = dl; } else if (dl < 16) { bj = 1; fq = 0; e = dl - 8; } else { const int rho = dl - 16; bj = rho / 24; fq = 1 + (rho % 24) / 8; e = rho & 7; }
        return 256 * tile + 128 * bj + 32 * wc + 8 * fq + e; }
    return n;
}
__device__ __forceinline__ int glu_map(int n) { const int j = n & 255; return 256 * (j >> 7) + ((n >> 8) << 7) + (j & 127); }
__device__ __forceinline__ int qk_dim(int bj, int fq, int e) { return fq == 0 ? bj * 8 + e : 16 + bj * 24 + (fq - 1) * 8 + e; }

template <int MAP>
__device__ __forceinline__ void transpose_item(const float* W, int K, int N, bf16* WT, LAS float* scr, int item, int lane) {
    const int nblk = N / 32, kb = item / nblk, nb = item % nblk, k0 = 64 * kb, n0 = 32 * nb;
    {
        const int rr = lane >> 3, c4 = (lane & 7) * 4; f32x4 t[8];
#pragma unroll
        for (int i = 0; i < 8; ++i) t[i] = __builtin_nontemporal_load((const f32x4*)(W + (size_t)(k0 + 8 * i + rr) * N + n0 + c4));
#pragma unroll
        for (int i = 0; i < 8; ++i) { LAS float* d = scr + (8 * i + rr) * 33 + c4; d[0] = t[i].x; d[1] = t[i].y; d[2] = t[i].z; d[3] = t[i].w; }
    }
    LDS_WAIT(); asm volatile("" ::: "memory");
    const int c = lane & 7;
#pragma unroll
    for (int j = 0; j < 4; ++j) { const int n = (lane >> 3) + 8 * j; const LAS float* s = scr + (8 * c) * 33 + n;
        u32x4 o; o.x = cvt_pk_bf16(s[0 * 33], s[1 * 33]); o.y = cvt_pk_bf16(s[2 * 33], s[3 * 33]); o.z = cvt_pk_bf16(s[4 * 33], s[5 * 33]); o.w = cvt_pk_bf16(s[6 * 33], s[7 * 33]);
        const int nn = n0 + n; const int row = MAP == 1 ? win_map(nn) : (MAP == 2 ? glu_map(nn) : nn);
        *(u32x4*)(WT + (size_t)row * K + k0 + 8 * c) = o; }
    LDS_WAIT(); asm volatile("" ::: "memory");
}

constexpr float WDN_SCALE = 16.f, ACT_SCALE = 8.f;
constexpr float WIN_SCALE = 32.f;
template <int MAP>
__device__ __forceinline__ void transpose_item8(const float* W, int K, int N, unsigned char* WT, LAS float* scr, int item, int lane, float scale = WIN_SCALE) {
    const int nblk = N / 32, kb = item / nblk, nb = item % nblk, k0 = 64 * kb, n0 = 32 * nb;
    {
        const int rr = lane >> 3, c4 = (lane & 7) * 4; f32x4 t[8];
#pragma unroll
        for (int i = 0; i < 8; ++i) t[i] = __builtin_nontemporal_load((const f32x4*)(W + (size_t)(k0 + 8 * i + rr) * N + n0 + c4));
#pragma unroll
        for (int i = 0; i < 8; ++i) { LAS float* d = scr + (8 * i + rr) * 33 + c4; d[0] = t[i].x * scale; d[1] = t[i].y * scale; d[2] = t[i].z * scale; d[3] = t[i].w * scale; }
    }
    LDS_WAIT(); asm volatile("" ::: "memory");
    const int c = lane & 7;
#pragma unroll
    for (int j = 0; j < 4; ++j) { const int n = (lane >> 3) + 8 * j; const LAS float* sp = scr + (8 * c) * 33 + n;
        int d0 = 0, d1 = 0;
        d0 = __builtin_amdgcn_cvt_pk_fp8_f32(sp[0 * 33], sp[1 * 33], d0, false); d0 = __builtin_amdgcn_cvt_pk_fp8_f32(sp[2 * 33], sp[3 * 33], d0, true);
        d1 = __builtin_amdgcn_cvt_pk_fp8_f32(sp[4 * 33], sp[5 * 33], d1, false); d1 = __builtin_amdgcn_cvt_pk_fp8_f32(sp[6 * 33], sp[7 * 33], d1, true);
        const int nn = n0 + n; const int row = MAP == 1 ? win_map(nn) : (MAP == 2 ? glu_map(nn) : nn);
        *(u32x2*)(WT + (size_t)row * K + k0 + 8 * c) = (u32x2){(unsigned)d0, (unsigned)d1}; }
    LDS_WAIT(); asm volatile("" ::: "memory");
}
__device__ __forceinline__ void phase0(Frame& F) {
    if (F.vcu < 96) {
        const int col = F.vcu * 64 + F.lane; const float* c = F.in(I_C); const float* wa = F.in(I_WADA);
        float a0 = 0.f, a1 = 0.f;
        for (int k = F.wave * 128; k < F.wave * 128 + 128; ++k) { const float c0 = c[k], c1 = c[1024 + k]; const float s0 = c0 * sigmoidf_(c0), s1 = c1 * sigmoidf_(c1); const float w = wa[(size_t)k * 6144 + col]; a0 += s0 * w; a1 += s1 * w; }
        LAS float* red = (LAS float*)F.lds;
        red[(F.wave * 2 + 0) * 64 + F.lane] = a0; red[(F.wave * 2 + 1) * 64 + F.lane] = a1;
        __syncthreads();
        if (F.wave == 0) { float s0 = 0.f, s1 = 0.f;
#pragma unroll
            for (int w = 0; w < 8; ++w) { s0 += red[(w * 2 + 0) * 64 + F.lane]; s1 += red[(w * 2 + 1) * 64 + F.lane]; }
            float* mod = (float*)(F.ws + WS_MOD); const float bb = F.in(I_BADA)[col]; mod[col] = s0 + bb; mod[6144 + col] = s1 + bb; }
        __syncthreads();
    }
    LAS float* scr = (LAS float*)(F.lds + F.wave * 16384);
    const int gw = F.vcu * NWAVES + F.wave, NGW = F.G * NWAVES;
    constexpr int I_IN = 16 * (NIN / 32), I_SQ = 16 * 32, I_EGU = 16 * 16, I_EDN = 4 * 32;
    constexpr int NITEMS = I_IN + 2 * I_SQ + NEX * I_EGU + NEX * I_EDN;
    for (int it = gw; it < NITEMS; it += NGW) {
        int r = it;
        if (r < I_IN) { transpose_item8<1>(F.in(I_WIN), 1024, NIN, (unsigned char*)(F.ws + WS_WIN), scr, r, F.lane); continue; } r -= I_IN;
        if (r < I_SQ) { transpose_item8<0>(F.in(I_WPW2), 1024, 1024, (unsigned char*)(F.ws + WS_WPW2), scr, r, F.lane); continue; } r -= I_SQ;
        if (r < I_SQ) { transpose_item<0>(F.in(I_WOUT), 1024, 1024, (bf16*)(F.ws + WS_WOUT), scr, r, F.lane); continue; } r -= I_SQ;
        if (r < NEX * I_EGU) { const int e = r / I_EGU, rr = r % I_EGU; const float* W = e < NE ? F.in(I_WEGU) + (size_t)e * 1024 * 512 : F.in(I_WSGU);
            transpose_item8<2>(W, 1024, 512, (unsigned char*)(F.ws + WS_WGU) + (size_t)e * 512 * 1024, scr, rr, F.lane); continue; } r -= NEX * I_EGU;
        { const int e = r / I_EDN, rr = r % I_EDN; const float* W = e < NE ? F.in(I_WEDN) + (size_t)e * 256 * 1024 : F.in(I_WSDN);
            transpose_item8<0>(W, 256, 1024, (unsigned char*)(F.ws + WS_WDN) + (size_t)e * 1024 * 256, scr, rr, F.lane, WDN_SCALE); }
    }
    {
        const float* wr = F.in(I_WR); bf16* wh = (bf16*)(F.ws + WS_WRH); bf16* wl = (bf16*)(F.ws + WS_WRL);
        for (int idx = F.vcu * NTHREADS + F.tid; idx < 64 * 1024; idx += F.G * NTHREADS) { const int e = idx >> 10, k = idx & 1023; const float w = wr[k * 64 + e];
            const unsigned h = cvt_pk_bf16(w, 0.f) & 0xffffu; const float r = w - bf_lo(h); wh[idx] = (bf16)h; wl[idx] = (bf16)(cvt_pk_bf16(r, 0.f) & 0xffffu); }
    }
    {
        const int* pos = (const int*)F.in(I_POS); float* rope = (float*)(F.ws + WS_ROPE);
        for (int idx = F.vcu * NTHREADS + F.tid; idx < T * 8; idx += F.G * NTHREADS) {
            const int tok = idx >> 3, i = idx & 7;
            const unsigned fb = i == 0 ? 1065353216u : i == 1 ? 1044812719u : i == 2 ? 1025116360u : i == 3 ? 1005516622u : i == 4 ? 985226530u : i == 5 ? 965724408u : i == 6 ? 945754309u : 925697960u;
            const float ang = (float)pos[tok] * __builtin_bit_cast(float, fb);
            double rv = (double)ang * 0.15915494309189535; rv -= floor(rv);
            const float fr_ = (float)rv;
            rope[tok * 16 + i] = __builtin_amdgcn_cosf(fr_); rope[tok * 16 + 8 + i] = __builtin_amdgcn_sinf(fr_);
        }
    }
}

__device__ __forceinline__ void phase1(Frame& F) {
    const float* mod = (const float*)(F.ws + WS_MOD); const float* gn = F.in(I_N1G); unsigned char* H = (unsigned char*)F.out;
    const int gw = F.vcu * NWAVES + F.wave, NGW = F.G * NWAVES, lane = F.lane;
    const float* X = F.in(I_X);
    f32x4 gg[4], sh[4]; int bcur = -1;
    f32x4 va[4][4], vb[4][4];
#define P1_LOAD(V, k_) do { _Pragma("unroll") for (int u = 0; u < 4; ++u) { const int m = gw + ((k_) + u) * NGW; if (m < T) { const f32x4* xr = (const f32x4*)(X + (size_t)m * D) + lane; \
            _Pragma("unroll") for (int j = 0; j < 4; ++j) V[u][j] = xr[64 * j]; } } } while (0)
#define P1_PROC(V, k_) do { _Pragma("unroll") for (int u = 0; u < 4; ++u) { const int m = gw + ((k_) + u) * NGW; if (m < T) { const int b = m >> 14; \
            if (b != bcur) { bcur = b; _Pragma("unroll") for (int j = 0; j < 4; ++j) { const int col = 4 * lane + 256 * j; \
                const f32x4 g = *(const f32x4*)(gn + col), sc = *(const f32x4*)(mod + b * 6144 + 1024 + col); gg[j] = g * (sc + 1.f); sh[j] = *(const f32x4*)(mod + b * 6144 + col); } } \
            float s = 0.f; _Pragma("unroll") for (int j = 0; j < 4; ++j) s += (V[u][j].x * V[u][j].x + V[u][j].y * V[u][j].y) + (V[u][j].z * V[u][j].z + V[u][j].w * V[u][j].w); \
            const float rstd = __builtin_amdgcn_rsqf(wave_sum(s) * (1.f / D) + EPS); \
            unsigned* o4 = (unsigned*)(H + (size_t)m * D) + lane;            \
            _Pragma("unroll") for (int j = 0; j < 4; ++j) { const f32x4 y = V[u][j] * rstd * gg[j] + sh[j]; \
                int w = 0; w = __builtin_amdgcn_cvt_pk_fp8_f32(y.x, y.y, w, false); w = __builtin_amdgcn_cvt_pk_fp8_f32(y.z, y.w, w, true); o4[64 * j] = (unsigned)w; } } } } while (0)
    P1_LOAD(va, 0);
    for (int k = 0; gw + k * NGW < T; k += 8) {
        P1_LOAD(vb, k + 4);
        P1_PROC(va, k);
        P1_LOAD(va, k + 8);
        P1_PROC(vb, k + 4);
    }
#undef P1_LOAD
#undef P1_PROC
}

struct EpiIn {
    static constexpr bool PERM = true;
    static constexpr float SI = 1.f / WIN_SCALE;
    bf16 *U, *Q, *Kb, *V, *GC, *GA; const float* rope; const float* qg; const float* kg; LAS unsigned char* scr;
    __device__ __forceinline__ void operator()(const f32x4 (&acc)[2][2][4][2], const pg8::Unit& u, int wr, int wc, int fr, int fq) const {
        asm volatile("" : "+v"(fr), "+v"(fq));
        const int pn = u.pn, row0 = u.pm * 256 + wr * 64 + fr;
        if (pn < 8) {
#pragma unroll
            for (int ai = 0; ai < 2; ++ai)
#pragma unroll
                for (int m = 0; m < 4; ++m) { const int row = row0 + ai * 128 + m * 16; float r[8];
#pragma unroll
                    for (int n = 0; n < 2; ++n)
#pragma unroll
                        for (int i = 0; i < 4; ++i) r[4 * n + i] = (acc[ai][0][m][n][i] * SI) * sigmoidf_(acc[ai][1][m][n][i] * SI);
                    u32x4 w; w.x = cvt_pk_bf16(r[0], r[1]); w.y = cvt_pk_bf16(r[2], r[3]); w.z = cvt_pk_bf16(r[4], r[5]); w.w = cvt_pk_bf16(r[6], r[7]);
                    *(u32x4*)(U + (size_t)row * D + pn * 128 + wc * 32 + fq * 8) = w; }
        } else if (pn < 16) {
            const bool isq = pn < 12; const int g = 4 * ((pn - 8) & 3) + wc, h = g >> 1, mp = g & 1;
            const float* gp = isq ? qg : kg; float gn[2][8];
#pragma unroll
            for (int bj = 0; bj < 2; ++bj)
#pragma unroll
                for (int e = 0; e < 8; ++e) gn[bj][e] = gp[qk_dim(bj, fq, e)] * (isq ? C2 * QSC : 1.f);
            bf16* dst = isq ? Q : Kb;
#pragma unroll
            for (int ai = 0; ai < 2; ++ai)
#pragma unroll
                for (int m = 0; m < 4; ++m) { const int row = row0 + ai * 128 + m * 16, b = row >> 14, s = row & (SEQ - 1);
                    float v[2][8]; float ss = 0.f;
#pragma unroll
                    for (int bj = 0; bj < 2; ++bj)
#pragma unroll
                        for (int n = 0; n < 2; ++n)
#pragma unroll
                            for (int i = 0; i < 4; ++i) { const float t = acc[ai][bj][m][n][i] * SI; v[bj][4 * n + i] = t; ss += t * t; }
                    ss += __shfl_xor(ss, 16); ss += __shfl_xor(ss, 32);
                    const float rstd = __builtin_amdgcn_rsqf(ss * (1.f / 64.f) + EPS);
#pragma unroll
                    for (int bj = 0; bj < 2; ++bj)
#pragma unroll
                        for (int e = 0; e < 8; ++e) v[bj][e] = v[bj][e] * rstd * gn[bj][e];
                    if (fq == 0) { const f32x4* rp = (const f32x4*)(rope + (size_t)row * 16); const f32x4 c0 = rp[0], c1 = rp[1], s0 = rp[2], s1 = rp[3];
#pragma unroll
                        for (int e = 0; e < 8; ++e) { const float cs = e < 4 ? c0[e & 3] : c1[e & 3], sn = e < 4 ? s0[e & 3] : s1[e & 3]; const float x1 = v[0][e], x2 = v[1][e];
                            v[0][e] = x1 * cs - x2 * sn; v[1][e] = x2 * cs + x1 * sn; } }
                    unsigned char* rowp = (unsigned char*)dst + ((size_t)((b * 8 + h) * 2 + mp) * SEQ + s) * 64;
                    const int sw = isq ? 0 : ((s >> 2) & 3);
                    u32x4 w;
                    { int d;
                      d = 0; d = __builtin_amdgcn_cvt_pk_fp8_f32(v[0][0], v[0][1], d, false); d = __builtin_amdgcn_cvt_pk_fp8_f32(v[0][2], v[0][3], d, true); w.x = (unsigned)d;
                      d = 0; d = __builtin_amdgcn_cvt_pk_fp8_f32(v[0][4], v[0][5], d, false); d = __builtin_amdgcn_cvt_pk_fp8_f32(v[0][6], v[0][7], d, true); w.y = (unsigned)d;
                      d = 0; d = __builtin_amdgcn_cvt_pk_fp8_f32(v[1][0], v[1][1], d, false); d = __builtin_amdgcn_cvt_pk_fp8_f32(v[1][2], v[1][3], d, true); w.z = (unsigned)d;
                      d = 0; d = __builtin_amdgcn_cvt_pk_fp8_f32(v[1][4], v[1][5], d, false); d = __builtin_amdgcn_cvt_pk_fp8_f32(v[1][6], v[1][7], d, true); w.w = (unsigned)d; }
                    *(u32x4*)(rowp + ((fq ^ sw) << 4)) = w; }
        } else if (pn < 20) {
            LAS unsigned char* wsb = scr + (wr * 4 + wc) * 2048; const int lane_ = fr + 16 * fq;
#pragma unroll
            for (int ai = 0; ai < 2; ++ai)
#pragma unroll
                for (int bj = 0; bj < 2; ++bj) {
#pragma unroll
                    for (int m = 0; m < 4; ++m) { const int kk = 16 * m + fr;
                        const int p = 32 * ((kk >> 2) & 1) + 16 * (kk >> 5) + (kk & 3) + 4 * ((kk & 31) >> 3);
#pragma unroll
                        for (int n = 0; n < 2; ++n) { const unsigned d01 = (unsigned)__builtin_amdgcn_cvt_pk_fp8_f32(acc[ai][bj][m][n][0] * SI, acc[ai][bj][m][n][1] * SI, 0, false);
                            const unsigned d23 = (unsigned)__builtin_amdgcn_cvt_pk_fp8_f32(acc[ai][bj][m][n][2] * SI, acc[ai][bj][m][n][3] * SI, 0, false);
#pragma unroll
                            for (int i = 0; i < 4; ++i) { const int e = 4 * n + i; const unsigned byte = ((i < 2 ? d01 : d23) >> (8 * (i & 1)));
                                const int sw = (2 * fq + (e >> 2)) & 3;
                                wsb[(fq * 8 + e) * 64 + ((((p >> 4) ^ sw) << 4) | (p & 15))] = (unsigned char)byte; } } }
                    LDS_WAIT(); asm volatile("" ::: "memory");
                    const u32x4 t0 = *(const LAS u32x4*)(wsb + lane_ * 32), t1 = *(const LAS u32x4*)(wsb + lane_ * 32 + 16);
                    const int row = u.pm * 256 + ai * 128 + wr * 64, b = row >> 14, s = row & (SEQ - 1), h = 2 * (pn - 16) + bj;
                    unsigned char* tp = (unsigned char*)V + (((size_t)(b * 8 + h) * 256 + (s >> 6)) * 128 + wc * 32) * 64 + lane_ * 32;
                    *(u32x4*)tp = t0; *(u32x4*)(tp + 16) = t1;
                    LDS_WAIT(); asm volatile("" ::: "memory"); }
        } else {
            bf16* dst = pn < 24 ? GC : GA; const int colt = ((pn - 20) & 3) * 256;
#pragma unroll
            for (int ai = 0; ai < 2; ++ai)
#pragma unroll
                for (int m = 0; m < 4; ++m) { const int row = row0 + ai * 128 + m * 16;
#pragma unroll
                    for (int bj = 0; bj < 2; ++bj) { float r[8];
#pragma unroll
                        for (int n = 0; n < 2; ++n)
#pragma unroll
                            for (int i = 0; i < 4; ++i) r[4 * n + i] = sigmoidf_(acc[ai][bj][m][n][i] * SI);
                        u32x4 w; w.x = cvt_pk_bf16(r[0], r[1]); w.y = cvt_pk_bf16(r[2], r[3]); w.z = cvt_pk_bf16(r[4], r[5]); w.w = cvt_pk_bf16(r[6], r[7]);
                        *(u32x4*)(dst + (size_t)row * D + colt + bj * 128 + wc * 32 + fq * 8) = w; } }
        }
    }
};

__device__ __forceinline__ void phase3(Frame& F) {
    const bf16* U = (const bf16*)(F.ws + WS_U); bf16* CV = (bf16*)F.out;
    const int ch = 2 * F.tid;
    float wa[31], wb[31];
#pragma unroll
    for (int j = 0; j < 31; ++j) { const f32x2 w = *(const f32x2*)(F.in(I_CDW) + j * 1024 + ch); wa[j] = w.x; wb[j] = w.y; }
    const f32x2 cb = *(const f32x2*)(F.in(I_CDWB) + ch);
    LAS float* tile = (LAS float*)F.lds;
    for (int unit = F.vcu; unit < T / 64; unit += F.G) {
        const int t0 = unit * 64, s0 = t0 & (SEQ - 1);
        float xa[38], xb[38];
#pragma unroll
        for (int k = 0; k < 30; ++k) { unsigned v = 0u; if (s0 - 30 + k >= 0) v = *(const unsigned*)(U + (size_t)(t0 - 30 + k) * D + ch); xa[k] = bf_lo(v); xb[k] = bf_hi(v); }
        for (int blk = 0; blk < 8; ++blk) {
#pragma unroll
            for (int k = 0; k < 8; ++k) { const unsigned v = *(const unsigned*)(U + (size_t)(t0 + blk * 8 + k) * D + ch); xa[30 + k] = bf_lo(v); xb[30 + k] = bf_hi(v); }
            LAS float* tl = tile + (blk & 1) * 8192;
#pragma unroll
            for (int i = 0; i < 8; ++i) { float a = cb.x, b = cb.y;
#pragma unroll
                for (int j = 0; j < 31; ++j) { a += xa[i + j] * wa[j]; b += xb[i + j] * wb[j]; }
                *(LAS f32x2*)(tl + i * 1024 + ch) = (f32x2){a, b}; }
#pragma unroll
            for (int k = 0; k < 30; ++k) { xa[k] = xa[k + 8]; xb[k] = xb[k + 8]; }
            __syncthreads();
            {
                const LAS float* rowp = tl + F.wave * 1024;
                f32x4 v[4];
#pragma unroll
                for (int jj = 0; jj < 2; ++jj) { v[2 * jj] = *(const LAS f32x4*)(rowp + 512 * jj + 8 * F.lane); v[2 * jj + 1] = *(const LAS f32x4*)(rowp + 512 * jj + 8 * F.lane + 4); }
                float s = 0.f;
#pragma unroll
                for (int q = 0; q < 4; ++q) s += (v[q].x + v[q].y) + (v[q].z + v[q].w);
                const float mean = wave_sum(s) * (1.f / D); float s2 = 0.f;
#pragma unroll
                for (int q = 0; q < 4; ++q) { v[q] = v[q] - mean; s2 += (v[q].x * v[q].x + v[q].y * v[q].y) + (v[q].z * v[q].z + v[q].w * v[q].w); }
                const float rstd = __builtin_amdgcn_rsqf(wave_sum(s2) * (1.f / D) + EPS);
                bf16* op = (bf16*)((unsigned char*)CV + (size_t)(t0 + blk * 8 + F.wave) * D);
#pragma unroll
                for (int jj = 0; jj < 2; ++jj) { const int col = 512 * jj + 8 * F.lane; float r[8];
#pragma unroll
                    for (int q = 0; q < 2; ++q) { const f32x4 g = *(const f32x4*)(F.in(I_CLNG) + col + 4 * q), bb = *(const f32x4*)(F.in(I_CLNB) + col + 4 * q); const f32x4 y = v[2 * jj + q] * rstd * g + bb;
#pragma unroll
                        for (int i = 0; i < 4; ++i) r[4 * q + i] = y[i] * sigmoidf_(y[i]); }
                    int d0 = 0, d1 = 0;
                    d0 = __builtin_amdgcn_cvt_pk_fp8_f32(r[0], r[1], d0, false); d0 = __builtin_amdgcn_cvt_pk_fp8_f32(r[2], r[3], d0, true);
                    d1 = __builtin_amdgcn_cvt_pk_fp8_f32(r[4], r[5], d1, false); d1 = __builtin_amdgcn_cvt_pk_fp8_f32(r[6], r[7], d1, true);
                    *(u32x2*)((unsigned char*)op + col) = (u32x2){(unsigned)d0, (unsigned)d1}; }
            }
        }
        __syncthreads();
    }
}

struct EpiPw2 {
    static constexpr bool PERM = true;
    bf16* O; const bf16* GC; const float* bias;
    __device__ __forceinline__ void operator()(const f32x4 (&acc)[2][2][4][2], const pg8::Unit& u, int wr, int wc, int fr, int fq) const {
        const int row0 = u.pm * 256 + wr * 64 + fr, col0 = u.pn * 256 + wc * 32 + fq * 8;
#pragma unroll
        for (int ai = 0; ai < 2; ++ai)
#pragma unroll
            for (int m = 0; m < 4; ++m) { const int row = row0 + ai * 128 + m * 16;
#pragma unroll
                for (int bj = 0; bj < 2; ++bj) { const int col = col0 + bj * 128; const u32x4 gv = *(const u32x4*)(GC + (size_t)row * D + col);
                    const f32x4 b0 = *(const f32x4*)(bias + col), b1 = *(const f32x4*)(bias + col + 4); float r[8];
#pragma unroll
                    for (int i = 0; i < 4; ++i) { r[i] = acc[ai][bj][m][0][i] * (1.f / WIN_SCALE) + b0[i]; r[4 + i] = acc[ai][bj][m][1][i] * (1.f / WIN_SCALE) + b1[i]; }
                    r[0] *= bf_lo(gv.x); r[1] *= bf_hi(gv.x); r[2] *= bf_lo(gv.y); r[3] *= bf_hi(gv.y); r[4] *= bf_lo(gv.z); r[5] *= bf_hi(gv.z); r[6] *= bf_lo(gv.w); r[7] *= bf_hi(gv.w);
                    u32x4 w; w.x = cvt_pk_bf16(r[0], r[1]); w.y = cvt_pk_bf16(r[2], r[3]); w.z = cvt_pk_bf16(r[4], r[5]); w.w = cvt_pk_bf16(r[6], r[7]);
                    *(u32x4*)(O + (size_t)row * D + col) = w; } }
    }
};

namespace att {
constexpr int SLOT = 32768, NSLOT = 3, XOFF = NSLOT * SLOT;
typedef int i32x8 __attribute__((ext_vector_type(8)));
__device__ __forceinline__ int crow(int r, int hi) { return (r & 3) + 8 * (r >> 2) + 4 * hi; }
__device__ __forceinline__ s16x4 vtr(const LAS char* p) { typedef short v4i16_t __attribute__((ext_vector_type(4))); return __builtin_bit_cast(s16x4, __builtin_amdgcn_ds_read_tr16_b64_v4i16((LAS v4i16_t*)p)); }
#define BUF_DMA16(m0v, voff, srd, soff) asm volatile("s_mov_b32 m0, %0\n\ts_nop 0\n\tbuffer_load_dwordx4 %1, %2, %3 offen lds" :: "s"(m0v), "v"(voff), "s"(srd), "s"(soff) : "m0", "memory")
#define ATT_SB() __builtin_amdgcn_sched_barrier(0)
#ifndef VLA
#define VLA 4
#endif
struct DmaSet { unsigned m0[2], so[2]; };
__device__ __forceinline__ f32x16 zacc() { return (f32x16){0.f, 0.f, 0.f, 0.f, 0.f, 0.f, 0.f, 0.f, 0.f, 0.f, 0.f, 0.f, 0.f, 0.f, 0.f, 0.f}; }
__device__ __forceinline__ f32x16 mfma8(i32x8 a, i32x8 b, f32x16 c) { return __builtin_amdgcn_mfma_scale_f32_32x32x64_f8f6f4(a, b, c, 0, 0, 0, 0, 0, 0); }
#define ATT_KFRAG(kp, blk) ({ const u32x4 lo_ = *(const LAS u32x4*)((kp) + (blk) * 2048 + kc0), hi_ = *(const LAS u32x4*)((kp) + (blk) * 2048 + kc1); \
        (i32x8){(int)lo_.x, (int)lo_.y, (int)lo_.z, (int)lo_.w, (int)hi_.x, (int)hi_.y, (int)hi_.z, (int)hi_.w}; })
template <bool MASK>
__device__ __forceinline__ void shift_mask(f32x16& c0, f32x16& c1, int kb, int qrow, float negM, bool shift) {
    if (shift) {
#pragma unroll
        for (int r = 0; r < 16; ++r) { c0[r] += negM; c1[r] += negM; } }
    if (MASK) {
#pragma unroll
        for (int r = 0; r < 16; ++r) { const int kv = kb + (r & 3) + 8 * (r >> 2); if (kv > qrow) c0[r] = -INFINITY; if (kv + 32 > qrow) c1[r] = -INFINITY; } }
}
#define ATT_VFRAG(dst, i) do { const s16x4 lo_ = vtr(vp + ((i) & 3) * 4096 + ((i) >> 2) * 1024), hh_ = vtr(vp + ((i) & 3) * 4096 + ((i) >> 2) * 1024 + 512); \
        dst = (bf16x8){lo_[0], lo_[1], lo_[2], lo_[3], hh_[0], hh_[1], hh_[2], hh_[3]}; } while (0)
__device__ __forceinline__ int exp2_bf8x4(float a, float b, float c, float d) {
    unsigned w = __builtin_amdgcn_cvt_pk_u8_f32(a, 0u, 0u); w = __builtin_amdgcn_cvt_pk_u8_f32(b, 1u, w); w = __builtin_amdgcn_cvt_pk_u8_f32(c, 2u, w); w = __builtin_amdgcn_cvt_pk_u8_f32(d, 3u, w);
    return (int)w;
}
__device__ __forceinline__ f32x16 mfma_pv(i32x8 p, i32x8 v, f32x16 c) { return __builtin_amdgcn_mfma_scale_f32_32x32x64_f8f6f4(p, v, c, 1, 0, 0, 0, 0, 0); }
__device__ __forceinline__ f32x4 mfma_sum(i32x8 p, i32x8 sel, f32x4 c) { return __builtin_amdgcn_mfma_scale_f32_16x16x128_f8f6f4(p, sel, c, 1, 0, 0, 0, 0, 0); }
template <bool SECOND>
__device__ __forceinline__ void mask16(f32x16& c, int kb, int qrow) {
    int d = qrow - kb; asm volatile("" : "+v"(d));
#pragma unroll
    for (int r = 0; r < 16; ++r) { if ((r & 3) + 8 * (r >> 2) + (SECOND ? 32 : 0) > d) c[r] = -1e30f; }
}
__device__ __forceinline__ void att_step(bool MASK, f32x16 (&o)[4], i32x8 (&kf)[2], const i32x8& qf, const f32x16& cinit, f32x4& lacc, const i32x8& ones, const i32x8& pfp, i32x8& pfc,
                                         const LAS char* vp, const LAS char* kpn, int kc0, int kc1, int kb, int qrow,
                                         const DmaSet& dm, unsigned vdma, __amdgpu_buffer_rsrc_t srdK, __amdgpu_buffer_rsrc_t srdV) {
    i32x8 vf[4]; f32x16 c0, c1;
    vf[0] = ATT_KFRAG(vp, 0); vf[1] = ATT_KFRAG(vp, 1);
    c0 = mfma8(kf[0], qf, cinit);
    vf[2] = ATT_KFRAG(vp, 2); vf[3] = ATT_KFRAG(vp, 3);
    c1 = mfma8(kf[1], qf, cinit);
    ATT_SB();
#pragma unroll
    for (int i = 0; i < 4; ++i) {
        o[i] = mfma_pv(pfp, vf[i], o[i]);
        if (i == 0) BUF_DMA16(dm.m0[0], vdma, srdK, dm.so[0]);
        if (i == 1) kf[0] = ATT_KFRAG(kpn, 0);
        if (i == 2) kf[1] = ATT_KFRAG(kpn, 1);
        if (MASK && i == 0) mask16<false>(c0, kb, qrow);
        if (MASK && i == 2) mask16<true>(c1, kb, qrow);
        { const f32x16& C = i < 2 ? c0 : c1; const int e = 8 * (i & 1);
          int w0 = exp2_bf8x4(C[e], C[e + 1], C[e + 2], C[e + 3]), w1 = exp2_bf8x4(C[e + 4], C[e + 5], C[e + 6], C[e + 7]);
          asm volatile("" : "+v"(w0), "+v"(w1)); pfc[2 * i] = w0; pfc[2 * i + 1] = w1; }
        if (i == 3) BUF_DMA16(dm.m0[1], vdma, srdV, dm.so[1]);
        ATT_SB();
    }
    lacc = mfma_sum(pfp, ones, lacc);
}
__device__ __forceinline__ void att_drain(f32x16 (&o)[4], const i32x8& pf, f32x4& lacc, const i32x8& ones, const LAS char* vp, int kc0, int kc1) {
#pragma unroll
    for (int i = 0; i < 4; ++i) { const i32x8 f = ATT_KFRAG(vp, i); o[i] = mfma_pv(pf, f, o[i]); }
    lacc = mfma_sum(pf, ones, lacc);
}

__device__ __forceinline__ void phase5(Frame& F, bf16* MGout) {
    const bf16* GA = (const bf16*)(F.ws + WS_GA); bf16* MG = (bf16*)(F.ws + WS_U);
    const int lane = F.lane, r32 = lane & 31, hi = lane >> 5, wid = F.wave, rg = wid & 3, mp = wid >> 2;
    float lam;
    {
        const float q1 = F.in(I_LQ1)[lane], k1 = F.in(I_LK1)[lane], q2 = F.in(I_LQ2)[lane], k2 = F.in(I_LK2)[lane];
        lam = __expf(wave_sum(q1 * k1)) - __expf(wave_sum(q2 * k2)) + LAMBDA_INIT;
    }
    f32x16 cinit;
    { float pb = PBIAS; asm volatile("" : "+v"(pb));
#pragma unroll
      for (int r = 0; r < 16; ++r) cinit[r] = pb; }
    const int one4 = (lane & 15) == ((lane >> 4) & 1) ? 0x38383838 : 0;
    const i32x8 ones = {one4, one4, one4, one4, one4, one4, one4, one4};
    LAS char* ring = (LAS char*)F.lds;
    const unsigned ring0 = (unsigned)(size_t)ring;
    const int voff = r32 * 64;
    const int ksw = (r32 >> 2) & 3;
    const int koff = r32 * 64 + mp * 4096, kc0 = ((2 * hi) ^ ksw) << 4, kc1 = ((2 * hi + 1) ^ ksw) << 4;
    const __amdgpu_buffer_rsrc_t srdK = __builtin_amdgcn_make_buffer_rsrc((void*)(F.ws + WS_K), (short)0, 64 << 20, 0x00020000);
    const __amdgpu_buffer_rsrc_t srdV = __builtin_amdgcn_make_buffer_rsrc((void*)(F.ws + WS_V), (short)0, 64 << 20, 0x00020000);
    const __amdgpu_buffer_rsrc_t srdQ = __builtin_amdgcn_make_buffer_rsrc((void*)(F.ws + WS_Q), (short)0, 64 << 20, 0x00020000);
    const unsigned vdma = (unsigned)(wid * 1024 + lane * 16);
    const unsigned vdmk = (unsigned)((wid & 3) * 1024 + lane * 16);
    const unsigned vq = (unsigned)(r32 * 64 + hi * 32);
    if (wid >= 4) __builtin_amdgcn_s_setprio(1);
#ifndef DBG_ATT2
#define DBG_ATT2 0
#endif
    for (int p_ = F.vcu; p_ < (DBG_ATT2 ? 2048 : 1024); p_ += F.G) {
        const int p = p_ & 1023; bf16* const MGo = (DBG_ATT2 && p_ < 1024) ? (bf16*)F.out : MGout;
        const int bh = p >> 6, j = p & 63;
        for (int half = 0; half < 2; ++half) {
            const int qt = half == 0 ? j : 127 - j;
            const int NT = 2 * (qt + 1);
            const unsigned kxoff = (unsigned)(bh * 2 + (wid >> 2)) * (SEQ * 64u), voffg = (unsigned)bh * (256u * 8192u);
#define ATT_ISSUE_K(tk_, dst_) do { const unsigned tk__ = (unsigned)((tk_) < NT ? (tk_) : NT - 1) * 4096u; BUF_DMA16(ring0 + (dst_) + wid * 1024, vdmk, srdK, kxoff + tk__); } while (0)
#define ATT_ISSUE_V(tv_, dst_) do { const unsigned tv__ = voffg + (unsigned)((tv_) < NT ? (tv_) : NT - 1) * 8192u; BUF_DMA16(ring0 + (dst_) + wid * 1024, vdma, srdV, tv__); } while (0)
            u32x4 q0, q1;
            { const unsigned qs = ((unsigned)(bh * 2 + mp) * SEQ + (unsigned)(qt * 128 + rg * 32)) * 64u;
              asm volatile("buffer_load_dwordx4 %0, %2, %3, %4 offen\n\tbuffer_load_dwordx4 %1, %2, %3, %4 offen offset:16"
                           : "=&v"(q0), "=&v"(q1) : "v"(vq), "s"(srdQ), "s"(qs) : "memory"); }
            ATT_ISSUE_K(0, XOFF); ATT_ISSUE_K(1, XOFF + 16384);
            ATT_ISSUE_K(2, 0); ATT_ISSUE_V(0, 16384);
            ATT_ISSUE_K(3, SLOT); ATT_ISSUE_V(1, SLOT + 16384);
            asm volatile("s_waitcnt vmcnt(4)\n\ts_barrier" : "+v"(q0), "+v"(q1) :: "memory");
            const i32x8 qf = {(int)q0.x, (int)q0.y, (int)q0.z, (int)q0.w, (int)q1.x, (int)q1.y, (int)q1.z, (int)q1.w};
            f32x16 o[4];
#pragma unroll
            for (int vb = 0; vb < 4; ++vb)
#pragma unroll
                for (int r = 0; r < 16; ++r) o[vb][r] = 0.f;
            f32x4 lacc = {0.f, 0.f, 0.f, 0.f};
            const int qrow = qt * 128 + rg * 32 + r32;
            i32x8 kf[2], pfA, pfB;
            { const LAS char* kp0 = ring + XOFF + koff; f32x16 c0, c1;
              kf[0] = ATT_KFRAG(kp0, 0); kf[1] = ATT_KFRAG(kp0, 1);
              c0 = mfma8(kf[0], qf, cinit); c1 = mfma8(kf[1], qf, cinit);
              if (NT == 2) { mask16<false>(c0, 4 * hi, qrow); mask16<true>(c1, 4 * hi, qrow); }
#pragma unroll
              for (int d = 0; d < 8; ++d) { const f32x16& C = d < 4 ? c0 : c1; const int e = 4 * (d & 3); pfA[d] = exp2_bf8x4(C[e], C[e + 1], C[e + 2], C[e + 3]); } }
            { const LAS char* kp1 = ring + XOFF + 16384 + koff; kf[0] = ATT_KFRAG(kp1, 0); kf[1] = ATT_KFRAG(kp1, 1); }
            unsigned sl_use = 0, sl_mid = SLOT, sl_new = 2 * SLOT;
#define ATT_STEP(MASKED, PFC, PFP, t_) do { asm volatile("s_waitcnt vmcnt(2) lgkmcnt(0)\n\ts_barrier" ::: "memory"); \
                DmaSet dm; { const unsigned tk__ = (unsigned)(((t_) + 3) < NT ? ((t_) + 3) : NT - 1) * 4096u, tv__ = voffg + (unsigned)(((t_) + 1) < NT ? ((t_) + 1) : NT - 1) * 8192u, d__ = ring0 + sl_new + wid * 1024; \
                    dm.m0[0] = d__; dm.m0[1] = d__ + 16384u; dm.so[0] = kxoff + tk__ - (unsigned)(wid >> 2) * 4096u; dm.so[1] = tv__; }   \
                { const LAS char* vp = ring + sl_use + 16384 + voff; const LAS char* kpn = ring + sl_use + koff; \
                  att_step(MASKED, o, kf, qf, cinit, lacc, ones, PFP, PFC, vp, kpn, kc0, kc1, 64 * (t_) + 4 * hi, qrow, dm, vdma, srdK, srdV); } \
                { const unsigned t__ = sl_use; sl_use = sl_mid; sl_mid = sl_new; sl_new = t__; } } while (0)
            int t = 1;
            for (; t + 1 < NT; t += 2) { ATT_STEP(false, pfB, pfA, t); ATT_STEP((t + 1 >= NT - 2), pfA, pfB, t + 1); }
            ATT_STEP(true, pfB, pfA, NT - 1);
            const size_t eidx = ((size_t)(bh >> 3) * SEQ + qt * 128 + (F.tid >> 2)) * D + (bh & 7) * 128 + (F.tid & 3) * 32;
            u32x4 gaP[4], mcP[4];
#pragma unroll
            for (int c8 = 0; c8 < 4; ++c8) { gaP[c8] = *(const u32x4*)(GA + eidx + c8 * 8); mcP[c8] = *(const u32x4*)(MG + eidx + c8 * 8); }
            f32x4 sgP[8];
            { const float* sgp = F.in(I_SUBG) + (F.tid & 3) * 32; asm volatile("" : "+v"(sgp));
#pragma unroll
              for (int c4 = 0; c4 < 8; ++c4) sgP[c4] = *(const __attribute__((address_space(1))) f32x4*)(sgp + c4 * 4); }
            asm volatile("s_waitcnt vmcnt(16) lgkmcnt(0)\n\ts_barrier" ::: "memory");
            att_drain(o, pfB, lacc, ones, ring + sl_use + 16384 + voff, kc0, kc1);
#undef ATT_STEP
#undef ATT_ISSUE_K
#undef ATT_ISSUE_V
            float rl[16];
            { int hi_e = hi; asm volatile("" : "+v"(hi_e));
#pragma unroll
              for (int r = 0; r < 16; ++r) rl[r] = __builtin_amdgcn_rcpf(__shfl(lacc[r & 3], 16 * (2 * ((r >> 2) & 1) + hi_e) + (r >> 3))); }
            asm volatile("s_waitcnt lgkmcnt(0)\n\ts_barrier" ::: "memory");
            LAS float* xch = (LAS float*)ring + rg * 4096;
            if (mp == 1) {
#pragma unroll
                for (int vb = 0; vb < 4; ++vb)
#pragma unroll
                    for (int r = 0; r < 16; ++r) xch[(vb * 16 + r) * 64 + lane] = o[vb][r] * rl[r] * lam;
            }
            asm volatile("s_waitcnt lgkmcnt(0)\n\ts_barrier" ::: "memory");
            if (mp == 0) {
                float ssq[16];
#pragma unroll
                for (int r = 0; r < 16; ++r) ssq[r] = 0.f;
#pragma unroll
                for (int vb = 0; vb < 4; ++vb)
#pragma unroll
                    for (int r = 0; r < 16; ++r) { const float d = o[vb][r] * rl[r] - xch[(vb * 16 + r) * 64 + lane]; o[vb][r] = d; ssq[r] += d * d; }
#pragma unroll
                for (int r = 0; r < 16; ++r) { float s = ssq[r];
#pragma unroll
                    for (int off = 1; off < 32; off <<= 1) s += __shfl_xor(s, off);
                    ssq[r] = __builtin_amdgcn_rsqf(s * (1.f / 128.f) + EPS) * (1.f - LAMBDA_INIT); }
#pragma unroll
                for (int vb = 0; vb < 4; ++vb)
#pragma unroll
                    for (int r = 0; r < 16; ++r) xch[(vb * 16 + r) * 64 + lane] = o[vb][r] * ssq[r];
            }
            asm volatile("s_waitcnt lgkmcnt(0)\n\ts_barrier" ::: "memory");
            {
                const int b = bh >> 3, h = bh & 7, q = F.tid >> 2, vb = F.tid & 3, q5 = q & 31;
                const int rr = (q5 & 3) + 4 * (q5 >> 3), hh = (q5 >> 2) & 1;
                const LAS float* src = (const LAS float*)ring + (q >> 5) * 4096 + (vb * 16 + rr) * 64 + hh * 32;
                const size_t idx = eidx; (void)b; (void)h;
#pragma unroll
                for (int c8 = 0; c8 < 4; ++c8) { const f32x4 y0 = *(const LAS f32x4*)(src + c8 * 8), y1 = *(const LAS f32x4*)(src + c8 * 8 + 4);
                    const f32x4 g0 = sgP[2 * c8], g1 = sgP[2 * c8 + 1];
                    const u32x4 ga = gaP[c8], mc = mcP[c8];
                    u32x4 w;
                    w.x = cvt_pk_bf16(y0[0] * g0[0] * bf_lo(ga.x) + bf_lo(mc.x), y0[1] * g0[1] * bf_hi(ga.x) + bf_hi(mc.x));
                    w.y = cvt_pk_bf16(y0[2] * g0[2] * bf_lo(ga.y) + bf_lo(mc.y), y0[3] * g0[3] * bf_hi(ga.y) + bf_hi(mc.y));
                    w.z = cvt_pk_bf16(y1[0] * g1[0] * bf_lo(ga.z) + bf_lo(mc.z), y1[1] * g1[1] * bf_hi(ga.z) + bf_hi(mc.z));
                    w.w = cvt_pk_bf16(y1[2] * g1[2] * bf_lo(ga.w) + bf_lo(mc.w), y1[3] * g1[3] * bf_hi(ga.w) + bf_hi(mc.w));
                    *(u32x4*)(MGo + idx + c8 * 8) = w; }
            }
            asm volatile("s_waitcnt lgkmcnt(0)\n\ts_barrier" ::: "memory");
        }
    }
    __builtin_amdgcn_s_setprio(0);
}
}

struct EpiOut {
    static constexpr bool PERM = true;
    const float* X; float* O; const float* mod;
    __device__ __forceinline__ void operator()(const f32x4 (&acc)[2][2][4][2], const pg8::Unit& u, int wr, int wc, int fr, int fq) const {
        const int row0 = u.pm * 256 + wr * 64 + fr, col0 = u.pn * 256 + wc * 32 + fq * 8;
#pragma unroll
        for (int ai = 0; ai < 2; ++ai)
#pragma unroll
            for (int m = 0; m < 4; ++m) { const int row = row0 + ai * 128 + m * 16, b = row >> 14;
#pragma unroll
                for (int bj = 0; bj < 2; ++bj)
#pragma unroll
                    for (int n = 0; n < 2; ++n) { const int col = col0 + bj * 128 + 4 * n; const f32x4 g = *(const f32x4*)(mod + b * 6144 + 2048 + col), xv = *(const f32x4*)(X + (size_t)row * D + col);
                        *(f32x4*)(O + (size_t)row * D + col) = xv + g * acc[ai][bj][m][n]; } }
    }
};

__device__ __forceinline__ void phase7(Frame& F) {
    const float* X1 = F.out; const float* mod = (const float*)(F.ws + WS_MOD); const float* gn = F.in(I_N2G); bf16* H2 = (bf16*)(F.ws + WS_U);
    constexpr int PITCH = 272;
    LAS char* Ahi = (LAS char*)F.lds;
    LAS char* Alo = Ahi + 128 * PITCH;
    LAS char* Whi = Alo + 128 * PITCH;
    LAS char* Wlo = Whi + 64 * PITCH;
    LAS float* RS = (LAS float*)(F.lds + 104448);
    LAS int* CW = (LAS int*)(F.lds + 104960);
    LAS unsigned char* RK = (LAS unsigned char*)(F.lds + 105472);
    LAS float* LG = (LAS float*)F.lds;
    const int tid = F.tid, lane = F.lane, wid = F.wave, r32 = lane & 31, hi = lane >> 5;
    const bf16* WRH = (const bf16*)(F.ws + WS_WRH); const bf16* WRL = (const bf16*)(F.ws + WS_WRL);
    for (int chunk = F.vcu; chunk < T / 128; chunk += F.G) {
        const int t0 = chunk * 128, b = t0 >> 14;
        for (int i4 = 0; i4 < 16; i4 += 4) {
            f32x4 v[4][4]; float ss[4];
#pragma unroll
            for (int u = 0; u < 4; ++u) { const f32x4* xr = (const f32x4*)(X1 + (size_t)(t0 + wid * 16 + i4 + u) * D) + lane;
#pragma unroll
                for (int j = 0; j < 4; ++j) v[u][j] = xr[64 * j]; }
#pragma unroll
            for (int u = 0; u < 4; ++u) { float s = 0.f;
#pragma unroll
                for (int j = 0; j < 4; ++j) s += (v[u][j].x * v[u][j].x + v[u][j].y * v[u][j].y) + (v[u][j].z * v[u][j].z + v[u][j].w * v[u][j].w);
                ss[u] = s; }
#pragma unroll
            for (int o_ = 1; o_ < 64; o_ <<= 1) {
#pragma unroll
                for (int u = 0; u < 4; ++u) ss[u] += __shfl_xor(ss[u], o_); }
#pragma unroll
            for (int u = 0; u < 4; ++u) { const int m = t0 + wid * 16 + i4 + u; const float rstd = __builtin_amdgcn_rsqf(ss[u] * (1.f / D) + EPS);
                if (lane == 0) RS[wid * 16 + i4 + u] = rstd;
                unsigned* o4 = (unsigned*)((unsigned char*)H2 + (size_t)m * D) + lane;
#pragma unroll
                for (int j = 0; j < 4; ++j) { const int col = 4 * lane + 256 * j;
                    const f32x4 g = *(const f32x4*)(gn + col), sc = *(const f32x4*)(mod + b * 6144 + 4096 + col), sh = *(const f32x4*)(mod + b * 6144 + 3072 + col);
                    const f32x4 y = v[u][j] * rstd * g * (sc + 1.f) + sh;
                    int w = 0; w = __builtin_amdgcn_cvt_pk_fp8_f32(y.x, y.y, w, false); w = __builtin_amdgcn_cvt_pk_fp8_f32(y.z, y.w, w, true); o4[64 * j] = (unsigned)w; } } }
        __syncthreads();
        f32x16 c;
#pragma unroll
        for (int r = 0; r < 16; ++r) c[r] = 0.f;
        const int tb = wid & 3, eb = wid >> 2;
        for (int ks = 0; ks < 8; ++ks) {
            { const int row = tid & 127, seg = tid >> 7; const float rstd = RS[row];
              const float* xp = X1 + (size_t)(t0 + row) * D + ks * 128 + seg * 32;
              unsigned wh[16], wl[16];
#pragma unroll
              for (int q = 0; q < 8; ++q) { const int col = ks * 128 + seg * 32 + 4 * q; const f32x4 xv = *(const f32x4*)(xp + 4 * q);
                  const f32x4 g = *(const f32x4*)(gn + col), sc = *(const f32x4*)(mod + b * 6144 + 4096 + col), sh = *(const f32x4*)(mod + b * 6144 + 3072 + col);
                  const f32x4 y = xv * rstd * g * (sc + 1.f) + sh;
                  const unsigned h0 = cvt_pk_bf16(y.x, y.y), h1 = cvt_pk_bf16(y.z, y.w);
                  wh[2 * q] = h0; wh[2 * q + 1] = h1;
                  wl[2 * q] = cvt_pk_bf16(y.x - bf_lo(h0), y.y - bf_hi(h0)); wl[2 * q + 1] = cvt_pk_bf16(y.z - bf_lo(h1), y.w - bf_hi(h1)); }
#pragma unroll
              for (int q = 0; q < 4; ++q) { *(LAS u32x4*)(Ahi + row * PITCH + seg * 64 + q * 16) = (u32x4){wh[4 * q], wh[4 * q + 1], wh[4 * q + 2], wh[4 * q + 3]};
                  *(LAS u32x4*)(Alo + row * PITCH + seg * 64 + q * 16) = (u32x4){wl[4 * q], wl[4 * q + 1], wl[4 * q + 2], wl[4 * q + 3]}; }
#pragma unroll
              for (int q = 0; q < 2; ++q) { const int cc = tid + 512 * q, e = cc >> 4, kc = cc & 15;
                  *(LAS u32x4*)(Whi + e * PITCH + kc * 16) = *(const u32x4*)(WRH + e * 1024 + ks * 128 + kc * 8);
                  *(LAS u32x4*)(Wlo + e * PITCH + kc * 16) = *(const u32x4*)(WRL + e * 1024 + ks * 128 + kc * 8); } }
            __syncthreads();
#pragma unroll
            for (int st = 0; st < 8; ++st) { const int ao = (tb * 32 + r32) * PITCH + (2 * st + hi) * 16, bo = (eb * 32 + r32) * PITCH + (2 * st + hi) * 16;
                const bf16x8 ah = *(const LAS bf16x8*)(Ahi + ao), al = *(const LAS bf16x8*)(Alo + ao), bh = *(const LAS bf16x8*)(Whi + bo), bl = *(const LAS bf16x8*)(Wlo + bo);
                c = __builtin_amdgcn_mfma_f32_32x32x16_bf16(ah, bh, c, 0, 0, 0); c = __builtin_amdgcn_mfma_f32_32x32x16_bf16(ah, bl, c, 0, 0, 0); c = __builtin_amdgcn_mfma_f32_32x32x16_bf16(al, bh, c, 0, 0, 0); }
            __syncthreads();
        }
#pragma unroll
        for (int r = 0; r < 16; ++r) LG[(tb * 32 + att::crow(r, hi)) * 65 + eb * 32 + r32] = c[r];
        __syncthreads();
        unsigned long long chosen = 0ull; int ek[8]; float sk[8];
        if (tid < 128) {
            LAS float* L = LG + tid * 65;
            float gs[8];
#pragma unroll
            for (int g = 0; g < 8; ++g) { float m1 = -INFINITY, m2 = -INFINITY;
#pragma unroll
                for (int jx = 0; jx < 8; ++jx) { const float sc = sigmoidf_(L[g * 8 + jx]); const float ch = sc + F.in(I_RB)[g * 8 + jx]; L[g * 8 + jx] = ch;
                    if (ch > m1) { m2 = m1; m1 = ch; } else if (ch > m2) m2 = ch; }
                gs[g] = m1 + m2; }
            unsigned gm = 0u;
#pragma unroll
            for (int it = 0; it < 4; ++it) { float best = -INFINITY; int bi = 0;
#pragma unroll
                for (int g = 0; g < 8; ++g) { const bool ok = !((gm >> g) & 1u) && gs[g] > best; best = ok ? gs[g] : best; bi = ok ? g : bi; }
                gm |= 1u << bi; }
            int gsel[4]; float cand[32];
            { unsigned m = gm;
#pragma unroll
              for (int sx = 0; sx < 4; ++sx) { const int g = __builtin_ctz(m); m &= m - 1u; gsel[sx] = g;
#pragma unroll
                  for (int jx = 0; jx < 8; ++jx) cand[sx * 8 + jx] = L[g * 8 + jx]; } }
            float ssum = 0.f;
#pragma unroll
            for (int it = 0; it < 8; ++it) { float best = -INFINITY; int bi = 0;
#pragma unroll
                for (int i = 0; i < 32; ++i) { const bool ok = cand[i] > best; best = ok ? cand[i] : best; bi = ok ? i : bi; }
#pragma unroll
                for (int i = 0; i < 32; ++i) cand[i] = (i == bi) ? -INFINITY : cand[i];
                const int sx = bi >> 3; const int g = sx == 0 ? gsel[0] : sx == 1 ? gsel[1] : sx == 2 ? gsel[2] : gsel[3]; const int e = g * 8 + (bi & 7);
                chosen |= 1ull << e; ek[it] = e; const float sc = best - F.in(I_RB)[e]; sk[it] = sc; ssum += sc; }
            const float inv = 2.5f / ssum;
#pragma unroll
            for (int it = 0; it < 8; ++it) sk[it] *= inv;
        }
        if (wid < 2) {
            for (int e = 0; e < 64; ++e) { const bool f = (chosen >> e) & 1ull; const unsigned long long bm = __ballot(f);
                const int rk = __popcll(bm & ((1ull << lane) - 1ull));
                if (f) RK[tid * 64 + e] = (unsigned char)rk;
                if (lane == 0) CW[wid * 64 + e] = __popcll(bm); }
        }
        __syncthreads();
        if (tid < 128) {
            int* tke = (int*)(F.ws + WS_TKE) + (size_t)(t0 + tid) * 8; int* tkr = (int*)(F.ws + WS_TKR) + (size_t)(t0 + tid) * 8; float* tkw = (float*)(F.ws + WS_TKW) + (size_t)(t0 + tid) * 8;
#pragma unroll
            for (int it = 0; it < 8; ++it) { const int e = ek[it]; tke[it] = e; tkr[it] = (int)RK[tid * 64 + e] + (wid == 1 ? CW[e] : 0); tkw[it] = sk[it]; }
        }
        if (tid < 64) ((int*)(F.ws + WS_CNT))[chunk * 64 + tid] = CW[tid] + CW[64 + tid];
        __syncthreads();
    }
}

__device__ __forceinline__ void phase8(Frame& F) {
    const int* CNT = (const int*)(F.ws + WS_CNT); int* TOK = (int*)(F.ws + WS_TOK); float* WGT = (float*)(F.ws + WS_WGT); int* POS = (int*)(F.ws + WS_POS);
    LAS int* part = (LAS int*)F.lds;
    LAS int* tot = part + 1024;
    LAS int* below = tot + 64;
    LAS int* ebase = below + 64;
    const int tid = F.tid;
    for (int chunk = F.vcu; chunk < T / 128; chunk += F.G) {
        { const int e = tid & 63, pr = tid >> 6; int s = 0, sb = 0;
          for (int c = pr * 32; c < pr * 32 + 32; ++c) { const int v = CNT[c * 64 + e]; s += v; sb += c < chunk ? v : 0; }
          part[(pr * 2 + 0) * 64 + e] = s; part[(pr * 2 + 1) * 64 + e] = sb; }
        __syncthreads();
        if (tid < 64) { int s = 0, sb = 0;
#pragma unroll
            for (int pr = 0; pr < 8; ++pr) { s += part[(pr * 2 + 0) * 64 + tid]; sb += part[(pr * 2 + 1) * 64 + tid]; }
            tot[tid] = s; below[tid] = sb; }
        __syncthreads();
        if (tid == 0) { int a = 0; for (int e = 0; e < 64; ++e) { ebase[e] = a; a += (tot[e] + 255) & ~255; } ebase[64] = a; }
        __syncthreads();
        if (tid < 128) { const int tokn = chunk * 128 + tid;
            const int* tke = (const int*)(F.ws + WS_TKE) + (size_t)tokn * 8; const int* tkr = (const int*)(F.ws + WS_TKR) + (size_t)tokn * 8; const float* tkw = (const float*)(F.ws + WS_TKW) + (size_t)tokn * 8;
#pragma unroll
            for (int k = 0; k < 8; ++k) { const int e = tke[k]; const int pos = ebase[e] + below[e] + tkr[k]; TOK[pos] = tokn; WGT[pos] = tkw[k]; POS[tokn * 8 + k] = pos; } }
        const int RTOT = ebase[64];
        if (chunk < 64) { const int e = chunk; for (int p = ebase[e] + tot[e] + tid; p < ebase[e + 1]; p += NTHREADS) { TOK[p] = -1; WGT[p] = 0.f; } }
        { const int tokn = chunk * 128 + (tid & 127); if (tid < 128) { TOK[RTOT + tokn] = tokn; WGT[RTOT + tokn] = 1.f; } }
        if (chunk == 0) { int* TE = (int*)(F.ws + WS_TE); const int NTR = RTOT >> 8;
            for (int pm = tid; pm < NTR + 128; pm += NTHREADS) { int e = 64; if (pm < NTR) { e = 0; for (int x = 1; x < 64; ++x) e = (pm * 256 >= ebase[x]) ? x : e; } TE[pm] = e; }
            if (tid == 0) ((int*)(F.ws + WS_META))[0] = NTR; }
        __syncthreads();
    }
}

struct SchedMoe {
    int G, c, nunits, pm0, csh, colbase, bmul; const int* te; const int* tok;
    __device__ __forceinline__ bool next(int i, pg8::Unit& u) const {
        int pm, ct;
        if ((G & 7) == 0) { const int x = c & 7, w = c >> 3, W = G >> 3, nrows = nunits >> csh, nloc = (nrows + 7) >> 3;
            const long Lx = (long)i * W + w; const int pl = (int)(Lx >> csh), pr = x * nloc + pl; if (pl >= nloc || pr >= nrows) return false;
            pm = pm0 + pr; ct = colbase + (int)(Lx & ((1 << csh) - 1)); }
        else { const long L = (long)i * G + c; if (L >= nunits) return false; pm = pm0 + (int)(L >> csh); ct = colbase + (int)(L & ((1 << csh) - 1)); }
        u.pm = pm; u.pn = bmul * te[pm] + ct; return true; }
};
template <int MODE> struct EpiNull {
    static constexpr bool PERM = true;
    float* sink;
    __device__ __forceinline__ void operator()(const f32x4 (&acc)[2][2][4][2], const pg8::Unit& u, int wr, int wc, int fr, int fq) const {
        float s = 0.f;
        if (MODE == 1) {
#pragma unroll
            for (int ai = 0; ai < 2; ++ai)
#pragma unroll
                for (int bj = 0; bj < 2; ++bj)
#pragma unroll
                    for (int m = 0; m < 4; ++m)
#pragma unroll
                        for (int n = 0; n < 2; ++n) s += (acc[ai][bj][m][n][0] + acc[ai][bj][m][n][1]) + (acc[ai][bj][m][n][2] + acc[ai][bj][m][n][3]);
        } else s = acc[0][0][0][0][0] + acc[1][1][3][1][3];
        if (s == 12345.678f) sink[0] = s;
    }
};
struct EpiGU {
    static constexpr bool PERM = true;
    unsigned char* ACT; const float* WGT;
    __device__ __forceinline__ void operator()(const f32x4 (&acc)[2][2][4][2], const pg8::Unit& u, int wr, int wc, int fr, int fq) const {
        const int row0 = u.pm * 256 + wr * 64 + fr, ct = u.pn & 1;
#pragma unroll
        for (int ai = 0; ai < 2; ++ai)
#pragma unroll
            for (int m = 0; m < 4; ++m) { const int row = row0 + ai * 128 + m * 16; const float w = WGT[row] * ACT_SCALE; float r[8];
#pragma unroll
                for (int n = 0; n < 2; ++n)
#pragma unroll
                    for (int i = 0; i < 4; ++i) { const float g = acc[ai][0][m][n][i] * (1.f / WIN_SCALE); r[4 * n + i] = g * sigmoidf_(g) * (acc[ai][1][m][n][i] * (1.f / WIN_SCALE)) * w; }
                int d0 = 0, d1 = 0;
                d0 = __builtin_amdgcn_cvt_pk_fp8_f32(r[0], r[1], d0, false); d0 = __builtin_amdgcn_cvt_pk_fp8_f32(r[2], r[3], d0, true);
                d1 = __builtin_amdgcn_cvt_pk_fp8_f32(r[4], r[5], d1, false); d1 = __builtin_amdgcn_cvt_pk_fp8_f32(r[6], r[7], d1, true);
                *(u32x2*)(ACT + (size_t)row * 256 + ct * 128 + wc * 32 + fq * 8) = (u32x2){(unsigned)d0, (unsigned)d1}; }
    }
};
constexpr float Y_SCALE = 16.f;
struct EpiDown {
    static constexpr bool PERM = true;
    static constexpr float YD = Y_SCALE / (ACT_SCALE * WDN_SCALE);
    unsigned char* Y;
    __device__ __forceinline__ void operator()(const f32x4 (&acc)[2][2][4][2], const pg8::Unit& u, int wr, int wc, int fr, int fq) const {
        const int row0 = u.pm * 256 + wr * 64 + fr, col0 = (u.pn & 3) * 256 + (wc * 4 + fq) * 16;
#pragma unroll
        for (int ai = 0; ai < 2; ++ai)
#pragma unroll
            for (int m = 0; m < 4; ++m) { const int row = row0 + ai * 128 + m * 16; u32x4 w;
#pragma unroll
                for (int bj = 0; bj < 2; ++bj) { int d0 = 0, d1 = 0;
                    d0 = __builtin_amdgcn_cvt_pk_fp8_f32(acc[ai][bj][m][0][0] * YD, acc[ai][bj][m][0][1] * YD, d0, false); d0 = __builtin_amdgcn_cvt_pk_fp8_f32(acc[ai][bj][m][0][2] * YD, acc[ai][bj][m][0][3] * YD, d0, true);
                    d1 = __builtin_amdgcn_cvt_pk_fp8_f32(acc[ai][bj][m][1][0] * YD, acc[ai][bj][m][1][1] * YD, d1, false); d1 = __builtin_amdgcn_cvt_pk_fp8_f32(acc[ai][bj][m][1][2] * YD, acc[ai][bj][m][1][3] * YD, d1, true);
                    if (bj == 0) { w.x = (unsigned)d0; w.y = (unsigned)d1; } else { w.z = (unsigned)d0; w.w = (unsigned)d1; } }
                *(u32x4*)(Y + (size_t)row * 1024 + col0) = w; }
    }
};
struct EpiComb {
    static constexpr bool PERM = true;
    float* O; const unsigned char* Y; const int* POS; const float* mod; int rtiles;
    __device__ __forceinline__ void operator()(const f32x4 (&acc)[2][2][4][2], const pg8::Unit& u, int wr, int wc, int fr, int fq) const {
        const int row0 = (u.pm - rtiles) * 256 + wr * 64 + fr, ct = u.pn & 3, col0 = ct * 256 + wc * 32 + fq * 8;
#pragma unroll
        for (int ai = 0; ai < 2; ++ai)
#pragma unroll
            for (int m = 0; m < 4; ++m) { const int row = row0 + ai * 128 + m * 16, b = row >> 14;
                const i32x4 p0 = *(const i32x4*)(POS + (size_t)row * 8), p1 = *(const i32x4*)(POS + (size_t)row * 8 + 4);
                f32x2 t[8] = {{0.f, 0.f}, {0.f, 0.f}, {0.f, 0.f}, {0.f, 0.f}, {0.f, 0.f}, {0.f, 0.f}, {0.f, 0.f}, {0.f, 0.f}};
#pragma unroll
                for (int k = 0; k < 8; ++k) { const int pos = k < 4 ? p0[k & 3] : p1[k & 3]; const u32x4 y = *(const u32x4*)(Y + (size_t)pos * 1024 + ct * 256 + (wc * 4 + fq) * 16);
                    t[0] += __builtin_amdgcn_cvt_pk_f32_fp8((int)y.x, false); t[1] += __builtin_amdgcn_cvt_pk_f32_fp8((int)y.x, true);
                    t[2] += __builtin_amdgcn_cvt_pk_f32_fp8((int)y.y, false); t[3] += __builtin_amdgcn_cvt_pk_f32_fp8((int)y.y, true);
                    t[4] += __builtin_amdgcn_cvt_pk_f32_fp8((int)y.z, false); t[5] += __builtin_amdgcn_cvt_pk_f32_fp8((int)y.z, true);
                    t[6] += __builtin_amdgcn_cvt_pk_f32_fp8((int)y.w, false); t[7] += __builtin_amdgcn_cvt_pk_f32_fp8((int)y.w, true); }
#pragma unroll
                for (int bj = 0; bj < 2; ++bj) {
                    const int col = col0 + bj * 128; float* op = O + (size_t)row * D + col;
#pragma unroll
                    for (int n = 0; n < 2; ++n) { const f32x4 g = *(const f32x4*)(mod + b * 6144 + 5120 + col + 4 * n), xv = *(const f32x4*)(op + 4 * n);
                        const f32x4 sv = acc[ai][bj][m][n] * (1.f / (ACT_SCALE * WDN_SCALE)) + (f32x4){t[bj * 4 + 2 * n].x, t[bj * 4 + 2 * n].y, t[bj * 4 + 2 * n + 1].x, t[bj * 4 + 2 * n + 1].y} * (1.f / Y_SCALE);
                        *(f32x4*)(op + 4 * n) = xv + g * sv; } } }
    }
};

constexpr int NPHASE = 12;
__global__ void __launch_bounds__(NTHREADS, 2) fwd_kernel(Args args) {
    extern __shared__ __attribute__((aligned(16))) unsigned char lds[];
    Frame F;
    F.lds = (LAS unsigned char*)lds;
    F.tid = threadIdx.x; F.lane = F.tid & 63; F.wave = __builtin_amdgcn_readfirstlane(F.tid >> 6);
    F.G = gridDim.x; { const int bx = blockIdx.x; F.vcu = (F.G % 8 == 0) ? (bx % 8) * (F.G / 8) + bx / 8 : bx; }
    F.ws = args.ws; F.out = args.out;
    F.ka = (const __attribute__((address_space(4))) unsigned char*)__builtin_amdgcn_kernarg_segment_ptr();
    volatile LAS unsigned* MISC = (volatile LAS unsigned*)(F.lds + MISC_OFF);
    if (F.tid < 64) MISC[F.tid] = 0u;
    __syncthreads();
    const int lo = args.ph_lo, hi = args.ph_hi;
    unsigned* barw = (unsigned*)(F.ws + WS_CTL) + CW_BAR;
    XcdBarrier bar; bar.bar = barw; bar.x = 0; bar.st = nullptr;
    if (hi - lo > 1) bar = xcd_barrier_post(barw, MISC + 8);
#ifndef ONLY_PHASE
#define ONLY_PHASE -1
#endif
#define HASP(k) (ONLY_PHASE < 0 || ONLY_PHASE == (k) || (ONLY_PHASE == 100 && (k) == 10) || (ONLY_PHASE == 101 && (k) == 11))
#define IN(k) (HASP(k) && lo <= (k) && (k) < hi)
#ifndef DBG_REP
#define DBG_REP -1
#endif
#ifndef DBG_REPN
#define DBG_REPN 2
#endif
#define REPS(k) for (int rep_ = 0; rep_ < ((DBG_REP == (k)) ? DBG_REPN : 1); (void)({ asm volatile("" ::: "memory"); 0; }), ++rep_)
#define SEAM(k) do { if (IN(k) && IN((k) + 1)) xcd_barrier(bar); } while (0)
    bf16* const H = (bf16*)F.out;

    if (IN(0)) { REPS(0) phase0(F); } SEAM(0);
    if (IN(1)) { REPS(1) phase1(F); } SEAM(1);
    if (IN(2)) REPS(2) {
        pg8::Gemm g{H, (const bf16*)(F.ws + WS_WIN), T, NIN, D / 2}; pg8::StaticOrder S; S.init(T, NIN, F.G, (int)blockIdx.x);
        EpiIn E{(bf16*)(F.ws + WS_U), (bf16*)(F.ws + WS_Q), (bf16*)(F.ws + WS_K), (bf16*)(F.ws + WS_V), (bf16*)(F.ws + WS_GC), (bf16*)(F.ws + WS_GA), (const float*)(F.ws + WS_ROPE), F.in(I_QNG), F.in(I_KNG), F.lds + EPI_SCR};
        pg8::gemm_phase<EpiIn, pg8::StaticOrder, true, true, false, true>(F.lds, g, S, E);
    } SEAM(2);
    if (IN(3)) { REPS(3) phase3(F); } SEAM(3);
    if (IN(4)) REPS(4) {
        pg8::Gemm g{H, (const bf16*)(F.ws + WS_WPW2), T, D, D / 2}; pg8::StaticOrder S; S.init(T, D, F.G, (int)blockIdx.x);
        EpiPw2 E{(bf16*)(F.ws + WS_U), (const bf16*)(F.ws + WS_GC), F.in(I_BPW2)};
        pg8::gemm_phase<EpiPw2, pg8::StaticOrder, true, true, false, true>(F.lds, g, S, E);
    } SEAM(4);
#ifndef DBG_ATTVAR
#define DBG_ATTVAR 0
#endif
    if (IN(5)) { att::phase5(F, (bf16*)(F.ws + WS_U)); } SEAM(5);
    if (IN(6)) REPS(6) {
        pg8::Gemm g{(const bf16*)(F.ws + WS_U), (const bf16*)(F.ws + WS_WOUT), T, D, D}; pg8::StaticOrder S; S.init(T, D, F.G, (int)blockIdx.x);
        EpiOut E{F.in(I_X), F.out, (const float*)(F.ws + WS_MOD)};
        pg8::gemm_phase<EpiOut, pg8::StaticOrder, true, true, false>(F.lds, g, S, E);
    } SEAM(6);
    if (IN(7)) { REPS(7) phase7(F); } SEAM(7);
    if (IN(8)) { REPS(8) phase8(F); } SEAM(8);
    const int* TE = (const int*)(F.ws + WS_TE); const int* TOK = (const int*)(F.ws + WS_TOK);
    if (IN(9)) REPS(9) {
        const int NTR = ((const int*)(F.ws + WS_META))[0];
        pg8::Gemm g{(const bf16*)(F.ws + WS_U), (const bf16*)(F.ws + WS_WGU), 0, 0, D / 2};
        SchedMoe S{F.G, (int)blockIdx.x, 2 * (NTR + 128), 0, 1, 0, 2, TE, TOK};
        EpiGU E{(unsigned char*)(F.ws + WS_ACT), (const float*)(F.ws + WS_WGT)};
        pg8::gemm_phase<EpiGU, SchedMoe, true, true, true, true>(F.lds, g, S, E);
    } SEAM(9);
    if (IN(10)) REPS(10) { const int NTR = ((const int*)(F.ws + WS_META))[0];
        pg8::Gemm g{(const bf16*)(F.ws + WS_ACT), (const bf16*)(F.ws + WS_WDN), 0, 0, ED / 2};
        SchedMoe S{F.G, (int)blockIdx.x, 4 * NTR, 0, 2, 0, 4, TE, TOK};
        EpiDown E{(unsigned char*)(F.ws + WS_Y)};
#ifndef DBG_P10VAR
#define DBG_P10VAR 0
#endif
        if (DBG_P10VAR == 1) { EpiNull<0> E0{(float*)(F.ws + WS_META) + 8}; pg8::gemm_phase<EpiNull<0>, SchedMoe, true, true, false>(F.lds, g, S, E0); }
        if (DBG_P10VAR == 2) { EpiNull<1> E0{(float*)(F.ws + WS_META) + 8}; pg8::gemm_phase<EpiNull<1>, SchedMoe, true, true, false>(F.lds, g, S, E0); }
        pg8::gemm_phase<EpiDown, SchedMoe, true, true, false, true>(F.lds, g, S, E);
    } SEAM(10);
    if (IN(11)) { const int NTR = ((const int*)(F.ws + WS_META))[0];
        pg8::Gemm g{(const bf16*)(F.ws + WS_ACT), (const bf16*)(F.ws + WS_WDN), 0, 0, ED / 2};
        SchedMoe S{F.G, (int)blockIdx.x, 512, NTR, 2, 0, 4, TE, TOK};
        EpiComb E{F.out, (const unsigned char*)(F.ws + WS_Y), (const int*)(F.ws + WS_POS), (const float*)(F.ws + WS_MOD), NTR};
        pg8::gemm_phase<EpiComb, SchedMoe, true, true, false, true>(F.lds, g, S, E);
    }
#undef IN
#undef SEAM

}

#ifndef DBG_A6
#define DBG_A6 WS_U
#endif
#ifndef DBG_SKIP
#define DBG_SKIP 0
#endif
#ifndef DBG_NPH
#define DBG_NPH NPHASE
#endif
#ifndef N_LAUNCH_MODE
#define N_LAUNCH_MODE 1
#endif
extern "C" void kernel_launch(void* const* d_in, const int* in_sizes, int n_in, void* d_out, int out_size, void* d_ws, size_t ws_size, hipStream_t stream) {
    static int grid = 0;
    if (grid == 0) {
        if (n_in != 28 || out_size != T * D || ws_size < WS_END) { fprintf(stderr, "kernel_launch: unexpected problem (n_in %d out %d ws %zu)\n", n_in, out_size, ws_size); grid = -1; return; }
        int dev = 0, cus = 0, per_cu = 0;
        if (hipGetDevice(&dev) != hipSuccess || hipDeviceGetAttribute(&cus, hipDeviceAttributeMultiprocessorCount, dev) != hipSuccess) { grid = -1; return; }
        if (hipFuncSetAttribute((const void*)fwd_kernel, hipFuncAttributeMaxDynamicSharedMemorySize, LDS_BYTES) != hipSuccess) { grid = -1; return; }
        if (hipOccupancyMaxActiveBlocksPerMultiprocessor(&per_cu, (const void*)fwd_kernel, NTHREADS, LDS_BYTES) != hipSuccess || per_cu < 1) { fprintf(stderr, "kernel_launch: occupancy query says %d\n", per_cu); }
        (void)hipGetLastError();
        grid = cus;
    }
    if (grid < 0) return;
    (void)hipMemsetAsync((char*)d_ws + WS_CTL, 0, CTL_ZERO_BYTES, stream);
    Args a{};
    for (int i = 0; i < 28; ++i) a.in[i] = d_in[i];
    a.out = (float*)d_out; a.ws = (unsigned char*)d_ws;
    if (N_LAUNCH_MODE == 1) { a.ph_lo = 0; a.ph_hi = NPHASE; hipLaunchKernelGGL(fwd_kernel, dim3(grid), dim3(NTHREADS), LDS_BYTES, stream, a); }
    else { for (int p = 0; p < DBG_NPH; ++p) { if ((DBG_SKIP >> p) & 1) continue; a.ph_lo = p; a.ph_hi = p + 1; hipLaunchKernelGGL(fwd_kernel, dim3(grid), dim3(NTHREADS), LDS_BYTES, stream, a); } }
}
```

```cpp
#include <hip/hip_runtime.h>
#include <cstdio>
#include <cstdint>

#define GAS __attribute__((address_space(1)))
#define LAS __attribute__((address_space(3)))
typedef unsigned short bf16;
typedef short bf16x8 __attribute__((ext_vector_type(8)));
typedef short s16x4 __attribute__((ext_vector_type(4)));
typedef float f32x4 __attribute__((ext_vector_type(4)));
typedef float f32x2 __attribute__((ext_vector_type(2)));
typedef float f32x16 __attribute__((ext_vector_type(16)));
typedef unsigned u32x4 __attribute__((ext_vector_type(4)));
typedef unsigned u32x2 __attribute__((ext_vector_type(2)));
typedef int i32x4 __attribute__((ext_vector_type(4)));

constexpr int NB = 2, SEQ = 16384, T = NB * SEQ, D = 1024, NIN = 7168;
constexpr int NE = 64, TOPK = 8, ED = 256, NEX = NE + 1;
constexpr float EPS = 1e-6f;
constexpr float C2 = 0.125f * 1.4426950408889634f;
constexpr float QSC = 4.f, PBIAS = 60.f;
constexpr float LAMBDA_INIT = 0.2f;
constexpr int NWAVES = 8, NTHREADS = 512;

constexpr size_t MiB = 1u << 20;
constexpr size_t WS_CTL = 0, CTL_ZERO_BYTES = 64 * 1024;
constexpr size_t WS_MOD = 1 * MiB;
constexpr size_t WS_ROPE = 1 * MiB + 64 * 1024;
constexpr size_t WS_TKE = 3 * MiB + 256 * 1024;
constexpr size_t WS_TKR = 4 * MiB + 256 * 1024;
constexpr size_t WS_TKW = 5 * MiB + 256 * 1024;
constexpr size_t WS_POS = 6 * MiB + 256 * 1024;
constexpr size_t WS_CNT = 7 * MiB + 256 * 1024;
constexpr size_t WS_TE = WS_CNT + 64 * 1024;
constexpr size_t WS_META = WS_TE + 8 * 1024;
constexpr size_t WS_TOK = 7 * MiB + 512 * 1024;
constexpr size_t WS_WGT = 8 * MiB + 768 * 1024;
constexpr int RMAX = 262144 + 64 * 256 + T;
static_assert(WS_TOK + (size_t)RMAX * 4 <= WS_WGT && WS_WGT + (size_t)RMAX * 4 <= 10 * MiB, "small region");
constexpr size_t WS_WRH = 10 * MiB, WS_WRL = 10 * MiB + 128 * 1024;
constexpr size_t WS_WDN = 11 * MiB;
constexpr size_t WS_WIN = WS_WDN + (size_t)NEX * 1024 * 256 * 2 + MiB / 2;
constexpr size_t WS_WPW2 = WS_WIN + 14 * MiB, WS_WOUT = WS_WPW2 + 2 * MiB;
constexpr size_t WS_WGU = WS_WOUT + 2 * MiB;
constexpr size_t WS_U = 127 * MiB;
constexpr size_t WS_Q = WS_U + 64 * MiB, WS_K = WS_Q + 64 * MiB, WS_V = WS_K + 64 * MiB, WS_GC = WS_V + 64 * MiB, WS_GA = WS_GC + 64 * MiB;
constexpr size_t WS_END = WS_GA + 64 * MiB;
static_assert(WS_WGU + (size_t)NEX * 512 * 1024 * 2 <= WS_U && WS_END <= 512 * MiB, "ws map");
constexpr size_t WS_ACT = 359 * MiB;
constexpr size_t WS_Y = 44 * MiB;
static_assert(WS_ACT + (size_t)RMAX * 512 <= WS_END && WS_Y + (size_t)(262144 + 64 * 256) * 1024 <= WS_ACT && WS_Y >= WS_WDN + (size_t)NEX * 1024 * 256 * 2, "moe overlays");
constexpr int CW_BAR = 1024;

#ifndef DBG_A6
#define DBG_A6 WS_U
#endif
constexpr int RING_BYTES = 131072;
constexpr int LDS_BYTES = 163840;
constexpr int EPI_SCR = RING_BYTES;
constexpr int MISC_OFF = LDS_BYTES - 256;

#define LDS_WAIT() asm volatile("s_waitcnt lgkmcnt(0)" ::: "memory")
#define VM_WAIT() asm volatile("s_waitcnt vmcnt(0)" ::: "memory")
typedef __bf16 bf16x2_t __attribute__((ext_vector_type(2)));
__device__ __forceinline__ unsigned cvt_pk_bf16(float lo, float hi) { const f32x2 v = {lo, hi}; const bf16x2_t b = __builtin_convertvector(v, bf16x2_t); return __builtin_bit_cast(unsigned, b); }
__device__ __forceinline__ float bf_lo(unsigned u) { return __builtin_bit_cast(float, u << 16); }
__device__ __forceinline__ float bf_hi(unsigned u) { return __builtin_bit_cast(float, u & 0xffff0000u); }
__device__ __forceinline__ float sigmoidf_(float x) { return __builtin_amdgcn_rcpf(1.f + __expf(-x)); }
__device__ __forceinline__ float wave_sum(float v) {
#pragma unroll
    for (int o = 1; o < 64; o <<= 1) v += __shfl_xor(v, o);
    return v;
}
__device__ __forceinline__ float wave_max(float v) {
#pragma unroll
    for (int o = 1; o < 64; o <<= 1) v = fmaxf(v, __shfl_xor(v, o));
    return v;
}

namespace pg8 {
typedef int i32x8_t __attribute__((ext_vector_type(8)));
typedef int i32x4_t __attribute__((ext_vector_type(4)));
constexpr int BM = 256, BK = 64, HALF = 128, HTB = HALF * BK * 2, STAGE_BYTES = 8 * HTB, NXCD = 8, WGM = 8;
__host__ __device__ __forceinline__ int lds_byte(int r, int c) { const int st = (r >> 4) * 2 + (c >> 5), rr = r & 15, cc = c & 31, ob = rr * 64 + cc * 2; return st * 1024 + (ob ^ (((ob >> 9) & 1) << 5)); }
__host__ __device__ __forceinline__ void stage_rc(int b, int& R, int& C) { const int st = b / 1024, sb = b % 1024, swz = sb ^ (((sb >> 9) & 1) << 5); R = (st >> 1) * 16 + swz / 64; C = (st & 1) * 32 + (swz % 64) / 2; }
__host__ __device__ __forceinline__ int perm32(int rho) { const int n = rho >> 4, i = rho & 15; return 8 * (i >> 2) + 4 * n + (i & 3); }

struct Unit { int pm, pn; };
struct Gemm { const bf16* A; const bf16* Bt; int M, N, K; };

struct StaticOrder {
    int nM, nN, nwg, G, c;
    const int* tok;
    __host__ __device__ void init(int M, int N, int G_, int c_) { nM = M / BM; nN = N / BM; nwg = nM * nN; G = G_; c = c_; tok = nullptr; }
    __host__ __device__ bool next(int i, Unit& u) const {
        const long L = (long)i * G + c; if (L >= nwg) return false;
        int wgid = (int)L; { const int q = nwg / NXCD, r = nwg % NXCD, xcd = wgid % NXCD, off = wgid / NXCD; wgid = (xcd < r ? xcd * (q + 1) : r * (q + 1) + (xcd - r) * q) + off; }
        const int nig = WGM * nN, gid = wgid / nig, fm = gid * WGM, gsz = (nM - fm) < WGM ? (nM - fm) : WGM;
        u.pm = fm + ((wgid % nig) % gsz); u.pn = (wgid % nig) / gsz; return true;
    }
};

template <class Epi, class Sched, bool ALIGN_EPI, bool SP2, bool GATHER, bool FP8 = false>
__device__ __forceinline__ void gemm_phase(LAS unsigned char* lds, const Gemm g, const Sched& S, const Epi& E) {
    const int tid = threadIdx.x, wid = __builtin_amdgcn_readfirstlane(tid >> 6), lane = tid & 63, wr = wid >> 2, wc = wid & 3, fr = lane & 15, fq = lane >> 4;
    const int K = g.K, nt = K / BK;
    unsigned voffA[2], voffB[2]; int RA[2]; unsigned CA2[2];
#pragma unroll
    for (int i = 0; i < 2; ++i) { int R, C; stage_rc(tid * 16 + i * 8192, R, C); const int Rb = Epi::PERM ? ((R & ~31) + perm32(R & 31)) : R;
        voffA[i] = (unsigned)(R * K + C) * 2u; voffB[i] = (unsigned)(Rb * K + C) * 2u; RA[i] = R; CA2[i] = (unsigned)C * 2u; }
    const size_t kstep = (size_t)(BK * 2);
    const size_t hstep = (size_t)HALF * K * 2;
    const size_t tstep = 2 * hstep;
    const unsigned ldsw = (unsigned)wid * 1024u;
    const int aoff = lds_byte(wr * 64 + fr, fq * 8), boff = lds_byte(wc * 32 + fr, fq * 8);
#define PG8_SA(b, h) (((b) * 2 + (h)) * HTB)
#define PG8_SB(b, h) ((4 + (b) * 2 + (h)) * HTB)
#define PG8_STAGE2(bufoff, gbase, o0, o1) do { \
        __builtin_amdgcn_global_load_lds((const unsigned*)((const char*)(gbase) + (o0)), (LAS unsigned*)(lds + (bufoff) + ldsw), 16, 0, 0); \
        __builtin_amdgcn_global_load_lds((const unsigned*)((const char*)(gbase) + (o1)), (LAS unsigned*)(lds + (bufoff) + ldsw + 8192), 16, 0, 0); } while (0)
#define PG8_STAGEB(bufoff, gbase) PG8_STAGE2(bufoff, gbase, voffB[0], voffB[1])
#define PG8_STAGEA(bufoff, gbase, h, o0, o1) do { if constexpr (GATHER) { PG8_STAGE2(bufoff, gbase, o0, o1); } else { PG8_STAGE2(bufoff, (gbase) + (h) * hstep, voffA[0], voffA[1]); } } while (0)
#define PG8_LD8(p) __builtin_shufflevector(*(const LAS i32x4_t*)(p), *(const LAS i32x4_t*)((p) + 1024), 0, 1, 2, 3, 4, 5, 6, 7)
#define PG8_LDA(dst, b, h) do { if constexpr (FP8) { _Pragma("unroll") for (int m = 0; m < 4; ++m) dst##8[m] = PG8_LD8(lds + PG8_SA(b, h) + aoff + m * 2048); } \
        else { _Pragma("unroll") for (int m = 0; m < 4; ++m) _Pragma("unroll") for (int k = 0; k < 2; ++k) dst[m][k] = *(const LAS bf16x8*)(lds + PG8_SA(b, h) + aoff + m * 2048 + k * 1024); } } while (0)
#define PG8_LDB(dst, b, h) do { if constexpr (FP8) { _Pragma("unroll") for (int n = 0; n < 2; ++n) dst##8[n] = PG8_LD8(lds + PG8_SB(b, h) + boff + n * 2048); } \
        else { _Pragma("unroll") for (int n = 0; n < 2; ++n) _Pragma("unroll") for (int k = 0; k < 2; ++k) dst[n][k] = *(const LAS bf16x8*)(lds + PG8_SB(b, h) + boff + n * 2048 + k * 1024); } } while (0)
#define PG8_CAT(x) __builtin_shufflevector(__builtin_bit_cast(i32x4_t, (x)[0]), __builtin_bit_cast(i32x4_t, (x)[1]), 0, 1, 2, 3, 4, 5, 6, 7)
#define PG8_MMA(ai, bj, At, Bt) do { __builtin_amdgcn_s_setprio(1); \
        if constexpr (FP8) { _Pragma("unroll") for (int m = 0; m < 4; ++m) _Pragma("unroll") for (int n = 0; n < 2; ++n) \
            asm volatile("v_mfma_f32_16x16x128_f8f6f4 %0, %1, %2, %0" : "+v"(acc[ai][bj][m][n]) : "v"(Bt##8[n]), "v"(At##8[m])); }   \
        else { _Pragma("unroll") for (int m = 0; m < 4; ++m) _Pragma("unroll") for (int n = 0; n < 2; ++n) _Pragma("unroll") for (int k = 0; k < 2; ++k) \
            acc[ai][bj][m][n] = __builtin_amdgcn_mfma_f32_16x16x32_bf16(Bt[n][k], At[m][k], acc[ai][bj][m][n], 0, 0, 0); } \
        __builtin_amdgcn_s_setprio(0); } while (0)
#define PG8_WAIT_V(n) asm volatile("s_waitcnt vmcnt(" #n ")" ::: "memory")
#define PG8_WAIT_L(n) asm volatile("s_waitcnt lgkmcnt(" #n ")" ::: "memory")
#define PG8_BAR __builtin_amdgcn_s_barrier()
#define PG8_SCHED __builtin_amdgcn_sched_barrier(0)
#define PG8_SETA(o, u) do { _Pragma("unroll") for (int h_ = 0; h_ < 2; ++h_) _Pragma("unroll") for (int i_ = 0; i_ < 2; ++i_) { \
        if constexpr (GATHER) { int t_ = S.tok[(u).pm * 256 + h_ * 128 + RA[i_]]; t_ = t_ < 0 ? 0 : t_; o[h_][i_] = (unsigned)t_ * (unsigned)(K * 2) + CA2[i_]; } \
        else { o[h_][i_] = (unsigned)(h_ * hstep) + voffA[i_]; } } } while (0)
    Unit cur, nxt; int ui = 0;
    if (!S.next(0, cur)) return;
    f32x4 acc[2][2][4][2];
#pragma unroll
    for (int a = 0; a < 2; ++a)
#pragma unroll
        for (int b = 0; b < 2; ++b)
#pragma unroll
            for (int m = 0; m < 4; ++m)
#pragma unroll
                for (int n = 0; n < 2; ++n) acc[a][b][m][n] = (f32x4){0.f, 0.f, 0.f, 0.f};
    bf16x8 At[4][2], B0[2][2], B1[2][2];
    i32x8_t At8[4], B08[2], B18[2];
    unsigned cO[2][2], nO[2][2];
    if constexpr (GATHER) { PG8_SETA(cO, cur); VM_WAIT(); }
    else { cO[0][0] = cO[0][1] = cO[1][0] = cO[1][1] = 0u; }
    const char* cA = GATHER ? (const char*)g.A : (const char*)g.A + (size_t)cur.pm * tstep; const char* cB = (const char*)g.Bt + (size_t)cur.pn * tstep;
    if constexpr (SP2) {
        PG8_STAGEB(PG8_SB(0, 0), cB); PG8_STAGEB(PG8_SB(0, 1), cB + hstep); PG8_STAGEA(PG8_SA(0, 0), cA, 0, cO[0][0], cO[0][1]); PG8_STAGEA(PG8_SA(0, 1), cA, 1, cO[1][0], cO[1][1]);
        if (wr == 1) PG8_BAR;
        PG8_WAIT_V(2); PG8_BAR;
        PG8_STAGEB(PG8_SB(1, 0), cB + kstep); PG8_STAGEA(PG8_SA(1, 0), cA + kstep, 0, cO[0][0], cO[0][1]); PG8_STAGEB(PG8_SB(1, 1), cB + hstep + kstep);
        PG8_WAIT_V(6); PG8_BAR;
    }
    for (;;) {
        const bool has_next = S.next(ui + 1, nxt);
        if constexpr (!GATHER) { nO[0][0] = nO[0][1] = nO[1][0] = nO[1][1] = 0u; }
        else if (has_next) { PG8_SETA(nO, nxt); } else {
#pragma unroll
            for (int h_ = 0; h_ < 2; ++h_)
#pragma unroll
                for (int i_ = 0; i_ < 2; ++i_) nO[h_][i_] = cO[h_][i_]; }
        const char* nA = GATHER ? (const char*)g.A : (has_next ? (const char*)g.A + (size_t)nxt.pm * tstep : cA);
        const char* nB = has_next ? (const char*)g.Bt + (size_t)nxt.pn * tstep : cB;
#pragma nounroll
        for (int t = 0; t < nt; t += 2) {
            const bool last = (t == nt - 2);
            const char* a1 = cA + (size_t)(t + 1) * kstep;
            const char* a2 = last ? nA : cA + (size_t)(t + 2) * kstep; const char* b2 = last ? nB : cB + (size_t)(t + 2) * kstep;
            const char* a3 = a2 + kstep; const char* b3 = b2 + kstep;
            const unsigned x00 = last ? nO[0][0] : cO[0][0], x01 = last ? nO[0][1] : cO[0][1], x10 = last ? nO[1][0] : cO[1][0], x11 = last ? nO[1][1] : cO[1][1];
            PG8_LDB(B0, 0, 0); PG8_LDB(B1, 0, 1); PG8_SCHED; PG8_LDA(At, 0, 0); PG8_STAGEA(PG8_SA(1, 1), a1, 1, cO[1][0], cO[1][1]);
            PG8_WAIT_V(8); PG8_WAIT_L(0); PG8_BAR; PG8_MMA(0, 0, At, B0); PG8_MMA(0, 1, At, B1); PG8_BAR; PG8_SCHED;
            PG8_LDA(At, 0, 1); PG8_STAGEB(PG8_SB(0, 0), b2); PG8_STAGEB(PG8_SB(0, 1), b2 + hstep); PG8_STAGEA(PG8_SA(0, 0), a2, 0, x00, x01);
            PG8_WAIT_V(8); PG8_WAIT_L(0); PG8_BAR; PG8_MMA(1, 0, At, B0); PG8_MMA(1, 1, At, B1); PG8_BAR; PG8_SCHED;
            PG8_LDB(B0, 1, 0); PG8_LDB(B1, 1, 1); PG8_SCHED; PG8_LDA(At, 1, 0); PG8_STAGEA(PG8_SA(0, 1), a2, 1, x10, x11);
            PG8_WAIT_V(8); PG8_WAIT_L(0); PG8_BAR; PG8_MMA(0, 0, At, B0); PG8_MMA(0, 1, At, B1); PG8_BAR; PG8_SCHED;
            PG8_LDA(At, 1, 1); PG8_STAGEB(PG8_SB(1, 0), b3); PG8_STAGEB(PG8_SB(1, 1), b3 + hstep); PG8_STAGEA(PG8_SA(1, 0), a3, 0, x00, x01);
            PG8_WAIT_V(8); PG8_WAIT_L(0); PG8_BAR; PG8_MMA(1, 0, At, B0); PG8_MMA(1, 1, At, B1); PG8_BAR; PG8_SCHED;
        }
        if constexpr (ALIGN_EPI) { if (wr == 0) PG8_BAR; }
        if constexpr (FP8) asm volatile("s_nop 15\n\ts_nop 15" ::: "memory");
        E(acc, cur, wr, wc, fr, fq);
        if (!has_next) break;
#pragma unroll
        for (int a = 0; a < 2; ++a)
#pragma unroll
            for (int b = 0; b < 2; ++b)
#pragma unroll
                for (int m = 0; m < 4; ++m)
#pragma unroll
                    for (int n = 0; n < 2; ++n) acc[a][b][m][n] = (f32x4){0.f, 0.f, 0.f, 0.f};
        cur = nxt; cA = nA; cB = nB; ++ui;
#pragma unroll
        for (int h_ = 0; h_ < 2; ++h_)
#pragma unroll
            for (int i_ = 0; i_ < 2; ++i_) cO[h_][i_] = nO[h_][i_];
        if constexpr (ALIGN_EPI) { if (wr == 1) PG8_BAR; }
    }
    PG8_WAIT_V(0);
    if constexpr (!ALIGN_EPI) { if (wr == 0) PG8_BAR; }
    PG8_BAR;
#undef PG8_SA
#undef PG8_SB
#undef PG8_STAGE2
#undef PG8_STAGEB
#undef PG8_STAGEA
#undef PG8_LDA
#undef PG8_LD8
#undef PG8_LDB
#undef PG8_MMA
#undef PG8_CAT
#undef PG8_WAIT_V
#undef PG8_WAIT_L
#undef PG8_BAR
#undef PG8_SCHED
#undef PG8_SETA
}
}

#define XB_TMO      128
#define XB_XCNT(j)  (256  + 64 * (j))
#define XB_XSUB(j)  (1280 + 64 * (j))
#define XB_XGEN(j)  (2304 + 64 * (j))
#define XB_TOP      3328
#define XB_TOPGEN   3392
#define XCD_BAR_WORDS 3456
#define XB_SPIN_CAP (1u << 18)
__device__ __forceinline__ unsigned xb_ld(unsigned* p)              { return __hip_atomic_load(p, __ATOMIC_RELAXED, __HIP_MEMORY_SCOPE_AGENT); }
__device__ __forceinline__ unsigned xb_add(unsigned* p, unsigned v) { return __hip_atomic_fetch_add(p, v, __ATOMIC_RELAXED, __HIP_MEMORY_SCOPE_AGENT); }
__device__ __forceinline__ unsigned xb_xcc_id() { return (unsigned)__builtin_amdgcn_s_getreg((3 << 11) | 20) & 0xFu; }
#define XB_SPIN(cond, bar) do { unsigned _sp = 0; while (cond) { __builtin_amdgcn_s_sleep(1); \
    if ((++_sp & 255u) == 0u) { if (xb_ld(&(bar)[XB_TMO])) break; if (_sp > XB_SPIN_CAP) { atomicAdd(&(bar)[XB_TMO], 1u); break; } } } } while (0)
struct XcdBarrier { unsigned* bar; unsigned x; volatile LAS unsigned* st; };
__device__ __forceinline__ XcdBarrier xcd_barrier_post(unsigned* bar, volatile LAS unsigned* st) {
    XcdBarrier b; b.bar = bar; b.x = xb_xcc_id(); b.st = st;
    if (threadIdx.x == 0) (void)xb_add(&bar[XB_XCNT(b.x)], 1u);
    return b;
}
__device__ __forceinline__ void xcd_barrier_complete(unsigned* bar, unsigned x, unsigned& nloc, unsigned& nx) {
    const unsigned G = gridDim.x * gridDim.y * gridDim.z;
    unsigned sum, cnt, mine, sp = 0u;
    for (;;) {
        sum = 0u; cnt = 0u; mine = 0u;
#pragma unroll
        for (unsigned j = 0; j < 16; ++j) { const unsigned c = xb_ld(&bar[XB_XCNT(j)]); sum += c; cnt += (c > 0u) ? 1u : 0u; mine = (j == x) ? c : mine; }
        if (sum == G) break;
        __builtin_amdgcn_s_sleep(1);
        if ((++sp & 255u) == 0u) { if (xb_ld(&bar[XB_TMO])) break; if (sp > XB_SPIN_CAP) { atomicAdd(&bar[XB_TMO], 1u); break; } }
    }
    nloc = mine > 0u ? mine : 1u; nx = cnt > 0u ? cnt : 1u;
}
__device__ __forceinline__ void xcd_barrier(const XcdBarrier& b) {
    asm volatile("s_waitcnt vmcnt(0)" ::: "memory");
    __syncthreads();
    if (threadIdx.x == 0) {
        unsigned* bar = b.bar;
        __builtin_amdgcn_s_waitcnt(0);
        unsigned nloc = b.st[0], nx = b.st[1];
        if (nloc == 0u) { xcd_barrier_complete(bar, b.x, nloc, nx); b.st[0] = nloc; b.st[1] = nx; }
        const unsigned old = xb_add(&bar[XB_XSUB(b.x)], 1u);
        const unsigned gen = old / nloc;
        if (old + 1u == (gen + 1u) * nloc) {
            __builtin_amdgcn_fence(__ATOMIC_RELEASE, "agent");
            asm volatile("s_waitcnt vmcnt(0)" ::: "memory");
            const unsigned og = xb_add(&bar[XB_TOP], 1u);
            const unsigned tg = og / nx;
            if (og + 1u == (tg + 1u) * nx) xb_add(&bar[XB_TOPGEN], 1u);
            else XB_SPIN(xb_ld(&bar[XB_TOPGEN]) == tg, bar);
            __builtin_amdgcn_fence(__ATOMIC_ACQUIRE, "agent");
            xb_add(&bar[XB_XGEN(b.x)], 1u);
            asm volatile("s_waitcnt vmcnt(0)" ::: "memory");
        } else {
            XB_SPIN(xb_ld(&bar[XB_XGEN(b.x)]) == gen, bar);
            __builtin_amdgcn_fence(__ATOMIC_ACQUIRE, "agent");
            asm volatile("s_waitcnt vmcnt(0)" ::: "memory");
        }
    }
    __syncthreads();
}

struct Args { const void* in[28]; float* out; unsigned char* ws; int ph_lo, ph_hi; };
struct Frame {
    LAS unsigned char* lds;
    int tid, lane, wave, vcu, G;
    unsigned char* ws; float* out;
    const __attribute__((address_space(4))) unsigned char* ka;
    __device__ __forceinline__ const float* in(int i) const { return ((const float* const __attribute__((address_space(4)))*)ka)[i]; }
};
enum { I_X = 0, I_C, I_POS, I_WADA, I_BADA, I_N1G, I_WIN, I_CDW, I_CDWB, I_CLNG, I_CLNB, I_WPW2, I_BPW2, I_QNG, I_KNG, I_LQ1, I_LK1, I_LQ2, I_LK2, I_SUBG, I_WOUT, I_N2G, I_WR, I_RB, I_WEGU, I_WEDN, I_WSGU, I_WSDN };

__device__ __forceinline__ int win_map(int n) {
    if (n < 1024) return 256 * (n >> 7) + (n & 127);
    if (n < 2048) { const int j = n - 1024; return 256 * (j >> 7) + 128 + (j & 127); }
    if (n < 4096) { const int qk = (n - 2048) >> 10, j = (n - 2048) & 1023, g = j >> 6, dl = j & 63; const int tile = 8 + 4 * qk + (g >> 2), wc = g & 3;
        int bj, fq, e; if (dl < 8) { bj = 0; fq = 0; e = dl; } else if (dl < 16) { bj = 1; fq = 0; e = dl - 8; } else { const int rho = dl - 16; bj = rho / 24; fq = 1 + (rho % 24) / 8; e = rho & 7; }
        return 256 * tile + 128 * bj + 32 * wc + 8 * fq + e; }
    return n;
}
__device__ __forceinline__ int glu_map(int n) { const int j = n & 255; return 256 * (j >> 7) + ((n >> 8) << 7) + (j & 127); }
__device__ __forceinline__ int qk_dim(int bj, int fq, int e) { return fq == 0 ? bj * 8 + e : 16 + bj * 24 + (fq - 1) * 8 + e; }

template <int MAP>
__device__ __forceinline__ void transpose_item(const float* W, int K, int N, bf16* WT, LAS float* scr, int item, int lane) {
    const int nblk = N / 32, kb = item / nblk, nb = item % nblk, k0 = 64 * kb, n0 = 32 * nb;
    {
        const int rr = lane >> 3, c4 = (lane & 7) * 4; f32x4 t[8];
#pragma unroll
        for (int i = 0; i < 8; ++i) t[i] = __builtin_nontemporal_load((const f32x4*)(W + (size_t)(k0 + 8 * i + rr) * N + n0 + c4));
#pragma unroll
        for (int i = 0; i < 8; ++i) { LAS float* d = scr + (8 * i + rr) * 33 + c4; d[0] = t[i].x; d[1] = t[i].y; d[2] = t[i].z; d[3] = t[i].w; }
    }
    LDS_WAIT(); asm volatile("" ::: "memory");
    const int c = lane & 7;
#pragma unroll
    for (int j = 0; j < 4; ++j) { const int n = (lane >> 3) + 8 * j; const LAS float* s = scr + (8 * c) * 33 + n;
        u32x4 o; o.x = cvt_pk_bf16(s[0 * 33], s[1 * 33]); o.y = cvt_pk_bf16(s[2 * 33], s[3 * 33]); o.z = cvt_pk_bf16(s[4 * 33], s[5 * 33]); o.w = cvt_pk_bf16(s[6 * 33], s[7 * 33]);
        const int nn = n0 + n; const int row = MAP == 1 ? win_map(nn) : (MAP == 2 ? glu_map(nn) : nn);
        *(u32x4*)(WT + (size_t)row * K + k0 + 8 * c) = o; }
    LDS_WAIT(); asm volatile("" ::: "memory");
}

constexpr float WDN_SCALE = 16.f, ACT_SCALE = 8.f;
constexpr float WIN_SCALE = 32.f;
template <int MAP>
__device__ __forceinline__ void transpose_item8(const float* W, int K, int N, unsigned char* WT, LAS float* scr, int item, int lane, float scale = WIN_SCALE) {
    const int nblk = N / 32, kb = item / nblk, nb = item % nblk, k0 = 64 * kb, n0 = 32 * nb;
    {
        const int rr = lane >> 3, c4 = (lane & 7) * 4; f32x4 t[8];
#pragma unroll
        for (int i = 0; i < 8; ++i) t[i] = __builtin_nontemporal_load((const f32x4*)(W + (size_t)(k0 + 8 * i + rr) * N + n0 + c4));
#pragma unroll
        for (int i = 0; i < 8; ++i) { LAS float* d = scr + (8 * i + rr) * 33 + c4; d[0] = t[i].x * scale; d[1] = t[i].y * scale; d[2] = t[i].z * scale; d[3] = t[i].w * scale; }
    }
    LDS_WAIT(); asm volatile("" ::: "memory");
    const int c = lane & 7;
#pragma unroll
    for (int j = 0; j < 4; ++j) { const int n = (lane >> 3) + 8 * j; const LAS float* sp = scr + (8 * c) * 33 + n;
        int d0 = 0, d1 = 0;
        d0 = __builtin_amdgcn_cvt_pk_fp8_f32(sp[0 * 33], sp[1 * 33], d0, false); d0 = __builtin_amdgcn_cvt_pk_fp8_f32(sp[2 * 33], sp[3 * 33], d0, true);
        d1 = __builtin_amdgcn_cvt_pk_fp8_f32(sp[4 * 33], sp[5 * 33], d1, false); d1 = __builtin_amdgcn_cvt_pk_fp8_f32(sp[6 * 33], sp[7 * 33], d1, true);
        const int nn = n0 + n; const int row = MAP == 1 ? win_map(nn) : (MAP == 2 ? glu_map(nn) : nn);
        *(u32x2*)(WT + (size_t)row * K + k0 + 8 * c) = (u32x2){(unsigned)d0, (unsigned)d1}; }
    LDS_WAIT(); asm volatile("" ::: "memory");
}
__device__ __forceinline__ void phase0(Frame& F) {
    if (F.vcu < 96) {
        const int col = F.vcu * 64 + F.lane; const float* c = F.in(I_C); const float* wa = F.in(I_WADA);
        float a0 = 0.f, a1 = 0.f;
        for (int k = F.wave * 128; k < F.wave * 128 + 128; ++k) { const float c0 = c[k], c1 = c[1024 + k]; const float s0 = c0 * sigmoidf_(c0), s1 = c1 * sigmoidf_(c1); const float w = wa[(size_t)k * 6144 + col]; a0 += s0 * w; a1 += s1 * w; }
        LAS float* red = (LAS float*)F.lds;
        red[(F.wave * 2 + 0) * 64 + F.lane] = a0; red[(F.wave * 2 + 1) * 64 + F.lane] = a1;
        __syncthreads();
        if (F.wave == 0) { float s0 = 0.f, s1 = 0.f;
#pragma unroll
            for (int w = 0; w < 8; ++w) { s0 += red[(w * 2 + 0) * 64 + F.lane]; s1 += red[(w * 2 + 1) * 64 + F.lane]; }
            float* mod = (float*)(F.ws + WS_MOD); const float bb = F.in(I_BADA)[col]; mod[col] = s0 + bb; mod[6144 + col] = s1 + bb; }
        __syncthreads();
    }
    LAS float* scr = (LAS float*)(F.lds + F.wave * 16384);
    const int gw = F.vcu * NWAVES + F.wave, NGW = F.G * NWAVES;
    constexpr int I_IN = 16 * (NIN / 32), I_SQ = 16 * 32, I_EGU = 16 * 16, I_EDN = 4 * 32;
    constexpr int NITEMS = I_IN + 2 * I_SQ + NEX * I_EGU + NEX * I_EDN;
    for (int it = gw; it < NITEMS; it += NGW) {
        int r = it;
        if (r < I_IN) { transpose_item8<1>(F.in(I_WIN), 1024, NIN, (unsigned char*)(F.ws + WS_WIN), scr, r, F.lane); continue; } r -= I_IN;
        if (r < I_SQ) { transpose_item8<0>(F.in(I_WPW2), 1024, 1024, (unsigned char*)(F.ws + WS_WPW2), scr, r, F.lane); continue; } r -= I_SQ;
        if (r < I_SQ) { transpose_item<0>(F.in(I_WOUT), 1024, 1024, (bf16*)(F.ws + WS_WOUT), scr, r, F.lane); continue; } r -= I_SQ;
        if (r < NEX * I_EGU) { const int e = r / I_EGU, rr = r % I_EGU; const float* W = e < NE ? F.in(I_WEGU) + (size_t)e * 1024 * 512 : F.in(I_WSGU);
            transpose_item8<2>(W, 1024, 512, (unsigned char*)(F.ws + WS_WGU) + (size_t)e * 512 * 1024, scr, rr, F.lane); continue; } r -= NEX * I_EGU;
        { const int e = r / I_EDN, rr = r % I_EDN; const float* W = e < NE ? F.in(I_WEDN) + (size_t)e * 256 * 1024 : F.in(I_WSDN);
            transpose_item8<0>(W, 256, 1024, (unsigned char*)(F.ws + WS_WDN) + (size_t)e * 1024 * 256, scr, rr, F.lane, WDN_SCALE); }
    }
    {
        const float* wr = F.in(I_WR); bf16* wh = (bf16*)(F.ws + WS_WRH); bf16* wl = (bf16*)(F.ws + WS_WRL);
        for (int idx = F.vcu * NTHREADS + F.tid; idx < 64 * 1024; idx += F.G * NTHREADS) { const int e = idx >> 10, k = idx & 1023; const float w = wr[k * 64 + e];
            const unsigned h = cvt_pk_bf16(w, 0.f) & 0xffffu; const float r = w - bf_lo(h); wh[idx] = (bf16)h; wl[idx] = (bf16)(cvt_pk_bf16(r, 0.f) & 0xffffu); }
    }
    {
        const int* pos = (const int*)F.in(I_POS); float* rope = (float*)(F.ws + WS_ROPE);
        for (int idx = F.vcu * NTHREADS + F.tid; idx < T * 8; idx += F.G * NTHREADS) {
            const int tok = idx >> 3, i = idx & 7;
            const unsigned fb = i == 0 ? 1065353216u : i == 1 ? 1044812719u : i == 2 ? 1025116360u : i == 3 ? 1005516622u : i == 4 ? 985226530u : i == 5 ? 965724408u : i == 6 ? 945754309u : 925697960u;
            const float ang = (float)pos[tok] * __builtin_bit_cast(float, fb);
            double rv = (double)ang * 0.15915494309189535; rv -= floor(rv);
            const float fr_ = (float)rv;
            rope[tok * 16 + i] = __builtin_amdgcn_cosf(fr_); rope[tok * 16 + 8 + i] = __builtin_amdgcn_sinf(fr_);
        }
    }
}

__device__ __forceinline__ void phase1(Frame& F) {
    const float* mod = (const float*)(F.ws + WS_MOD); const float* gn = F.in(I_N1G); unsigned char* H = (unsigned char*)F.out;
    const int gw = F.vcu * NWAVES + F.wave, NGW = F.G * NWAVES, lane = F.lane;
    const float* X = F.in(I_X);
    f32x4 gg[4], sh[4]; int bcur = -1;
    f32x4 va[4][4], vb[4][4];
#define P1_LOAD(V, k_) do { _Pragma("unroll") for (int u = 0; u < 4; ++u) { const int m = gw + ((k_) + u) * NGW; if (m < T) { const f32x4* xr = (const f32x4*)(X + (size_t)m * D) + lane; \
            _Pragma("unroll") for (int j = 0; j < 4; ++j) V[u][j] = xr[64 * j]; } } } while (0)
#define P1_PROC(V, k_) do { _Pragma("unroll") for (int u = 0; u < 4; ++u) { const int m = gw + ((k_) + u) * NGW; if (m < T) { const int b = m >> 14; \
            if (b != bcur) { bcur = b; _Pragma("unroll") for (int j = 0; j < 4; ++j) { const int col = 4 * lane + 256 * j; \
                const f32x4 g = *(const f32x4*)(gn + col), sc = *(const f32x4*)(mod + b * 6144 + 1024 + col); gg[j] = g * (sc + 1.f); sh[j] = *(const f32x4*)(mod + b * 6144 + col); } } \
            float s = 0.f; _Pragma("unroll") for (int j = 0; j < 4; ++j) s += (V[u][j].x * V[u][j].x + V[u][j].y * V[u][j].y) + (V[u][j].z * V[u][j].z + V[u][j].w * V[u][j].w); \
            const float rstd = __builtin_amdgcn_rsqf(wave_sum(s) * (1.f / D) + EPS); \
            unsigned* o4 = (unsigned*)(H + (size_t)m * D) + lane;            \
            _Pragma("unroll") for (int j = 0; j < 4; ++j) { const f32x4 y = V[u][j] * rstd * gg[j] + sh[j]; \
                int w = 0; w = __builtin_amdgcn_cvt_pk_fp8_f32(y.x, y.y, w, false); w = __builtin_amdgcn_cvt_pk_fp8_f32(y.z, y.w, w, true); o4[64 * j] = (unsigned)w; } } } } while (0)
    P1_LOAD(va, 0);
    for (int k = 0; gw + k * NGW < T; k += 8) {
        P1_LOAD(vb, k + 4);
        P1_PROC(va, k);
        P1_LOAD(va, k + 8);
        P1_PROC(vb, k + 4);
    }
#undef P1_LOAD
#undef P1_PROC
}

struct EpiIn {
    static constexpr bool PERM = true;
    static constexpr float SI = 1.f / WIN_SCALE;
    bf16 *U, *Q, *Kb, *V, *GC, *GA; const float* rope; const float* qg; const float* kg; LAS unsigned char* scr;
    __device__ __forceinline__ void operator()(const f32x4 (&acc)[2][2][4][2], const pg8::Unit& u, int wr, int wc, int fr, int fq) const {
        asm volatile("" : "+v"(fr), "+v"(fq));
        const int pn = u.pn, row0 = u.pm * 256 + wr * 64 + fr;
        if (pn < 8) {
#pragma unroll
            for (int ai = 0; ai < 2; ++ai)
#pragma unroll
                for (int m = 0; m < 4; ++m) { const int row = row0 + ai * 128 + m * 16; float r[8];
#pragma unroll
                    for (int n = 0; n < 2; ++n)
#pragma unroll
                        for (int i = 0; i < 4; ++i) r[4 * n + i] = (acc[ai][0][m][n][i] * SI) * sigmoidf_(acc[ai][1][m][n][i] * SI);
                    u32x4 w; w.x = cvt_pk_bf16(r[0], r[1]); w.y = cvt_pk_bf16(r[2], r[3]); w.z = cvt_pk_bf16(r[4], r[5]); w.w = cvt_pk_bf16(r[6], r[7]);
                    *(u32x4*)(U + (size_t)row * D + pn * 128 + wc * 32 + fq * 8) = w; }
        } else if (pn < 16) {
            const bool isq = pn < 12; const int g = 4 * ((pn - 8) & 3) + wc, h = g >> 1, mp = g & 1;
            const float* gp = isq ? qg : kg; float gn[2][8];
#pragma unroll
            for (int bj = 0; bj < 2; ++bj)
#pragma unroll
                for (int e = 0; e < 8; ++e) gn[bj][e] = gp[qk_dim(bj, fq, e)] * (isq ? C2 * QSC : 1.f);
            bf16* dst = isq ? Q : Kb;
#pragma unroll
            for (int ai = 0; ai < 2; ++ai)
#pragma unroll
                for (int m = 0; m < 4; ++m) { const int row = row0 + ai * 128 + m * 16, b = row >> 14, s = row & (SEQ - 1);
                    float v[2][8]; float ss = 0.f;
#pragma unroll
                    for (int bj = 0; bj < 2; ++bj)
#pragma unroll
                        for (int n = 0; n < 2; ++n)
#pragma unroll
                            for (int i = 0; i < 4; ++i) { const float t = acc[ai][bj][m][n][i] * SI; v[bj][4 * n + i] = t; ss += t * t; }
                    ss += __shfl_xor(ss, 16); ss += __shfl_xor(ss, 32);
                    const float rstd = __builtin_amdgcn_rsqf(ss * (1.f / 64.f) + EPS);
#pragma unroll
                    for (int bj = 0; bj < 2; ++bj)
#pragma unroll
                        for (int e = 0; e < 8; ++e) v[bj][e] = v[bj][e] * rstd * gn[bj][e];
                    if (fq == 0) { const f32x4* rp = (const f32x4*)(rope + (size_t)row * 16); const f32x4 c0 = rp[0], c1 = rp[1], s0 = rp[2], s1 = rp[3];
#pragma unroll
                        for (int e = 0; e < 8; ++e) { const float cs = e < 4 ? c0[e & 3] : c1[e & 3], sn = e < 4 ? s0[e & 3] : s1[e & 3]; const float x1 = v[0][e], x2 = v[1][e];
                            v[0][e] = x1 * cs - x2 * sn; v[1][e] = x2 * cs + x1 * sn; } }
                    unsigned char* rowp = (unsigned char*)dst + ((size_t)((b * 8 + h) * 2 + mp) * SEQ + s) * 64;
                    const int sw = isq ? 0 : ((s >> 2) & 3);
                    u32x4 w;
                    { int d;
                      d = 0; d = __builtin_amdgcn_cvt_pk_fp8_f32(v[0][0], v[0][1], d, false); d = __builtin_amdgcn_cvt_pk_fp8_f32(v[0][2], v[0][3], d, true); w.x = (unsigned)d;
                      d = 0; d = __builtin_amdgcn_cvt_pk_fp8_f32(v[0][4], v[0][5], d, false); d = __builtin_amdgcn_cvt_pk_fp8_f32(v[0][6], v[0][7], d, true); w.y = (unsigned)d;
                      d = 0; d = __builtin_amdgcn_cvt_pk_fp8_f32(v[1][0], v[1][1], d, false); d = __builtin_amdgcn_cvt_pk_fp8_f32(v[1][2], v[1][3], d, true); w.z = (unsigned)d;
                      d = 0; d = __builtin_amdgcn_cvt_pk_fp8_f32(v[1][4], v[1][5], d, false); d = __builtin_amdgcn_cvt_pk_fp8_f32(v[1][6], v[1][7], d, true); w.w = (unsigned)d; }
                    *(u32x4*)(rowp + ((fq ^ sw) << 4)) = w; }
        } else if (pn < 20) {
            LAS unsigned char* wsb = scr + (wr * 4 + wc) * 2048; const int lane_ = fr + 16 * fq;
#pragma unroll
            for (int ai = 0; ai < 2; ++ai)
#pragma unroll
                for (int bj = 0; bj < 2; ++bj) {
#pragma unroll
                    for (int m = 0; m < 4; ++m) { const int kk = 16 * m + fr;
                        const int p = 32 * ((kk >> 2) & 1) + 16 * (kk >> 5) + (kk & 3) + 4 * ((kk & 31) >> 3);
#pragma unroll
                        for (int n = 0; n < 2; ++n) { const unsigned d01 = (unsigned)__builtin_amdgcn_cvt_pk_fp8_f32(acc[ai][bj][m][n][0] * SI, acc[ai][bj][m][n][1] * SI, 0, false);
                            const unsigned d23 = (unsigned)__builtin_amdgcn_cvt_pk_fp8_f32(acc[ai][bj][m][n][2] * SI, acc[ai][bj][m][n][3] * SI, 0, false);
#pragma unroll
                            for (int i = 0; i < 4; ++i) { const int e = 4 * n + i; const unsigned byte = ((i < 2 ? d01 : d23) >> (8 * (i & 1)));
                                const int sw = (2 * fq + (e >> 2)) & 3;
                                wsb[(fq * 8 + e) * 64 + ((((p >> 4) ^ sw) << 4) | (p & 15))] = (unsigned char)byte; } } }
                    LDS_WAIT(); asm volatile("" ::: "memory");
                    const u32x4 t0 = *(const LAS u32x4*)(wsb + lane_ * 32), t1 = *(const LAS u32x4*)(wsb + lane_ * 32 + 16);
                    const int row = u.pm * 256 + ai * 128 + wr * 64, b = row >> 14, s = row & (SEQ - 1), h = 2 * (pn - 16) + bj;
                    unsigned char* tp = (unsigned char*)V + (((size_t)(b * 8 + h) * 256 + (s >> 6)) * 128 + wc * 32) * 64 + lane_ * 32;
                    *(u32x4*)tp = t0; *(u32x4*)(tp + 16) = t1;
                    LDS_WAIT(); asm volatile("" ::: "memory"); }
        } else {
            bf16* dst = pn < 24 ? GC : GA; const int colt = ((pn - 20) & 3) * 256;
#pragma unroll
            for (int ai = 0; ai < 2; ++ai)
#pragma unroll
                for (int m = 0; m < 4; ++m) { const int row = row0 + ai * 128 + m * 16;
#pragma unroll
                    for (int bj = 0; bj < 2; ++bj) { float r[8];
#pragma unroll
                        for (int n = 0; n < 2; ++n)
#pragma unroll
                            for (int i = 0; i < 4; ++i) r[4 * n + i] = sigmoidf_(acc[ai][bj][m][n][i] * SI);
                        u32x4 w; w.x = cvt_pk_bf16(r[0], r[1]); w.y = cvt_pk_bf16(r[2], r[3]); w.z = cvt_pk_bf16(r[4], r[5]); w.w = cvt_pk_bf16(r[6], r[7]);
                        *(u32x4*)(dst + (size_t)row * D + colt + bj * 128 + wc * 32 + fq * 8) = w; } }
        }
    }
};

__device__ __forceinline__ void phase3(Frame& F) {
    const bf16* U = (const bf16*)(F.ws + WS_U); bf16* CV = (bf16*)F.out;
    const int ch = 2 * F.tid;
    float wa[31], wb[31];
#pragma unroll
    for (int j = 0; j < 31; ++j) { const f32x2 w = *(const f32x2*)(F.in(I_CDW) + j * 1024 + ch); wa[j] = w.x; wb[j] = w.y; }
    const f32x2 cb = *(const f32x2*)(F.in(I_CDWB) + ch);
    LAS float* tile = (LAS float*)F.lds;
    for (int unit = F.vcu; unit < T / 64; unit += F.G) {
        const int t0 = unit * 64, s0 = t0 & (SEQ - 1);
        float xa[38], xb[38];
#pragma unroll
        for (int k = 0; k < 30; ++k) { unsigned v = 0u; if (s0 - 30 + k >= 0) v = *(const unsigned*)(U + (size_t)(t0 - 30 + k) * D + ch); xa[k] = bf_lo(v); xb[k] = bf_hi(v); }
        for (int blk = 0; blk < 8; ++blk) {
#pragma unroll
            for (int k = 0; k < 8; ++k) { const unsigned v = *(const unsigned*)(U + (size_t)(t0 + blk * 8 + k) * D + ch); xa[30 + k] = bf_lo(v); xb[30 + k] = bf_hi(v); }
            LAS float* tl = tile + (blk & 1) * 8192;
#pragma unroll
            for (int i = 0; i < 8; ++i) { float a = cb.x, b = cb.y;
#pragma unroll
                for (int j = 0; j < 31; ++j) { a += xa[i + j] * wa[j]; b += xb[i + j] * wb[j]; }
                *(LAS f32x2*)(tl + i * 1024 + ch) = (f32x2){a, b}; }
#pragma unroll
            for (int k = 0; k < 30; ++k) { xa[k] = xa[k + 8]; xb[k] = xb[k + 8]; }
            __syncthreads();
            {
                const LAS float* rowp = tl + F.wave * 1024;
                f32x4 v[4];
#pragma unroll
                for (int jj = 0; jj < 2; ++jj) { v[2 * jj] = *(const LAS f32x4*)(rowp + 512 * jj + 8 * F.lane); v[2 * jj + 1] = *(const LAS f32x4*)(rowp + 512 * jj + 8 * F.lane + 4); }
                float s = 0.f;
#pragma unroll
                for (int q = 0; q < 4; ++q) s += (v[q].x + v[q].y) + (v[q].z + v[q].w);
                const float mean = wave_sum(s) * (1.f / D); float s2 = 0.f;
#pragma unroll
                for (int q = 0; q < 4; ++q) { v[q] = v[q] - mean; s2 += (v[q].x * v[q].x + v[q].y * v[q].y) + (v[q].z * v[q].z + v[q].w * v[q].w); }
                const float rstd = __builtin_amdgcn_rsqf(wave_sum(s2) * (1.f / D) + EPS);
                bf16* op = (bf16*)((unsigned char*)CV + (size_t)(t0 + blk * 8 + F.wave) * D);
#pragma unroll
                for (int jj = 0; jj < 2; ++jj) { const int col = 512 * jj + 8 * F.lane; float r[8];
#pragma unroll
                    for (int q = 0; q < 2; ++q) { const f32x4 g = *(const f32x4*)(F.in(I_CLNG) + col + 4 * q), bb = *(const f32x4*)(F.in(I_CLNB) + col + 4 * q); const f32x4 y = v[2 * jj + q] * rstd * g + bb;
#pragma unroll
                        for (int i = 0; i < 4; ++i) r[4 * q + i] = y[i] * sigmoidf_(y[i]); }
                    int d0 = 0, d1 = 0;
                    d0 = __builtin_amdgcn_cvt_pk_fp8_f32(r[0], r[1], d0, false); d0 = __builtin_amdgcn_cvt_pk_fp8_f32(r[2], r[3], d0, true);
                    d1 = __builtin_amdgcn_cvt_pk_fp8_f32(r[4], r[5], d1, false); d1 = __builtin_amdgcn_cvt_pk_fp8_f32(r[6], r[7], d1, true);
                    *(u32x2*)((unsigned char*)op + col) = (u32x2){(unsigned)d0, (unsigned)d1}; }
            }
        }
        __syncthreads();
    }
}

struct EpiPw2 {
    static constexpr bool PERM = true;
    bf16* O; const bf16* GC; const float* bias;
    __device__ __forceinline__ void operator()(const f32x4 (&acc)[2][2][4][2], const pg8::Unit& u, int wr, int wc, int fr, int fq) const {
        const int row0 = u.pm * 256 + wr * 64 + fr, col0 = u.pn * 256 + wc * 32 + fq * 8;
#pragma unroll
        for (int ai = 0; ai < 2; ++ai)
#pragma unroll
            for (int m = 0; m < 4; ++m) { const int row = row0 + ai * 128 + m * 16;
#pragma unroll
                for (int bj = 0; bj < 2; ++bj) { const int col = col0 + bj * 128; const u32x4 gv = *(const u32x4*)(GC + (size_t)row * D + col);
                    const f32x4 b0 = *(const f32x4*)(bias + col), b1 = *(const f32x4*)(bias + col + 4); float r[8];
#pragma unroll
                    for (int i = 0; i < 4; ++i) { r[i] = acc[ai][bj][m][0][i] * (1.f / WIN_SCALE) + b0[i]; r[4 + i] = acc[ai][bj][m][1][i] * (1.f / WIN_SCALE) + b1[i]; }
                    r[0] *= bf_lo(gv.x); r[1] *= bf_hi(gv.x); r[2] *= bf_lo(gv.y); r[3] *= bf_hi(gv.y); r[4] *= bf_lo(gv.z); r[5] *= bf_hi(gv.z); r[6] *= bf_lo(gv.w); r[7] *= bf_hi(gv.w);
                    u32x4 w; w.x = cvt_pk_bf16(r[0], r[1]); w.y = cvt_pk_bf16(r[2], r[3]); w.z = cvt_pk_bf16(r[4], r[5]); w.w = cvt_pk_bf16(r[6], r[7]);
                    *(u32x4*)(O + (size_t)row * D + col) = w; } }
    }
};

namespace att {
constexpr int SLOT = 32768, NSLOT = 3, XOFF = NSLOT * SLOT;
typedef int i32x8 __attribute__((ext_vector_type(8)));
__device__ __forceinline__ int crow(int r, int hi) { return (r & 3) + 8 * (r >> 2) + 4 * hi; }
__device__ __forceinline__ s16x4 vtr(const LAS char* p) { typedef short v4i16_t __attribute__((ext_vector_type(4))); return __builtin_bit_cast(s16x4, __builtin_amdgcn_ds_read_tr16_b64_v4i16((LAS v4i16_t*)p)); }
#define BUF_DMA16(m0v, voff, srd, soff) asm volatile("s_mov_b32 m0, %0\n\ts_nop 0\n\tbuffer_load_dwordx4 %1, %2, %3 offen lds" :: "s"(m0v), "v"(voff), "s"(srd), "s"(soff) : "m0", "memory")
#define ATT_SB() __builtin_amdgcn_sched_barrier(0)
#ifndef VLA
#define VLA 4
#endif
struct DmaSet { unsigned m0[2], so[2]; };
__device__ __forceinline__ f32x16 zacc() { return (f32x16){0.f, 0.f, 0.f, 0.f, 0.f, 0.f, 0.f, 0.f, 0.f, 0.f, 0.f, 0.f, 0.f, 0.f, 0.f, 0.f}; }
__device__ __forceinline__ f32x16 mfma8(i32x8 a, i32x8 b, f32x16 c) { return __builtin_amdgcn_mfma_scale_f32_32x32x64_f8f6f4(a, b, c, 0, 0, 0, 0, 0, 0); }
#define ATT_KFRAG(kp, blk) ({ const u32x4 lo_ = *(const LAS u32x4*)((kp) + (blk) * 2048 + kc0), hi_ = *(const LAS u32x4*)((kp) + (blk) * 2048 + kc1); \
        (i32x8){(int)lo_.x, (int)lo_.y, (int)lo_.z, (int)lo_.w, (int)hi_.x, (int)hi_.y, (int)hi_.z, (int)hi_.w}; })
template <bool MASK>
__device__ __forceinline__ void shift_mask(f32x16& c0, f32x16& c1, int kb, int qrow, float negM, bool shift) {
    if (shift) {
#pragma unroll
        for (int r = 0; r < 16; ++r) { c0[r] += negM; c1[r] += negM; } }
    if (MASK) {
#pragma unroll
        for (int r = 0; r < 16; ++r) { const int kv = kb + (r & 3) + 8 * (r >> 2); if (kv > qrow) c0[r] = -INFINITY; if (kv + 32 > qrow) c1[r] = -INFINITY; } }
}
#define ATT_VFRAG(dst, i) do { const s16x4 lo_ = vtr(vp + ((i) & 3) * 4096 + ((i) >> 2) * 1024), hh_ = vtr(vp + ((i) & 3) * 4096 + ((i) >> 2) * 1024 + 512); \
        dst = (bf16x8){lo_[0], lo_[1], lo_[2], lo_[3], hh_[0], hh_[1], hh_[2], hh_[3]}; } while (0)
__device__ __forceinline__ int exp2_bf8x4(float a, float b, float c, float d) {
    unsigned w = __builtin_amdgcn_cvt_pk_u8_f32(a, 0u, 0u); w = __builtin_amdgcn_cvt_pk_u8_f32(b, 1u, w); w = __builtin_amdgcn_cvt_pk_u8_f32(c, 2u, w); w = __builtin_amdgcn_cvt_pk_u8_f32(d, 3u, w);
    return (int)w;
}
__device__ __forceinline__ f32x16 mfma_pv(i32x8 p, i32x8 v, f32x16 c) { return __builtin_amdgcn_mfma_scale_f32_32x32x64_f8f6f4(p, v, c, 1, 0, 0, 0, 0, 0); }
__device__ __forceinline__ f32x4 mfma_sum(i32x8 p, i32x8 sel, f32x4 c) { return __builtin_amdgcn_mfma_scale_f32_16x16x128_f8f6f4(p, sel, c, 1, 0, 0, 0, 0, 0); }
template <bool SECOND>
__device__ __forceinline__ void mask16(f32x16& c, int kb, int qrow) {
    int d = qrow - kb; asm volatile("" : "+v"(d));
#pragma unroll
    for (int r = 0; r < 16; ++r) { if ((r & 3) + 8 * (r >> 2) + (SECOND ? 32 : 0) > d) c[r] = -1e30f; }
}
__device__ __forceinline__ void att_step(bool MASK, f32x16 (&o)[4], i32x8 (&kf)[2], const i32x8& qf, const f32x16& cinit, f32x4& lacc, const i32x8& ones, const i32x8& pfp, i32x8& pfc,
                                         const LAS char* vp, const LAS char* kpn, int kc0, int kc1, int kb, int qrow,
                                         const DmaSet& dm, unsigned vdma, __amdgpu_buffer_rsrc_t srdK, __amdgpu_buffer_rsrc_t srdV) {
    i32x8 vf[4]; f32x16 c0, c1;
    vf[0] = ATT_KFRAG(vp, 0); vf[1] = ATT_KFRAG(vp, 1);
    c0 = mfma8(kf[0], qf, cinit);
    vf[2] = ATT_KFRAG(vp, 2); vf[3] = ATT_KFRAG(vp, 3);
    c1 = mfma8(kf[1], qf, cinit);
    ATT_SB();
#pragma unroll
    for (int i = 0; i < 4; ++i) {
        o[i] = mfma_pv(pfp, vf[i], o[i]);
        if (i == 0) BUF_DMA16(dm.m0[0], vdma, srdK, dm.so[0]);
        if (i == 1) kf[0] = ATT_KFRAG(kpn, 0);
        if (i == 2) kf[1] = ATT_KFRAG(kpn, 1);
        if (MASK && i == 0) mask16<false>(c0, kb, qrow);
        if (MASK && i == 2) mask16<true>(c1, kb, qrow);
        { const f32x16& C = i < 2 ? c0 : c1; const int e = 8 * (i & 1);
          int w0 = exp2_bf8x4(C[e], C[e + 1], C[e + 2], C[e + 3]), w1 = exp2_bf8x4(C[e + 4], C[e + 5], C[e + 6], C[e + 7]);
          asm volatile("" : "+v"(w0), "+v"(w1)); pfc[2 * i] = w0; pfc[2 * i + 1] = w1; }
        if (i == 3) BUF_DMA16(dm.m0[1], vdma, srdV, dm.so[1]);
        ATT_SB();
    }
    lacc = mfma_sum(pfp, ones, lacc);
}
__device__ __forceinline__ void att_drain(f32x16 (&o)[4], const i32x8& pf, f32x4& lacc, const i32x8& ones, const LAS char* vp, int kc0, int kc1) {
#pragma unroll
    for (int i = 0; i < 4; ++i) { const i32x8 f = ATT_KFRAG(vp, i); o[i] = mfma_pv(pf, f, o[i]); }
    lacc = mfma_sum(pf, ones, lacc);
}

__device__ __forceinline__ void phase5(Frame& F, bf16* MGout) {
    const bf16* GA = (const bf16*)(F.ws + WS_GA); bf16* MG = (bf16*)(F.ws + WS_U);
    const int lane = F.lane, r32 = lane & 31, hi = lane >> 5, wid = F.wave, rg = wid & 3, mp = wid >> 2;
    float lam;
    {
        const float q1 = F.in(I_LQ1)[lane], k1 = F.in(I_LK1)[lane], q2 = F.in(I_LQ2)[lane], k2 = F.in(I_LK2)[lane];
        lam = __expf(wave_sum(q1 * k1)) - __expf(wave_sum(q2 * k2)) + LAMBDA_INIT;
    }
    f32x16 cinit;
    { float pb = PBIAS; asm volatile("" : "+v"(pb));
#pragma unroll
      for (int r = 0; r < 16; ++r) cinit[r] = pb; }
    const int one4 = (lane & 15) == ((lane >> 4) & 1) ? 0x38383838 : 0;
    const i32x8 ones = {one4, one4, one4, one4, one4, one4, one4, one4};
    LAS char* ring = (LAS char*)F.lds;
    const unsigned ring0 = (unsigned)(size_t)ring;
    const int voff = r32 * 64;
    const int ksw = (r32 >> 2) & 3;
    const int koff = r32 * 64 + mp * 4096, kc0 = ((2 * hi) ^ ksw) << 4, kc1 = ((2 * hi + 1) ^ ksw) << 4;
    const __amdgpu_buffer_rsrc_t srdK = __builtin_amdgcn_make_buffer_rsrc((void*)(F.ws + WS_K), (short)0, 64 << 20, 0x00020000);
    const __amdgpu_buffer_rsrc_t srdV = __builtin_amdgcn_make_buffer_rsrc((void*)(F.ws + WS_V), (short)0, 64 << 20, 0x00020000);
    const __amdgpu_buffer_rsrc_t srdQ = __builtin_amdgcn_make_buffer_rsrc((void*)(F.ws + WS_Q), (short)0, 64 << 20, 0x00020000);
    const unsigned vdma = (unsigned)(wid * 1024 + lane * 16);
    const unsigned vdmk = (unsigned)((wid & 3) * 1024 + lane * 16);
    const unsigned vq = (unsigned)(r32 * 64 + hi * 32);
    if (wid >= 4) __builtin_amdgcn_s_setprio(1);
#ifndef DBG_ATT2
#define DBG_ATT2 0
#endif
    for (int p_ = F.vcu; p_ < (DBG_ATT2 ? 2048 : 1024); p_ += F.G) {
        const int p = p_ & 1023; bf16* const MGo = (DBG_ATT2 && p_ < 1024) ? (bf16*)F.out : MGout;
        const int bh = p >> 6, j = p & 63;
        for (int half = 0; half < 2; ++half) {
            const int qt = half == 0 ? j : 127 - j;
            const int NT = 2 * (qt + 1);
            const unsigned kxoff = (unsigned)(bh * 2 + (wid >> 2)) * (SEQ * 64u), voffg = (unsigned)bh * (256u * 8192u);
#define ATT_ISSUE_K(tk_, dst_) do { const unsigned tk__ = (unsigned)((tk_) < NT ? (tk_) : NT - 1) * 4096u; BUF_DMA16(ring0 + (dst_) + wid * 1024, vdmk, srdK, kxoff + tk__); } while (0)
#define ATT_ISSUE_V(tv_, dst_) do { const unsigned tv__ = voffg + (unsigned)((tv_) < NT ? (tv_) : NT - 1) * 8192u; BUF_DMA16(ring0 + (dst_) + wid * 1024, vdma, srdV, tv__); } while (0)
            u32x4 q0, q1;
            { const unsigned qs = ((unsigned)(bh * 2 + mp) * SEQ + (unsigned)(qt * 128 + rg * 32)) * 64u;
              asm volatile("buffer_load_dwordx4 %0, %2, %3, %4 offen\n\tbuffer_load_dwordx4 %1, %2, %3, %4 offen offset:16"
                           : "=&v"(q0), "=&v"(q1) : "v"(vq), "s"(srdQ), "s"(qs) : "memory"); }
            ATT_ISSUE_K(0, XOFF); ATT_ISSUE_K(1, XOFF + 16384);
            ATT_ISSUE_K(2, 0); ATT_ISSUE_V(0, 16384);
            ATT_ISSUE_K(3, SLOT); ATT_ISSUE_V(1, SLOT + 16384);
            asm volatile("s_waitcnt vmcnt(4)\n\ts_barrier" : "+v"(q0), "+v"(q1) :: "memory");
            const i32x8 qf = {(int)q0.x, (int)q0.y, (int)q0.z, (int)q0.w, (int)q1.x, (int)q1.y, (int)q1.z, (int)q1.w};
            f32x16 o[4];
#pragma unroll
            for (int vb = 0; vb < 4; ++vb)
#pragma unroll
                for (int r = 0; r < 16; ++r) o[vb][r] = 0.f;
            f32x4 lacc = {0.f, 0.f, 0.f, 0.f};
            const int qrow = qt * 128 + rg * 32 + r32;
            i32x8 kf[2], pfA, pfB;
            { const LAS char* kp0 = ring + XOFF + koff; f32x16 c0, c1;
              kf[0] = ATT_KFRAG(kp0, 0); kf[1] = ATT_KFRAG(kp0, 1);
              c0 = mfma8(kf[0], qf, cinit); c1 = mfma8(kf[1], qf, cinit);
              if (NT == 2) { mask16<false>(c0, 4 * hi, qrow); mask16<true>(c1, 4 * hi, qrow); }
#pragma unroll
              for (int d = 0; d < 8; ++d) { const f32x16& C = d < 4 ? c0 : c1; const int e = 4 * (d & 3); pfA[d] = exp2_bf8x4(C[e], C[e + 1], C[e + 2], C[e + 3]); } }
            { const LAS char* kp1 = ring + XOFF + 16384 + koff; kf[0] = ATT_KFRAG(kp1, 0); kf[1] = ATT_KFRAG(kp1, 1); }
            unsigned sl_use = 0, sl_mid = SLOT, sl_new = 2 * SLOT;
#define ATT_STEP(MASKED, PFC, PFP, t_) do { asm volatile("s_waitcnt vmcnt(2) lgkmcnt(0)\n\ts_barrier" ::: "memory"); \
                DmaSet dm; { const unsigned tk__ = (unsigned)(((t_) + 3) < NT ? ((t_) + 3) : NT - 1) * 4096u, tv__ = voffg + (unsigned)(((t_) + 1) < NT ? ((t_) + 1) : NT - 1) * 8192u, d__ = ring0 + sl_new + wid * 1024; \
                    dm.m0[0] = d__; dm.m0[1] = d__ + 16384u; dm.so[0] = kxoff + tk__ - (unsigned)(wid >> 2) * 4096u; dm.so[1] = tv__; }   \
                { const LAS char* vp = ring + sl_use + 16384 + voff; const LAS char* kpn = ring + sl_use + koff; \
                  att_step(MASKED, o, kf, qf, cinit, lacc, ones, PFP, PFC, vp, kpn, kc0, kc1, 64 * (t_) + 4 * hi, qrow, dm, vdma, srdK, srdV); } \
                { const unsigned t__ = sl_use; sl_use = sl_mid; sl_mid = sl_new; sl_new = t__; } } while (0)
            int t = 1;
            for (; t + 1 < NT; t += 2) { ATT_STEP(false, pfB, pfA, t); ATT_STEP((t + 1 >= NT - 2), pfA, pfB, t + 1); }
            ATT_STEP(true, pfB, pfA, NT - 1);
            const size_t eidx = ((size_t)(bh >> 3) * SEQ + qt * 128 + (F.tid >> 2)) * D + (bh & 7) * 128 + (F.tid & 3) * 32;
            u32x4 gaP[4], mcP[4];
#pragma unroll
            for (int c8 = 0; c8 < 4; ++c8) { gaP[c8] = *(const u32x4*)(GA + eidx + c8 * 8); mcP[c8] = *(const u32x4*)(MG + eidx + c8 * 8); }
            f32x4 sgP[8];
            { const float* sgp = F.in(I_SUBG) + (F.tid & 3) * 32; asm volatile("" : "+v"(sgp));
#pragma unroll
              for (int c4 = 0; c4 < 8; ++c4) sgP[c4] = *(const __attribute__((address_space(1))) f32x4*)(sgp + c4 * 4); }
            asm volatile("s_waitcnt vmcnt(16) lgkmcnt(0)\n\ts_barrier" ::: "memory");
            att_drain(o, pfB, lacc, ones, ring + sl_use + 16384 + voff, kc0, kc1);
#undef ATT_STEP
#undef ATT_ISSUE_K
#undef ATT_ISSUE_V
            float rl[16];
            { int hi_e = hi; asm volatile("" : "+v"(hi_e));
#pragma unroll
              for (int r = 0; r < 16; ++r) rl[r] = __builtin_amdgcn_rcpf(__shfl(lacc[r & 3], 16 * (2 * ((r >> 2) & 1) + hi_e) + (r >> 3))); }
            asm volatile("s_waitcnt lgkmcnt(0)\n\ts_barrier" ::: "memory");
            LAS float* xch = (LAS float*)ring + rg * 4096;
            if (mp == 1) {
#pragma unroll
                for (int vb = 0; vb < 4; ++vb)
#pragma unroll
                    for (int r = 0; r < 16; ++r) xch[(vb * 16 + r) * 64 + lane] = o[vb][r] * rl[r] * lam;
            }
            asm volatile("s_waitcnt lgkmcnt(0)\n\ts_barrier" ::: "memory");
            if (mp == 0) {
                float ssq[16];
#pragma unroll
                for (int r = 0; r < 16; ++r) ssq[r] = 0.f;
#pragma unroll
                for (int vb = 0; vb < 4; ++vb)
#pragma unroll
                    for (int r = 0; r < 16; ++r) { const float d = o[vb][r] * rl[r] - xch[(vb * 16 + r) * 64 + lane]; o[vb][r] = d; ssq[r] += d * d; }
#pragma unroll
                for (int r = 0; r < 16; ++r) { float s = ssq[r];
#pragma unroll
                    for (int off = 1; off < 32; off <<= 1) s += __shfl_xor(s, off);
                    ssq[r] = __builtin_amdgcn_rsqf(s * (1.f / 128.f) + EPS) * (1.f - LAMBDA_INIT); }
#pragma unroll
                for (int vb = 0; vb < 4; ++vb)
#pragma unroll
                    for (int r = 0; r < 16; ++r) xch[(vb * 16 + r) * 64 + lane] = o[vb][r] * ssq[r];
            }
            asm volatile("s_waitcnt lgkmcnt(0)\n\ts_barrier" ::: "memory");
            {
                const int b = bh >> 3, h = bh & 7, q = F.tid >> 2, vb = F.tid & 3, q5 = q & 31;
                const int rr = (q5 & 3) + 4 * (q5 >> 3), hh = (q5 >> 2) & 1;
                const LAS float* src = (const LAS float*)ring + (q >> 5) * 4096 + (vb * 16 + rr) * 64 + hh * 32;
                const size_t idx = eidx; (void)b; (void)h;
#pragma unroll
                for (int c8 = 0; c8 < 4; ++c8) { const f32x4 y0 = *(const LAS f32x4*)(src + c8 * 8), y1 = *(const LAS f32x4*)(src + c8 * 8 + 4);
                    const f32x4 g0 = sgP[2 * c8], g1 = sgP[2 * c8 + 1];
                    const u32x4 ga = gaP[c8], mc = mcP[c8];
                    u32x4 w;
                    w.x = cvt_pk_bf16(y0[0] * g0[0] * bf_lo(ga.x) + bf_lo(mc.x), y0[1] * g0[1] * bf_hi(ga.x) + bf_hi(mc.x));
                    w.y = cvt_pk_bf16(y0[2] * g0[2] * bf_lo(ga.y) + bf_lo(mc.y), y0[3] * g0[3] * bf_hi(ga.y) + bf_hi(mc.y));
                    w.z = cvt_pk_bf16(y1[0] * g1[0] * bf_lo(ga.z) + bf_lo(mc.z), y1[1] * g1[1] * bf_hi(ga.z) + bf_hi(mc.z));
                    w.w = cvt_pk_bf16(y1[2] * g1[2] * bf_lo(ga.w) + bf_lo(mc.w), y1[3] * g1[3] * bf_hi(ga.w) + bf_hi(mc.w));
                    *(u32x4*)(MGo + idx + c8 * 8) = w; }
            }
            asm volatile("s_waitcnt lgkmcnt(0)\n\ts_barrier" ::: "memory");
        }
    }
    __builtin_amdgcn_s_setprio(0);
}
}

struct EpiOut {
    static constexpr bool PERM = true;
    const float* X; float* O; const float* mod;
    __device__ __forceinline__ void operator()(const f32x4 (&acc)[2][2][4][2], const pg8::Unit& u, int wr, int wc, int fr, int fq) const {
        const int row0 = u.pm * 256 + wr * 64 + fr, col0 = u.pn * 256 + wc * 32 + fq * 8;
#pragma unroll
        for (int ai = 0; ai < 2; ++ai)
#pragma unroll
            for (int m = 0; m < 4; ++m) { const int row = row0 + ai * 128 + m * 16, b = row >> 14;
#pragma unroll
                for (int bj = 0; bj < 2; ++bj)
#pragma unroll
                    for (int n = 0; n < 2; ++n) { const int col = col0 + bj * 128 + 4 * n; const f32x4 g = *(const f32x4*)(mod + b * 6144 + 2048 + col), xv = *(const f32x4*)(X + (size_t)row * D + col);
                        *(f32x4*)(O + (size_t)row * D + col) = xv + g * acc[ai][bj][m][n]; } }
    }
};

__device__ __forceinline__ void phase7(Frame& F) {
    const float* X1 = F.out; const float* mod = (const float*)(F.ws + WS_MOD); const float* gn = F.in(I_N2G); bf16* H2 = (bf16*)(F.ws + WS_U);
    constexpr int PITCH = 272;
    LAS char* Ahi = (LAS char*)F.lds;
    LAS char* Alo = Ahi + 128 * PITCH;
    LAS char* Whi = Alo + 128 * PITCH;
    LAS char* Wlo = Whi + 64 * PITCH;
    LAS float* RS = (LAS float*)(F.lds + 104448);
    LAS int* CW = (LAS int*)(F.lds + 104960);
    LAS unsigned char* RK = (LAS unsigned char*)(F.lds + 105472);
    LAS float* LG = (LAS float*)F.lds;
    const int tid = F.tid, lane = F.lane, wid = F.wave, r32 = lane & 31, hi = lane >> 5;
    const bf16* WRH = (const bf16*)(F.ws + WS_WRH); const bf16* WRL = (const bf16*)(F.ws + WS_WRL);
    for (int chunk = F.vcu; chunk < T / 128; chunk += F.G) {
        const int t0 = chunk * 128, b = t0 >> 14;
        for (int i4 = 0; i4 < 16; i4 += 4) {
            f32x4 v[4][4]; float ss[4];
#pragma unroll
            for (int u = 0; u < 4; ++u) { const f32x4* xr = (const f32x4*)(X1 + (size_t)(t0 + wid * 16 + i4 + u) * D) + lane;
#pragma unroll
                for (int j = 0; j < 4; ++j) v[u][j] = xr[64 * j]; }
#pragma unroll
            for (int u = 0; u < 4; ++u) { float s = 0.f;
#pragma unroll
                for (int j = 0; j < 4; ++j) s += (v[u][j].x * v[u][j].x + v[u][j].y * v[u][j].y) + (v[u][j].z * v[u][j].z + v[u][j].w * v[u][j].w);
                ss[u] = s; }
#pragma unroll
            for (int o_ = 1; o_ < 64; o_ <<= 1) {
#pragma unroll
                for (int u = 0; u < 4; ++u) ss[u] += __shfl_xor(ss[u], o_); }
#pragma unroll
            for (int u = 0; u < 4; ++u) { const int m = t0 + wid * 16 + i4 + u; const float rstd = __builtin_amdgcn_rsqf(ss[u] * (1.f / D) + EPS);
                if (lane == 0) RS[wid * 16 + i4 + u] = rstd;
                unsigned* o4 = (unsigned*)((unsigned char*)H2 + (size_t)m * D) + lane;
#pragma unroll
                for (int j = 0; j < 4; ++j) { const int col = 4 * lane + 256 * j;
                    const f32x4 g = *(const f32x4*)(gn + col), sc = *(const f32x4*)(mod + b * 6144 + 4096 + col), sh = *(const f32x4*)(mod + b * 6144 + 3072 + col);
                    const f32x4 y = v[u][j] * rstd * g * (sc + 1.f) + sh;
                    int w = 0; w = __builtin_amdgcn_cvt_pk_fp8_f32(y.x, y.y, w, false); w = __builtin_amdgcn_cvt_pk_fp8_f32(y.z, y.w, w, true); o4[64 * j] = (unsigned)w; } } }
        __syncthreads();
        f32x16 c;
#pragma unroll
        for (int r = 0; r < 16; ++r) c[r] = 0.f;
        const int tb = wid & 3, eb = wid >> 2;
        const int cq = (lane & 31) * 4;
        f32x4 xv[8], pg, psc, psh; u32x4 wv[4];
#define P7_FETCH(ks_) do { const int col = (ks_) * 128 + cq; pg = *(const f32x4*)(gn + col); psc = *(const f32x4*)(mod + b * 6144 + 4096 + col); psh = *(const f32x4*)(mod + b * 6144 + 3072 + col); \
            _Pragma("unroll") for (int i = 0; i < 8; ++i) xv[i] = *(const f32x4*)(X1 + (size_t)(t0 + wid * 16 + 2 * i + hi) * D + col); \
            _Pragma("unroll") for (int q = 0; q < 2; ++q) { const int cc = tid + 512 * q, e = cc >> 4, kc = cc & 15; \
                wv[2 * q] = *(const u32x4*)(WRH + e * 1024 + (ks_) * 128 + kc * 8); wv[2 * q + 1] = *(const u32x4*)(WRL + e * 1024 + (ks_) * 128 + kc * 8); } } while (0)
        P7_FETCH(0);
        for (int ks = 0; ks < 8; ++ks) {
            {
#pragma unroll
              for (int i = 0; i < 8; ++i) { const int row = wid * 16 + 2 * i + hi; const float rstd = RS[row];
                  const f32x4 y = xv[i] * rstd * pg * (psc + 1.f) + psh;
                  const unsigned h0 = cvt_pk_bf16(y.x, y.y), h1 = cvt_pk_bf16(y.z, y.w);
                  *(LAS u32x2*)(Ahi + row * PITCH + cq * 2) = (u32x2){h0, h1};
                  *(LAS u32x2*)(Alo + row * PITCH + cq * 2) = (u32x2){cvt_pk_bf16(y.x - bf_lo(h0), y.y - bf_hi(h0)), cvt_pk_bf16(y.z - bf_lo(h1), y.w - bf_hi(h1))}; }
#pragma unroll
              for (int q = 0; q < 2; ++q) { const int cc = tid + 512 * q, e = cc >> 4, kc = cc & 15;
                  *(LAS u32x4*)(Whi + e * PITCH + kc * 16) = wv[2 * q]; *(LAS u32x4*)(Wlo + e * PITCH + kc * 16) = wv[2 * q + 1]; } }
            __syncthreads();
            if (ks + 1 < 8) P7_FETCH(ks + 1);
#pragma unroll
            for (int st = 0; st < 8; ++st) { const int ao = (tb * 32 + r32) * PITCH + (2 * st + hi) * 16, bo = (eb * 32 + r32) * PITCH + (2 * st + hi) * 16;
                const bf16x8 ah = *(const LAS bf16x8*)(Ahi + ao), al = *(const LAS bf16x8*)(Alo + ao), bh = *(const LAS bf16x8*)(Whi + bo), bl = *(const LAS bf16x8*)(Wlo + bo);
                c = __builtin_amdgcn_mfma_f32_32x32x16_bf16(ah, bh, c, 0, 0, 0); c = __builtin_amdgcn_mfma_f32_32x32x16_bf16(ah, bl, c, 0, 0, 0); c = __builtin_amdgcn_mfma_f32_32x32x16_bf16(al, bh, c, 0, 0, 0); }
            __syncthreads();
        }
#undef P7_FETCH
#pragma unroll
        for (int r = 0; r < 16; ++r) LG[(tb * 32 + att::crow(r, hi)) * 65 + eb * 32 + r32] = c[r];
        __syncthreads();
        unsigned long long chosen = 0ull; int ek[8]; float sk[8];
        if (tid < 128) {
            LAS float* L = LG + tid * 65;
            float gs[8];
#pragma unroll
            for (int g = 0; g < 8; ++g) { float m1 = -INFINITY, m2 = -INFINITY;
#pragma unroll
                for (int jx = 0; jx < 8; ++jx) { const float sc = sigmoidf_(L[g * 8 + jx]); const float ch = sc + F.in(I_RB)[g * 8 + jx]; L[g * 8 + jx] = ch;
                    if (ch > m1) { m2 = m1; m1 = ch; } else if (ch > m2) m2 = ch; }
                gs[g] = m1 + m2; }
            unsigned gm = 0u;
#pragma unroll
            for (int it = 0; it < 4; ++it) { float best = -INFINITY; int bi = 0;
#pragma unroll
                for (int g = 0; g < 8; ++g) { const bool ok = !((gm >> g) & 1u) && gs[g] > best; best = ok ? gs[g] : best; bi = ok ? g : bi; }
                gm |= 1u << bi; }
            int gsel[4]; float cand[32];
            { unsigned m = gm;
#pragma unroll
              for (int sx = 0; sx < 4; ++sx) { const int g = __builtin_ctz(m); m &= m - 1u; gsel[sx] = g;
#pragma unroll
                  for (int jx = 0; jx < 8; ++jx) cand[sx * 8 + jx] = L[g * 8 + jx]; } }
            float ssum = 0.f;
#pragma unroll
            for (int it = 0; it < 8; ++it) { float best = -INFINITY; int bi = 0;
#pragma unroll
                for (int i = 0; i < 32; ++i) { const bool ok = cand[i] > best; best = ok ? cand[i] : best; bi = ok ? i : bi; }
#pragma unroll
                for (int i = 0; i < 32; ++i) cand[i] = (i == bi) ? -INFINITY : cand[i];
                const int sx = bi >> 3; const int g = sx == 0 ? gsel[0] : sx == 1 ? gsel[1] : sx == 2 ? gsel[2] : gsel[3]; const int e = g * 8 + (bi & 7);
                chosen |= 1ull << e; ek[it] = e; const float sc = best - F.in(I_RB)[e]; sk[it] = sc; ssum += sc; }
            const float inv = 2.5f / ssum;
#pragma unroll
            for (int it = 0; it < 8; ++it) sk[it] *= inv;
        }
        if (wid < 2) {
            for (int e = 0; e < 64; ++e) { const bool f = (chosen >> e) & 1ull; const unsigned long long bm = __ballot(f);
                const int rk = __popcll(bm & ((1ull << lane) - 1ull));
                if (f) RK[tid * 64 + e] = (unsigned char)rk;
                if (lane == 0) CW[wid * 64 + e] = __popcll(bm); }
        }
        __syncthreads();
        if (tid < 128) {
            int* tke = (int*)(F.ws + WS_TKE) + (size_t)(t0 + tid) * 8; int* tkr = (int*)(F.ws + WS_TKR) + (size_t)(t0 + tid) * 8; float* tkw = (float*)(F.ws + WS_TKW) + (size_t)(t0 + tid) * 8;
#pragma unroll
            for (int it = 0; it < 8; ++it) { const int e = ek[it]; tke[it] = e; tkr[it] = (int)RK[tid * 64 + e] + (wid == 1 ? CW[e] : 0); tkw[it] = sk[it]; }
        }
        if (tid < 64) ((int*)(F.ws + WS_CNT))[chunk * 64 + tid] = CW[tid] + CW[64 + tid];
        __syncthreads();
    }
}

__device__ __forceinline__ void phase8(Frame& F) {
    const int* CNT = (const int*)(F.ws + WS_CNT); int* TOK = (int*)(F.ws + WS_TOK); float* WGT = (float*)(F.ws + WS_WGT); int* POS = (int*)(F.ws + WS_POS);
    LAS int* part = (LAS int*)F.lds;
    LAS int* tot = part + 1024;
    LAS int* below = tot + 64;
    LAS int* ebase = below + 64;
    const int tid = F.tid;
    for (int chunk = F.vcu; chunk < T / 128; chunk += F.G) {
        { const int e = tid & 63, pr = tid >> 6; int s = 0, sb = 0;
          for (int c = pr * 32; c < pr * 32 + 32; ++c) { const int v = CNT[c * 64 + e]; s += v; sb += c < chunk ? v : 0; }
          part[(pr * 2 + 0) * 64 + e] = s; part[(pr * 2 + 1) * 64 + e] = sb; }
        __syncthreads();
        if (tid < 64) { int s = 0, sb = 0;
#pragma unroll
            for (int pr = 0; pr < 8; ++pr) { s += part[(pr * 2 + 0) * 64 + tid]; sb += part[(pr * 2 + 1) * 64 + tid]; }
            tot[tid] = s; below[tid] = sb; }
        __syncthreads();
        if (tid == 0) { int a = 0; for (int e = 0; e < 64; ++e) { ebase[e] = a; a += (tot[e] + 255) & ~255; } ebase[64] = a; }
        __syncthreads();
        if (tid < 128) { const int tokn = chunk * 128 + tid;
            const int* tke = (const int*)(F.ws + WS_TKE) + (size_t)tokn * 8; const int* tkr = (const int*)(F.ws + WS_TKR) + (size_t)tokn * 8; const float* tkw = (const float*)(F.ws + WS_TKW) + (size_t)tokn * 8;
#pragma unroll
            for (int k = 0; k < 8; ++k) { const int e = tke[k]; const int pos = ebase[e] + below[e] + tkr[k]; TOK[pos] = tokn; WGT[pos] = tkw[k]; POS[tokn * 8 + k] = pos; } }
        const int RTOT = ebase[64];
        if (chunk < 64) { const int e = chunk; for (int p = ebase[e] + tot[e] + tid; p < ebase[e + 1]; p += NTHREADS) { TOK[p] = -1; WGT[p] = 0.f; } }
        { const int tokn = chunk * 128 + (tid & 127); if (tid < 128) { TOK[RTOT + tokn] = tokn; WGT[RTOT + tokn] = 1.f; } }
        if (chunk == 0) { int* TE = (int*)(F.ws + WS_TE); const int NTR = RTOT >> 8;
            for (int pm = tid; pm < NTR + 128; pm += NTHREADS) { int e = 64; if (pm < NTR) { e = 0; for (int x = 1; x < 64; ++x) e = (pm * 256 >= ebase[x]) ? x : e; } TE[pm] = e; }
            if (tid == 0) ((int*)(F.ws + WS_META))[0] = NTR; }
        __syncthreads();
    }
}

struct SchedMoe {
    int G, c, nunits, pm0, csh, colbase, bmul; const int* te; const int* tok;
    __device__ __forceinline__ bool next(int i, pg8::Unit& u) const {
        int pm, ct;
        if ((G & 7) == 0) { const int x = c & 7, w = c >> 3, W = G >> 3, nrows = nunits >> csh, nloc = (nrows + 7) >> 3;
            const long Lx = (long)i * W + w; const int pl = (int)(Lx >> csh), pr = x * nloc + pl; if (pl >= nloc || pr >= nrows) return false;
            pm = pm0 + pr; ct = colbase + (int)(Lx & ((1 << csh) - 1)); }
        else { const long L = (long)i * G + c; if (L >= nunits) return false; pm = pm0 + (int)(L >> csh); ct = colbase + (int)(L & ((1 << csh) - 1)); }
        u.pm = pm; u.pn = bmul * te[pm] + ct; return true; }
};
template <int MODE> struct EpiNull {
    static constexpr bool PERM = true;
    float* sink;
    __device__ __forceinline__ void operator()(const f32x4 (&acc)[2][2][4][2], const pg8::Unit& u, int wr, int wc, int fr, int fq) const {
        float s = 0.f;
        if (MODE == 1) {
#pragma unroll
            for (int ai = 0; ai < 2; ++ai)
#pragma unroll
                for (int bj = 0; bj < 2; ++bj)
#pragma unroll
                    for (int m = 0; m < 4; ++m)
#pragma unroll
                        for (int n = 0; n < 2; ++n) s += (acc[ai][bj][m][n][0] + acc[ai][bj][m][n][1]) + (acc[ai][bj][m][n][2] + acc[ai][bj][m][n][3]);
        } else s = acc[0][0][0][0][0] + acc[1][1][3][1][3];
        if (s == 12345.678f) sink[0] = s;
    }
};
struct EpiGU {
    static constexpr bool PERM = true;
    unsigned char* ACT; const float* WGT;
    __device__ __forceinline__ void operator()(const f32x4 (&acc)[2][2][4][2], const pg8::Unit& u, int wr, int wc, int fr, int fq) const {
        const int row0 = u.pm * 256 + wr * 64 + fr, ct = u.pn & 1;
#pragma unroll
        for (int ai = 0; ai < 2; ++ai)
#pragma unroll
            for (int m = 0; m < 4; ++m) { const int row = row0 + ai * 128 + m * 16; const float w = WGT[row] * ACT_SCALE; float r[8];
#pragma unroll
                for (int n = 0; n < 2; ++n)
#pragma unroll
                    for (int i = 0; i < 4; ++i) { const float g = acc[ai][0][m][n][i] * (1.f / WIN_SCALE); r[4 * n + i] = g * sigmoidf_(g) * (acc[ai][1][m][n][i] * (1.f / WIN_SCALE)) * w; }
                int d0 = 0, d1 = 0;
                d0 = __builtin_amdgcn_cvt_pk_fp8_f32(r[0], r[1], d0, false); d0 = __builtin_amdgcn_cvt_pk_fp8_f32(r[2], r[3], d0, true);
                d1 = __builtin_amdgcn_cvt_pk_fp8_f32(r[4], r[5], d1, false); d1 = __builtin_amdgcn_cvt_pk_fp8_f32(r[6], r[7], d1, true);
                *(u32x2*)(ACT + (size_t)row * 256 + ct * 128 + wc * 32 + fq * 8) = (u32x2){(unsigned)d0, (unsigned)d1}; }
    }
};
constexpr float Y_SCALE = 16.f;
struct EpiDown {
    static constexpr bool PERM = true;
    static constexpr float YD = Y_SCALE / (ACT_SCALE * WDN_SCALE);
    unsigned char* Y;
    __device__ __forceinline__ void operator()(const f32x4 (&acc)[2][2][4][2], const pg8::Unit& u, int wr, int wc, int fr, int fq) const {
        const int row0 = u.pm * 256 + wr * 64 + fr, col0 = (u.pn & 3) * 256 + (wc * 4 + fq) * 16;
#pragma unroll
        for (int ai = 0; ai < 2; ++ai)
#pragma unroll
            for (int m = 0; m < 4; ++m) { const int row = row0 + ai * 128 + m * 16; u32x4 w;
#pragma unroll
                for (int bj = 0; bj < 2; ++bj) { int d0 = 0, d1 = 0;
                    d0 = __builtin_amdgcn_cvt_pk_fp8_f32(acc[ai][bj][m][0][0] * YD, acc[ai][bj][m][0][1] * YD, d0, false); d0 = __builtin_amdgcn_cvt_pk_fp8_f32(acc[ai][bj][m][0][2] * YD, acc[ai][bj][m][0][3] * YD, d0, true);
                    d1 = __builtin_amdgcn_cvt_pk_fp8_f32(acc[ai][bj][m][1][0] * YD, acc[ai][bj][m][1][1] * YD, d1, false); d1 = __builtin_amdgcn_cvt_pk_fp8_f32(acc[ai][bj][m][1][2] * YD, acc[ai][bj][m][1][3] * YD, d1, true);
                    if (bj == 0) { w.x = (unsigned)d0; w.y = (unsigned)d1; } else { w.z = (unsigned)d0; w.w = (unsigned)d1; } }
                *(u32x4*)(Y + (size_t)row * 1024 + col0) = w; }
    }
};
struct EpiComb {
    static constexpr bool PERM = true;
    float* O; const unsigned char* Y; const int* POS; const float* mod; int rtiles;
    __device__ __forceinline__ void operator()(const f32x4 (&acc)[2][2][4][2], const pg8::Unit& u, int wr, int wc, int fr, int fq) const {
        const int row0 = (u.pm - rtiles) * 256 + wr * 64 + fr, ct = u.pn & 3, col0 = ct * 256 + wc * 32 + fq * 8;
#pragma unroll
        for (int ai = 0; ai < 2; ++ai)
#pragma unroll
            for (int m = 0; m < 4; ++m) { const int row = row0 + ai * 128 + m * 16, b = row >> 14;
                const i32x4 p0 = *(const i32x4*)(POS + (size_t)row * 8), p1 = *(const i32x4*)(POS + (size_t)row * 8 + 4);
                f32x2 t[8] = {{0.f, 0.f}, {0.f, 0.f}, {0.f, 0.f}, {0.f, 0.f}, {0.f, 0.f}, {0.f, 0.f}, {0.f, 0.f}, {0.f, 0.f}};
#pragma unroll
                for (int k = 0; k < 8; ++k) { const int pos = k < 4 ? p0[k & 3] : p1[k & 3]; const u32x4 y = *(const u32x4*)(Y + (size_t)pos * 1024 + ct * 256 + (wc * 4 + fq) * 16);
                    t[0] += __builtin_amdgcn_cvt_pk_f32_fp8((int)y.x, false); t[1] += __builtin_amdgcn_cvt_pk_f32_fp8((int)y.x, true);
                    t[2] += __builtin_amdgcn_cvt_pk_f32_fp8((int)y.y, false); t[3] += __builtin_amdgcn_cvt_pk_f32_fp8((int)y.y, true);
                    t[4] += __builtin_amdgcn_cvt_pk_f32_fp8((int)y.z, false); t[5] += __builtin_amdgcn_cvt_pk_f32_fp8((int)y.z, true);
                    t[6] += __builtin_amdgcn_cvt_pk_f32_fp8((int)y.w, false); t[7] += __builtin_amdgcn_cvt_pk_f32_fp8((int)y.w, true); }
#pragma unroll
                for (int bj = 0; bj < 2; ++bj) {
                    const int col = col0 + bj * 128; float* op = O + (size_t)row * D + col;
#pragma unroll
                    for (int n = 0; n < 2; ++n) { const f32x4 g = *(const f32x4*)(mod + b * 6144 + 5120 + col + 4 * n), xv = *(const f32x4*)(op + 4 * n);
                        const f32x4 sv = acc[ai][bj][m][n] * (1.f / (ACT_SCALE * WDN_SCALE)) + (f32x4){t[bj * 4 + 2 * n].x, t[bj * 4 + 2 * n].y, t[bj * 4 + 2 * n + 1].x, t[bj * 4 + 2 * n + 1].y} * (1.f / Y_SCALE);
                        *(f32x4*)(op + 4 * n) = xv + g * sv; } } }
    }
};

constexpr int NPHASE = 12;
__global__ void __launch_bounds__(NTHREADS, 2) fwd_kernel(Args args) {
    extern __shared__ __attribute__((aligned(16))) unsigned char lds[];
    Frame F;
    F.lds = (LAS unsigned char*)lds;
    F.tid = threadIdx.x; F.lane = F.tid & 63; F.wave = __builtin_amdgcn_readfirstlane(F.tid >> 6);
    F.G = gridDim.x; { const int bx = blockIdx.x; F.vcu = (F.G % 8 == 0) ? (bx % 8) * (F.G / 8) + bx / 8 : bx; }
    F.ws = args.ws; F.out = args.out;
    F.ka = (const __attribute__((address_space(4))) unsigned char*)__builtin_amdgcn_kernarg_segment_ptr();
    volatile LAS unsigned* MISC = (volatile LAS unsigned*)(F.lds + MISC_OFF);
    if (F.tid < 64) MISC[F.tid] = 0u;
    __syncthreads();
    const int lo = args.ph_lo, hi = args.ph_hi;
    unsigned* barw = (unsigned*)(F.ws + WS_CTL) + CW_BAR;
    XcdBarrier bar; bar.bar = barw; bar.x = 0; bar.st = nullptr;
    if (hi - lo > 1) bar = xcd_barrier_post(barw, MISC + 8);
#ifndef ONLY_PHASE
#define ONLY_PHASE -1
#endif
#define HASP(k) (ONLY_PHASE < 0 || ONLY_PHASE == (k) || (ONLY_PHASE == 100 && (k) == 10) || (ONLY_PHASE == 101 && (k) == 11))
#define IN(k) (HASP(k) && lo <= (k) && (k) < hi)
#ifndef DBG_REP
#define DBG_REP -1
#endif
#ifndef DBG_REPN
#define DBG_REPN 2
#endif
#define REPS(k) for (int rep_ = 0; rep_ < ((DBG_REP == (k)) ? DBG_REPN : 1); (void)({ asm volatile("" ::: "memory"); 0; }), ++rep_)
#define SEAM(k) do { if (IN(k) && IN((k) + 1)) xcd_barrier(bar); } while (0)
    bf16* const H = (bf16*)F.out;

    if (IN(0)) { REPS(0) phase0(F); } SEAM(0);
    if (IN(1)) { REPS(1) phase1(F); } SEAM(1);
    if (IN(2)) REPS(2) {
        pg8::Gemm g{H, (const bf16*)(F.ws + WS_WIN), T, NIN, D / 2}; pg8::StaticOrder S; S.init(T, NIN, F.G, (int)blockIdx.x);
        EpiIn E{(bf16*)(F.ws + WS_U), (bf16*)(F.ws + WS_Q), (bf16*)(F.ws + WS_K), (bf16*)(F.ws + WS_V), (bf16*)(F.ws + WS_GC), (bf16*)(F.ws + WS_GA), (const float*)(F.ws + WS_ROPE), F.in(I_QNG), F.in(I_KNG), F.lds + EPI_SCR};
        pg8::gemm_phase<EpiIn, pg8::StaticOrder, true, true, false, true>(F.lds, g, S, E);
    } SEAM(2);
    if (IN(3)) { REPS(3) phase3(F); } SEAM(3);
    if (IN(4)) REPS(4) {
        pg8::Gemm g{H, (const bf16*)(F.ws + WS_WPW2), T, D, D / 2}; pg8::StaticOrder S; S.init(T, D, F.G, (int)blockIdx.x);
        EpiPw2 E{(bf16*)(F.ws + WS_U), (const bf16*)(F.ws + WS_GC), F.in(I_BPW2)};
        pg8::gemm_phase<EpiPw2, pg8::StaticOrder, true, true, false, true>(F.lds, g, S, E);
    } SEAM(4);
#ifndef DBG_ATTVAR
#define DBG_ATTVAR 0
#endif
    if (IN(5)) { att::phase5(F, (bf16*)(F.ws + WS_U)); } SEAM(5);
    if (IN(6)) REPS(6) {
        pg8::Gemm g{(const bf16*)(F.ws + WS_U), (const bf16*)(F.ws + WS_WOUT), T, D, D}; pg8::StaticOrder S; S.init(T, D, F.G, (int)blockIdx.x);
        EpiOut E{F.in(I_X), F.out, (const float*)(F.ws + WS_MOD)};
        pg8::gemm_phase<EpiOut, pg8::StaticOrder, true, true, false>(F.lds, g, S, E);
    } SEAM(6);
    if (IN(7)) { REPS(7) phase7(F); } SEAM(7);
    if (IN(8)) { REPS(8) phase8(F); } SEAM(8);
    const int* TE = (const int*)(F.ws + WS_TE); const int* TOK = (const int*)(F.ws + WS_TOK);
    if (IN(9)) REPS(9) {
        const int NTR = ((const int*)(F.ws + WS_META))[0];
        pg8::Gemm g{(const bf16*)(F.ws + WS_U), (const bf16*)(F.ws + WS_WGU), 0, 0, D / 2};
        SchedMoe S{F.G, (int)blockIdx.x, 2 * (NTR + 128), 0, 1, 0, 2, TE, TOK};
        EpiGU E{(unsigned char*)(F.ws + WS_ACT), (const float*)(F.ws + WS_WGT)};
        pg8::gemm_phase<EpiGU, SchedMoe, true, true, true, true>(F.lds, g, S, E);
    } SEAM(9);
    if (IN(10)) REPS(10) { const int NTR = ((const int*)(F.ws + WS_META))[0];
        pg8::Gemm g{(const bf16*)(F.ws + WS_ACT), (const bf16*)(F.ws + WS_WDN), 0, 0, ED / 2};
        SchedMoe S{F.G, (int)blockIdx.x, 4 * NTR, 0, 2, 0, 4, TE, TOK};
        EpiDown E{(unsigned char*)(F.ws + WS_Y)};
#ifndef DBG_P10VAR
#define DBG_P10VAR 0
#endif
        if (DBG_P10VAR == 1) { EpiNull<0> E0{(float*)(F.ws + WS_META) + 8}; pg8::gemm_phase<EpiNull<0>, SchedMoe, true, true, false>(F.lds, g, S, E0); }
        if (DBG_P10VAR == 2) { EpiNull<1> E0{(float*)(F.ws + WS_META) + 8}; pg8::gemm_phase<EpiNull<1>, SchedMoe, true, true, false>(F.lds, g, S, E0); }
        pg8::gemm_phase<EpiDown, SchedMoe, true, true, false, true>(F.lds, g, S, E);
    } SEAM(10);
    if (IN(11)) { const int NTR = ((const int*)(F.ws + WS_META))[0];
        pg8::Gemm g{(const bf16*)(F.ws + WS_ACT), (const bf16*)(F.ws + WS_WDN), 0, 0, ED / 2};
        SchedMoe S{F.G, (int)blockIdx.x, 512, NTR, 2, 0, 4, TE, TOK};
        EpiComb E{F.out, (const unsigned char*)(F.ws + WS_Y), (const int*)(F.ws + WS_POS), (const float*)(F.ws + WS_MOD), NTR};
        pg8::gemm_phase<EpiComb, SchedMoe, true, true, false, true>(F.lds, g, S, E);
    }
#undef IN
#undef SEAM

}

#ifndef DBG_A6
#define DBG_A6 WS_U
#endif
#ifndef DBG_SKIP
#define DBG_SKIP 0
#endif
#ifndef DBG_NPH
#define DBG_NPH NPHASE
#endif
#ifndef N_LAUNCH_MODE
#define N_LAUNCH_MODE 1
#endif
extern "C" void kernel_launch(void* const* d_in, const int* in_sizes, int n_in, void* d_out, int out_size, void* d_ws, size_t ws_size, hipStream_t stream) {
    static int grid = 0;
    if (grid == 0) {
        if (n_in != 28 || out_size != T * D || ws_size < WS_END) { fprintf(stderr, "kernel_launch: unexpected problem (n_in %d out %d ws %zu)\n", n_in, out_size, ws_size); grid = -1; return; }
        int dev = 0, cus = 0, per_cu = 0;
        if (hipGetDevice(&dev) != hipSuccess || hipDeviceGetAttribute(&cus, hipDeviceAttributeMultiprocessorCount, dev) != hipSuccess) { grid = -1; return; }
        if (hipFuncSetAttribute((const void*)fwd_kernel, hipFuncAttributeMaxDynamicSharedMemorySize, LDS_BYTES) != hipSuccess) { grid = -1; return; }
        if (hipOccupancyMaxActiveBlocksPerMultiprocessor(&per_cu, (const void*)fwd_kernel, NTHREADS, LDS_BYTES) != hipSuccess || per_cu < 1) { fprintf(stderr, "kernel_launch: occupancy query says %d\n", per_cu); }
        (void)hipGetLastError();
        grid = cus;
    }
    if (grid < 0) return;
    (void)hipMemsetAsync((char*)d_ws + WS_CTL, 0, CTL_ZERO_BYTES, stream);
    Args a{};
    for (int i = 0; i < 28; ++i) a.in[i] = d_in[i];
    a.out = (float*)d_out; a.ws = (unsigned char*)d_ws;
    if (N_LAUNCH_MODE == 1) { a.ph_lo = 0; a.ph_hi = NPHASE; hipLaunchKernelGGL(fwd_kernel, dim3(grid), dim3(NTHREADS), LDS_BYTES, stream, a); }
    else { for (int p = 0; p < DBG_NPH; ++p) { if ((DBG_SKIP >> p) & 1) continue; a.ph_lo = p; a.ph_hi = p + 1; hipLaunchKernelGGL(fwd_kernel, dim3(grid), dim3(NTHREADS), LDS_BYTES, stream, a); } }
}
```

```cpp
#include <hip/hip_runtime.h>
#include <cstdio>
#include <cstdint>

#define GAS __attribute__((address_space(1)))
#define LAS __attribute__((address_space(3)))
typedef unsigned short bf16;
typedef short bf16x8 __attribute__((ext_vector_type(8)));
typedef short s16x4 __attribute__((ext_vector_type(4)));
typedef float f32x4 __attribute__((ext_vector_type(4)));
typedef float f32x2 __attribute__((ext_vector_type(2)));
typedef float f32x16 __attribute__((ext_vector_type(16)));
typedef unsigned u32x4 __attribute__((ext_vector_type(4)));
typedef unsigned u32x2 __attribute__((ext_vector_type(2)));
typedef int i32x4 __attribute__((ext_vector_type(4)));

constexpr int NB = 2, SEQ = 16384, T = NB * SEQ, D = 1024, NIN = 7168;
constexpr int NE = 64, TOPK = 8, ED = 256, NEX = NE + 1;
constexpr float EPS = 1e-6f;
constexpr float C2 = 0.125f * 1.4426950408889634f;
constexpr float MG_SCALE = 8.f;
constexpr float QSC = 4.f, PBIAS = 60.f;
constexpr float LAMBDA_INIT = 0.2f;
constexpr int NWAVES = 8, NTHREADS = 512;

constexpr size_t MiB = 1u << 20;
constexpr size_t WS_CTL = 0, CTL_ZERO_BYTES = 64 * 1024;
constexpr size_t WS_MOD = 1 * MiB;
constexpr size_t WS_ROPE = 1 * MiB + 64 * 1024;
constexpr size_t WS_TKE = 3 * MiB + 256 * 1024;
constexpr size_t WS_TKR = 4 * MiB + 256 * 1024;
constexpr size_t WS_TKW = 5 * MiB + 256 * 1024;
constexpr size_t WS_POS = 6 * MiB + 256 * 1024;
constexpr size_t WS_CNT = 7 * MiB + 256 * 1024;
constexpr size_t WS_TE = WS_CNT + 64 * 1024;
constexpr size_t WS_META = WS_TE + 8 * 1024;
constexpr size_t WS_TOK = 7 * MiB + 512 * 1024;
constexpr size_t WS_WGT = 8 * MiB + 768 * 1024;
constexpr int RMAX = 262144 + 64 * 256 + T;
static_assert(WS_TOK + (size_t)RMAX * 4 <= WS_WGT && WS_WGT + (size_t)RMAX * 4 <= 10 * MiB, "small region");
constexpr size_t WS_WRH = 10 * MiB, WS_WRL = 10 * MiB + 128 * 1024;
constexpr size_t WS_WDN = 11 * MiB;
constexpr size_t WS_WIN = WS_WDN + (size_t)NEX * 1024 * 256 * 2 + MiB / 2;
constexpr size_t WS_WPW2 = WS_WIN + 14 * MiB, WS_WOUT = WS_WPW2 + 2 * MiB;
constexpr size_t WS_WGU = WS_WOUT + 2 * MiB;
constexpr size_t WS_U = 127 * MiB;
constexpr size_t WS_Q = WS_U + 64 * MiB, WS_K = WS_Q + 64 * MiB, WS_V = WS_K + 64 * MiB, WS_GC = WS_V + 64 * MiB, WS_GA = WS_GC + 64 * MiB;
constexpr size_t WS_END = WS_GA + 64 * MiB;
static_assert(WS_WGU + (size_t)NEX * 512 * 1024 * 2 <= WS_U && WS_END <= 512 * MiB, "ws map");
constexpr size_t WS_X1 = WS_GA;
constexpr size_t WS_ACT = 359 * MiB;
constexpr size_t WS_Y = 44 * MiB;
static_assert(WS_ACT + (size_t)RMAX * 256 <= WS_X1 && WS_X1 + (size_t)T * D * 2 <= WS_END && WS_Y + (size_t)(262144 + 64 * 256) * 1024 <= WS_ACT && WS_Y >= WS_WDN + (size_t)NEX * 1024 * 256 * 2, "moe overlays");
constexpr int CW_BAR = 1024;

#ifndef DBG_A6
#define DBG_A6 WS_U
#endif
constexpr int RING_BYTES = 131072;
constexpr int LDS_BYTES = 163840;
constexpr int EPI_SCR = RING_BYTES;
constexpr int MISC_OFF = LDS_BYTES - 256;

#define LDS_WAIT() asm volatile("s_waitcnt lgkmcnt(0)" ::: "memory")
#define VM_WAIT() asm volatile("s_waitcnt vmcnt(0)" ::: "memory")
typedef __bf16 bf16x2_t __attribute__((ext_vector_type(2)));
__device__ __forceinline__ unsigned cvt_pk_bf16(float lo, float hi) { const f32x2 v = {lo, hi}; const bf16x2_t b = __builtin_convertvector(v, bf16x2_t); return __builtin_bit_cast(unsigned, b); }
__device__ __forceinline__ float bf_lo(unsigned u) { return __builtin_bit_cast(float, u << 16); }
__device__ __forceinline__ float bf_hi(unsigned u) { return __builtin_bit_cast(float, u & 0xffff0000u); }
__device__ __forceinline__ float sigmoidf_(float x) { return __builtin_amdgcn_rcpf(1.f + __expf(-x)); }
template <int CTRL, int ROWMASK = 0xF>
__device__ __forceinline__ float dppf(float v) { return __builtin_bit_cast(float, __builtin_amdgcn_update_dpp(0, __builtin_bit_cast(int, v), CTRL, ROWMASK, 0xF, ROWMASK == 0xF)); }
__device__ __forceinline__ float row16_sum(float v) { v += dppf<0xB1>(v); v += dppf<0x4E>(v); v += dppf<0x141>(v); v += dppf<0x140>(v); return v; }
__device__ __forceinline__ float wave_sum(float v) {
    v = row16_sum(v);
    v += dppf<0x142, 0xA>(v);
    v += dppf<0x143, 0xC>(v);
    return __builtin_bit_cast(float, __builtin_amdgcn_readlane(__builtin_bit_cast(int, v), 63));
}
__device__ __forceinline__ float wave_max(float v) {
#pragma unroll
    for (int o = 1; o < 64; o <<= 1) v = fmaxf(v, __shfl_xor(v, o));
    return v;
}

namespace pg8 {
typedef int i32x8_t __attribute__((ext_vector_type(8)));
typedef int i32x4_t __attribute__((ext_vector_type(4)));
constexpr int BM = 256, BK = 64, HALF = 128, HTB = HALF * BK * 2, STAGE_BYTES = 8 * HTB, NXCD = 8, WGM = 8;
__host__ __device__ __forceinline__ int lds_byte(int r, int c) { const int st = (r >> 4) * 2 + (c >> 5), rr = r & 15, cc = c & 31, ob = rr * 64 + cc * 2; return st * 1024 + (ob ^ (((ob >> 9) & 1) << 5)); }
__host__ __device__ __forceinline__ void stage_rc(int b, int& R, int& C) { const int st = b / 1024, sb = b % 1024, swz = sb ^ (((sb >> 9) & 1) << 5); R = (st >> 1) * 16 + swz / 64; C = (st & 1) * 32 + (swz % 64) / 2; }
__host__ __device__ __forceinline__ int perm32(int rho) { const int n = rho >> 4, i = rho & 15; return 8 * (i >> 2) + 4 * n + (i & 3); }

struct Unit { int pm, pn; };
struct Gemm { const bf16* A; const bf16* Bt; int M, N, K; };

struct StaticOrder {
    int nM, nN, nwg, G, c;
    const int* tok;
    __host__ __device__ void init(int M, int N, int G_, int c_) { nM = M / BM; nN = N / BM; nwg = nM * nN; G = G_; c = c_; tok = nullptr; }
    __host__ __device__ bool next(int i, Unit& u) const {
        const long L = (long)i * G + c; if (L >= nwg) return false;
        int wgid = (int)L; { const int q = nwg / NXCD, r = nwg % NXCD, xcd = wgid % NXCD, off = wgid / NXCD; wgid = (xcd < r ? xcd * (q + 1) : r * (q + 1) + (xcd - r) * q) + off; }
        const int nig = WGM * nN, gid = wgid / nig, fm = gid * WGM, gsz = (nM - fm) < WGM ? (nM - fm) : WGM;
        u.pm = fm + ((wgid % nig) % gsz); u.pn = (wgid % nig) / gsz; return true;
    }
};

template <class Epi, class Sched, bool ALIGN_EPI, bool SP2, bool GATHER, bool FP8 = false>
__device__ __forceinline__ void gemm_phase(LAS unsigned char* lds, const Gemm g, const Sched& S, const Epi& E) {
    const int tid = threadIdx.x, wid = __builtin_amdgcn_readfirstlane(tid >> 6), lane = tid & 63, wr = wid >> 2, wc = wid & 3, fr = lane & 15, fq = lane >> 4;
    const int K = g.K, nt = K / BK;
    unsigned voffA[2], voffB[2]; int RA[2]; unsigned CA2[2];
#pragma unroll
    for (int i = 0; i < 2; ++i) { int R, C; stage_rc(tid * 16 + i * 8192, R, C); const int Rb = Epi::PERM ? ((R & ~31) + perm32(R & 31)) : R;
        voffA[i] = (unsigned)(R * K + C) * 2u; voffB[i] = (unsigned)(Rb * K + C) * 2u; RA[i] = R; CA2[i] = (unsigned)C * 2u; }
    const size_t kstep = (size_t)(BK * 2);
    const size_t hstep = (size_t)HALF * K * 2;
    const size_t tstep = 2 * hstep;
    const unsigned ldsw = (unsigned)wid * 1024u;
    const int aoff = lds_byte(wr * 64 + fr, fq * 8), boff = lds_byte(wc * 32 + fr, fq * 8);
#define PG8_SA(b, h) (((b) * 2 + (h)) * HTB)
#define PG8_SB(b, h) ((4 + (b) * 2 + (h)) * HTB)
#define PG8_STAGE2(bufoff, gbase, o0, o1) do { \
        __builtin_amdgcn_global_load_lds((const unsigned*)((const char*)(gbase) + (o0)), (LAS unsigned*)(lds + (bufoff) + ldsw), 16, 0, 0); \
        __builtin_amdgcn_global_load_lds((const unsigned*)((const char*)(gbase) + (o1)), (LAS unsigned*)(lds + (bufoff) + ldsw + 8192), 16, 0, 0); } while (0)
#define PG8_STAGEB(bufoff, gbase) PG8_STAGE2(bufoff, gbase, voffB[0], voffB[1])
#define PG8_STAGEA(bufoff, gbase, h, o0, o1) do { if constexpr (GATHER) { PG8_STAGE2(bufoff, gbase, o0, o1); } else { PG8_STAGE2(bufoff, (gbase) + (h) * hstep, voffA[0], voffA[1]); } } while (0)
#define PG8_LD8(p) __builtin_shufflevector(*(const LAS i32x4_t*)(p), *(const LAS i32x4_t*)((p) + 1024), 0, 1, 2, 3, 4, 5, 6, 7)
#define PG8_LDA(dst, b, h) do { if constexpr (FP8) { _Pragma("unroll") for (int m = 0; m < 4; ++m) dst##8[m] = PG8_LD8(lds + PG8_SA(b, h) + aoff + m * 2048); } \
        else { _Pragma("unroll") for (int m = 0; m < 4; ++m) _Pragma("unroll") for (int k = 0; k < 2; ++k) dst[m][k] = *(const LAS bf16x8*)(lds + PG8_SA(b, h) + aoff + m * 2048 + k * 1024); } } while (0)
#define PG8_LDB(dst, b, h) do { if constexpr (FP8) { _Pragma("unroll") for (int n = 0; n < 2; ++n) dst##8[n] = PG8_LD8(lds + PG8_SB(b, h) + boff + n * 2048); } \
        else { _Pragma("unroll") for (int n = 0; n < 2; ++n) _Pragma("unroll") for (int k = 0; k < 2; ++k) dst[n][k] = *(const LAS bf16x8*)(lds + PG8_SB(b, h) + boff + n * 2048 + k * 1024); } } while (0)
#define PG8_CAT(x) __builtin_shufflevector(__builtin_bit_cast(i32x4_t, (x)[0]), __builtin_bit_cast(i32x4_t, (x)[1]), 0, 1, 2, 3, 4, 5, 6, 7)
#define PG8_MMA(ai, bj, At, Bt) do { __builtin_amdgcn_s_setprio(1); \
        if constexpr (FP8) { _Pragma("unroll") for (int m = 0; m < 4; ++m) _Pragma("unroll") for (int n = 0; n < 2; ++n) \
            asm volatile("v_mfma_f32_16x16x128_f8f6f4 %0, %1, %2, %0" : "+v"(acc[ai][bj][m][n]) : "v"(Bt##8[n]), "v"(At##8[m])); }   \
        else { _Pragma("unroll") for (int m = 0; m < 4; ++m) _Pragma("unroll") for (int n = 0; n < 2; ++n) _Pragma("unroll") for (int k = 0; k < 2; ++k) \
            acc[ai][bj][m][n] = __builtin_amdgcn_mfma_f32_16x16x32_bf16(Bt[n][k], At[m][k], acc[ai][bj][m][n], 0, 0, 0); } \
        __builtin_amdgcn_s_setprio(0); } while (0)
#define PG8_WAIT_V(n) asm volatile("s_waitcnt vmcnt(" #n ")" ::: "memory")
#define PG8_WAIT_L(n) asm volatile("s_waitcnt lgkmcnt(" #n ")" ::: "memory")
#define PG8_BAR __builtin_amdgcn_s_barrier()
#define PG8_SCHED __builtin_amdgcn_sched_barrier(0)
#define PG8_SETA(o, u) do { _Pragma("unroll") for (int h_ = 0; h_ < 2; ++h_) _Pragma("unroll") for (int i_ = 0; i_ < 2; ++i_) { \
        if constexpr (GATHER) { int t_ = S.tok[(u).pm * 256 + h_ * 128 + RA[i_]]; t_ = t_ < 0 ? 0 : t_; o[h_][i_] = (unsigned)t_ * (unsigned)(K * 2) + CA2[i_]; } \
        else { o[h_][i_] = (unsigned)(h_ * hstep) + voffA[i_]; } } } while (0)
    Unit cur, nxt; int ui = 0;
    if (!S.next(0, cur)) return;
    f32x4 acc[2][2][4][2];
#pragma unroll
    for (int a = 0; a < 2; ++a)
#pragma unroll
        for (int b = 0; b < 2; ++b)
#pragma unroll
            for (int m = 0; m < 4; ++m)
#pragma unroll
                for (int n = 0; n < 2; ++n) acc[a][b][m][n] = (f32x4){0.f, 0.f, 0.f, 0.f};
    bf16x8 At[4][2], B0[2][2], B1[2][2];
    i32x8_t At8[4], B08[2], B18[2];
    unsigned cO[2][2], nO[2][2];
    if constexpr (GATHER) { PG8_SETA(cO, cur); VM_WAIT(); }
    else { cO[0][0] = cO[0][1] = cO[1][0] = cO[1][1] = 0u; }
    const char* cA = GATHER ? (const char*)g.A : (const char*)g.A + (size_t)cur.pm * tstep; const char* cB = (const char*)g.Bt + (size_t)cur.pn * tstep;
    if constexpr (SP2) {
        PG8_STAGEB(PG8_SB(0, 0), cB); PG8_STAGEB(PG8_SB(0, 1), cB + hstep); PG8_STAGEA(PG8_SA(0, 0), cA, 0, cO[0][0], cO[0][1]); PG8_STAGEA(PG8_SA(0, 1), cA, 1, cO[1][0], cO[1][1]);
        if (wr == 1) PG8_BAR;
        PG8_WAIT_V(2); PG8_BAR;
        PG8_STAGEB(PG8_SB(1, 0), cB + kstep); PG8_STAGEA(PG8_SA(1, 0), cA + kstep, 0, cO[0][0], cO[0][1]); PG8_STAGEB(PG8_SB(1, 1), cB + hstep + kstep);
        PG8_WAIT_V(6); PG8_BAR;
    }
    for (;;) {
        const bool has_next = S.next(ui + 1, nxt);
        if constexpr (!GATHER) { nO[0][0] = nO[0][1] = nO[1][0] = nO[1][1] = 0u; }
        else if (has_next) { PG8_SETA(nO, nxt); } else {
#pragma unroll
            for (int h_ = 0; h_ < 2; ++h_)
#pragma unroll
                for (int i_ = 0; i_ < 2; ++i_) nO[h_][i_] = cO[h_][i_]; }
        const char* nA = GATHER ? (const char*)g.A : (has_next ? (const char*)g.A + (size_t)nxt.pm * tstep : cA);
        const char* nB = has_next ? (const char*)g.Bt + (size_t)nxt.pn * tstep : cB;
#pragma nounroll
        for (int t = 0; t < nt; t += 2) {
            const bool last = (t == nt - 2);
            const char* a1 = cA + (size_t)(t + 1) * kstep;
            const char* a2 = last ? nA : cA + (size_t)(t + 2) * kstep; const char* b2 = last ? nB : cB + (size_t)(t + 2) * kstep;
            const char* a3 = a2 + kstep; const char* b3 = b2 + kstep;
            const unsigned x00 = last ? nO[0][0] : cO[0][0], x01 = last ? nO[0][1] : cO[0][1], x10 = last ? nO[1][0] : cO[1][0], x11 = last ? nO[1][1] : cO[1][1];
            PG8_LDB(B0, 0, 0); PG8_LDB(B1, 0, 1); PG8_SCHED; PG8_LDA(At, 0, 0); PG8_STAGEA(PG8_SA(1, 1), a1, 1, cO[1][0], cO[1][1]);
            PG8_WAIT_V(8); PG8_WAIT_L(0); PG8_BAR; PG8_MMA(0, 0, At, B0); PG8_MMA(0, 1, At, B1); PG8_BAR; PG8_SCHED;
            PG8_LDA(At, 0, 1); PG8_STAGEB(PG8_SB(0, 0), b2); PG8_STAGEB(PG8_SB(0, 1), b2 + hstep); PG8_STAGEA(PG8_SA(0, 0), a2, 0, x00, x01);
            PG8_WAIT_V(8); PG8_WAIT_L(0); PG8_BAR; PG8_MMA(1, 0, At, B0); PG8_MMA(1, 1, At, B1); PG8_BAR; PG8_SCHED;
            PG8_LDB(B0, 1, 0); PG8_LDB(B1, 1, 1); PG8_SCHED; PG8_LDA(At, 1, 0); PG8_STAGEA(PG8_SA(0, 1), a2, 1, x10, x11);
            PG8_WAIT_V(8); PG8_WAIT_L(0); PG8_BAR; PG8_MMA(0, 0, At, B0); PG8_MMA(0, 1, At, B1); PG8_BAR; PG8_SCHED;
            PG8_LDA(At, 1, 1); PG8_STAGEB(PG8_SB(1, 0), b3); PG8_STAGEB(PG8_SB(1, 1), b3 + hstep); PG8_STAGEA(PG8_SA(1, 0), a3, 0, x00, x01);
            PG8_WAIT_V(8); PG8_WAIT_L(0); PG8_BAR; PG8_MMA(1, 0, At, B0); PG8_MMA(1, 1, At, B1); PG8_BAR; PG8_SCHED;
        }
        if constexpr (ALIGN_EPI) { if (wr == 0) PG8_BAR; }
        if constexpr (FP8) asm volatile("s_nop 15\n\ts_nop 15" ::: "memory");
        E(acc, cur, wr, wc, fr, fq);
        if (!has_next) break;
#pragma unroll
        for (int a = 0; a < 2; ++a)
#pragma unroll
            for (int b = 0; b < 2; ++b)
#pragma unroll
                for (int m = 0; m < 4; ++m)
#pragma unroll
                    for (int n = 0; n < 2; ++n) acc[a][b][m][n] = (f32x4){0.f, 0.f, 0.f, 0.f};
        cur = nxt; cA = nA; cB = nB; ++ui;
#pragma unroll
        for (int h_ = 0; h_ < 2; ++h_)
#pragma unroll
            for (int i_ = 0; i_ < 2; ++i_) cO[h_][i_] = nO[h_][i_];
        if constexpr (ALIGN_EPI) { if (wr == 1) PG8_BAR; }
    }
    PG8_WAIT_V(0);
    if constexpr (!ALIGN_EPI) { if (wr == 0) PG8_BAR; }
    PG8_BAR;
#undef PG8_SA
#undef PG8_SB
#undef PG8_STAGE2
#undef PG8_STAGEB
#undef PG8_STAGEA
#undef PG8_LDA
#undef PG8_LD8
#undef PG8_LDB
#undef PG8_MMA
#undef PG8_CAT
#undef PG8_WAIT_V
#undef PG8_WAIT_L
#undef PG8_BAR
#undef PG8_SCHED
#undef PG8_SETA
}
}

#define XB_TMO      128
#define XB_XCNT(j)  (256  + 64 * (j))
#define XB_XSUB(j)  (1280 + 64 * (j))
#define XB_XGEN(j)  (2304 + 64 * (j))
#define XB_TOP      3328
#define XB_TOPGEN   3392
#define XCD_BAR_WORDS 3456
#define XB_SPIN_CAP (1u << 18)
__device__ __forceinline__ unsigned xb_ld(unsigned* p)              { return __hip_atomic_load(p, __ATOMIC_RELAXED, __HIP_MEMORY_SCOPE_AGENT); }
__device__ __forceinline__ unsigned xb_add(unsigned* p, unsigned v) { return __hip_atomic_fetch_add(p, v, __ATOMIC_RELAXED, __HIP_MEMORY_SCOPE_AGENT); }
__device__ __forceinline__ unsigned xb_xcc_id() { return (unsigned)__builtin_amdgcn_s_getreg((3 << 11) | 20) & 0xFu; }
#define XB_SPIN(cond, bar) do { unsigned _sp = 0; while (cond) { __builtin_amdgcn_s_sleep(1); \
    if ((++_sp & 255u) == 0u) { if (xb_ld(&(bar)[XB_TMO])) break; if (_sp > XB_SPIN_CAP) { atomicAdd(&(bar)[XB_TMO], 1u); break; } } } } while (0)
struct XcdBarrier { unsigned* bar; unsigned x; volatile LAS unsigned* st; };
__device__ __forceinline__ XcdBarrier xcd_barrier_post(unsigned* bar, volatile LAS unsigned* st) {
    XcdBarrier b; b.bar = bar; b.x = xb_xcc_id(); b.st = st;
    if (threadIdx.x == 0) (void)xb_add(&bar[XB_XCNT(b.x)], 1u);
    return b;
}
__device__ __forceinline__ void xcd_barrier_complete(unsigned* bar, unsigned x, unsigned& nloc, unsigned& nx) {
    const unsigned G = gridDim.x * gridDim.y * gridDim.z;
    unsigned sum, cnt, mine, sp = 0u;
    for (;;) {
        sum = 0u; cnt = 0u; mine = 0u;
#pragma unroll
        for (unsigned j = 0; j < 16; ++j) { const unsigned c = xb_ld(&bar[XB_XCNT(j)]); sum += c; cnt += (c > 0u) ? 1u : 0u; mine = (j == x) ? c : mine; }
        if (sum == G) break;
        __builtin_amdgcn_s_sleep(1);
        if ((++sp & 255u) == 0u) { if (xb_ld(&bar[XB_TMO])) break; if (sp > XB_SPIN_CAP) { atomicAdd(&bar[XB_TMO], 1u); break; } }
    }
    nloc = mine > 0u ? mine : 1u; nx = cnt > 0u ? cnt : 1u;
}
__device__ __forceinline__ void xcd_barrier(const XcdBarrier& b) {
    asm volatile("s_waitcnt vmcnt(0)" ::: "memory");
    __syncthreads();
    if (threadIdx.x == 0) {
        unsigned* bar = b.bar;
        __builtin_amdgcn_s_waitcnt(0);
        unsigned nloc = b.st[0], nx = b.st[1];
        if (nloc == 0u) { xcd_barrier_complete(bar, b.x, nloc, nx); b.st[0] = nloc; b.st[1] = nx; }
        const unsigned old = xb_add(&bar[XB_XSUB(b.x)], 1u);
        const unsigned gen = old / nloc;
        if (old + 1u == (gen + 1u) * nloc) {
            __builtin_amdgcn_fence(__ATOMIC_RELEASE, "agent");
            asm volatile("s_waitcnt vmcnt(0)" ::: "memory");
            const unsigned og = xb_add(&bar[XB_TOP], 1u);
            const unsigned tg = og / nx;
            if (og + 1u == (tg + 1u) * nx) xb_add(&bar[XB_TOPGEN], 1u);
            else XB_SPIN(xb_ld(&bar[XB_TOPGEN]) == tg, bar);
            __builtin_amdgcn_fence(__ATOMIC_ACQUIRE, "agent");
            xb_add(&bar[XB_XGEN(b.x)], 1u);
            asm volatile("s_waitcnt vmcnt(0)" ::: "memory");
        } else {
            XB_SPIN(xb_ld(&bar[XB_XGEN(b.x)]) == gen, bar);
            __builtin_amdgcn_fence(__ATOMIC_ACQUIRE, "agent");
            asm volatile("s_waitcnt vmcnt(0)" ::: "memory");
        }
    }
    __syncthreads();
}

struct Args { const void* in[28]; float* out; unsigned char* ws; int ph_lo, ph_hi; };
struct Frame {
    LAS unsigned char* lds;
    int tid, lane, wave, vcu, G;
    unsigned char* ws; float* out;
    const __attribute__((address_space(4))) unsigned char* ka;
    __device__ __forceinline__ const float* in(int i) const { return ((const float* const __attribute__((address_space(4)))*)ka)[i]; }
};
enum { I_X = 0, I_C, I_POS, I_WADA, I_BADA, I_N1G, I_WIN, I_CDW, I_CDWB, I_CLNG, I_CLNB, I_WPW2, I_BPW2, I_QNG, I_KNG, I_LQ1, I_LK1, I_LQ2, I_LK2, I_SUBG, I_WOUT, I_N2G, I_WR, I_RB, I_WEGU, I_WEDN, I_WSGU, I_WSDN };

__device__ __forceinline__ int win_map(int n) {
    if (n < 1024) return 256 * (n >> 7) + (n & 127);
    if (n < 2048) { const int j = n - 1024; return 256 * (j >> 7) + 128 + (j & 127); }
    if (n < 4096) { const int qk = (n - 2048) >> 10, j = (n - 2048) & 1023, g = j >> 6, dl = j & 63; const int tile = 8 + 4 * qk + (g >> 2), wc = g & 3;
        int bj, fq, e; if (dl < 8) { bj = 0; fq = 0; e = dl; } else if (dl < 16) { bj = 1; fq = 0; e = dl - 8; } else { const int rho = dl - 16; bj = rho / 24; fq = 1 + (rho % 24) / 8; e = rho & 7; }
        return 256 * tile + 128 * bj + 32 * wc + 8 * fq + e; }
    return n;
}
__device__ __forceinline__ int glu_map(int n) { const int j = n & 255; return 256 * (j >> 7) + ((n >> 8) << 7) + (j & 127); }
__device__ __forceinline__ int qk_dim(int bj, int fq, int e) { return fq == 0 ? bj * 8 + e : 16 + bj * 24 + (fq - 1) * 8 + e; }

template <int MAP>
__device__ __forceinline__ void transpose_item(const float* W, int K, int N, bf16* WT, LAS float* scr, int item, int lane) {
    const int nblk = N / 32, kb = item / nblk, nb = item % nblk, k0 = 64 * kb, n0 = 32 * nb;
    {
        const int rr = lane >> 3, c4 = (lane & 7) * 4; f32x4 t[8];
#pragma unroll
        for (int i = 0; i < 8; ++i) t[i] = __builtin_nontemporal_load((const f32x4*)(W + (size_t)(k0 + 8 * i + rr) * N + n0 + c4));
#pragma unroll
        for (int i = 0; i < 8; ++i) { LAS float* d = scr + (8 * i + rr) * 33 + c4; d[0] = t[i].x; d[1] = t[i].y; d[2] = t[i].z; d[3] = t[i].w; }
    }
    LDS_WAIT(); asm volatile("" ::: "memory");
    const int c = lane & 7;
#pragma unroll
    for (int j = 0; j < 4; ++j) { const int n = (lane >> 3) + 8 * j; const LAS float* s = scr + (8 * c) * 33 + n;
        u32x4 o; o.x = cvt_pk_bf16(s[0 * 33], s[1 * 33]); o.y = cvt_pk_bf16(s[2 * 33], s[3 * 33]); o.z = cvt_pk_bf16(s[4 * 33], s[5 * 33]); o.w = cvt_pk_bf16(s[6 * 33], s[7 * 33]);
        const int nn = n0 + n; const int row = MAP == 1 ? win_map(nn) : (MAP == 2 ? glu_map(nn) : nn);
        *(u32x4*)(WT + (size_t)row * K + k0 + 8 * c) = o; }
    LDS_WAIT(); asm volatile("" ::: "memory");
}

constexpr float WDN_SCALE = 16.f, ACT_SCALE = 8.f;
constexpr float WIN_SCALE = 32.f;
template <int MAP>
__device__ __forceinline__ void transpose_item8(const float* W, int K, int N, unsigned char* WT, LAS float* scr, int item, int lane, float scale = WIN_SCALE) {
    const int nblk = N / 32, kb = item / nblk, nb = item % nblk, k0 = 64 * kb, n0 = 32 * nb;
    {
        const int rr = lane >> 3, c4 = (lane & 7) * 4; f32x4 t[8];
#pragma unroll
        for (int i = 0; i < 8; ++i) t[i] = __builtin_nontemporal_load((const f32x4*)(W + (size_t)(k0 + 8 * i + rr) * N + n0 + c4));
#pragma unroll
        for (int i = 0; i < 8; ++i) { LAS float* d = scr + (8 * i + rr) * 33 + c4; d[0] = t[i].x * scale; d[1] = t[i].y * scale; d[2] = t[i].z * scale; d[3] = t[i].w * scale; }
    }
    LDS_WAIT(); asm volatile("" ::: "memory");
    const int c = lane & 7;
#pragma unroll
    for (int j = 0; j < 4; ++j) { const int n = (lane >> 3) + 8 * j; const LAS float* sp = scr + (8 * c) * 33 + n;
        int d0 = 0, d1 = 0;
        d0 = __builtin_amdgcn_cvt_pk_fp8_f32(sp[0 * 33], sp[1 * 33], d0, false); d0 = __builtin_amdgcn_cvt_pk_fp8_f32(sp[2 * 33], sp[3 * 33], d0, true);
        d1 = __builtin_amdgcn_cvt_pk_fp8_f32(sp[4 * 33], sp[5 * 33], d1, false); d1 = __builtin_amdgcn_cvt_pk_fp8_f32(sp[6 * 33], sp[7 * 33], d1, true);
        const int nn = n0 + n; const int row = MAP == 1 ? win_map(nn) : (MAP == 2 ? glu_map(nn) : nn);
        *(u32x2*)(WT + (size_t)row * K + k0 + 8 * c) = (u32x2){(unsigned)d0, (unsigned)d1}; }
    LDS_WAIT(); asm volatile("" ::: "memory");
}
__device__ __forceinline__ void phase0(Frame& F) {
    if (F.vcu < 96) {
        const int col = F.vcu * 64 + F.lane; const float* c = F.in(I_C); const float* wa = F.in(I_WADA);
        float a0 = 0.f, a1 = 0.f;
        LAS float* sc = (LAS float*)F.lds + 4096;
#pragma unroll
        for (int q = 0; q < 4; ++q) { const int i = F.tid + 512 * q; const float cv = c[i]; sc[i] = cv * sigmoidf_(cv); }
        __syncthreads();
        for (int k = F.wave * 128; k < F.wave * 128 + 128; k += 16) { float w[16];
#pragma unroll
            for (int u = 0; u < 16; ++u) w[u] = wa[(size_t)(k + u) * 6144 + col];
#pragma unroll
            for (int u = 0; u < 16; ++u) { a0 += sc[k + u] * w[u]; a1 += sc[1024 + k + u] * w[u]; } }
        LAS float* red = (LAS float*)F.lds;
        red[(F.wave * 2 + 0) * 64 + F.lane] = a0; red[(F.wave * 2 + 1) * 64 + F.lane] = a1;
        __syncthreads();
        if (F.wave == 0) { float s0 = 0.f, s1 = 0.f;
#pragma unroll
            for (int w = 0; w < 8; ++w) { s0 += red[(w * 2 + 0) * 64 + F.lane]; s1 += red[(w * 2 + 1) * 64 + F.lane]; }
            float* mod = (float*)(F.ws + WS_MOD); const float bb = F.in(I_BADA)[col]; mod[col] = s0 + bb; mod[6144 + col] = s1 + bb; }
        __syncthreads();
    }
    LAS float* scr = (LAS float*)(F.lds + F.wave * 16384);
    const int gw = F.vcu * NWAVES + F.wave, NGW = F.G * NWAVES;
    constexpr int I_IN = 16 * (NIN / 32), I_SQ = 16 * 32, I_EGU = 16 * 16, I_EDN = 4 * 32;
    constexpr int NITEMS = I_IN + 2 * I_SQ + NEX * I_EGU + NEX * I_EDN;
    auto do_item = [&](int it) {
        int r = it;
        if (r < I_IN) { transpose_item8<1>(F.in(I_WIN), 1024, NIN, (unsigned char*)(F.ws + WS_WIN), scr, r, F.lane); return; } r -= I_IN;
        if (r < I_SQ) { transpose_item8<0>(F.in(I_WPW2), 1024, 1024, (unsigned char*)(F.ws + WS_WPW2), scr, r, F.lane); return; } r -= I_SQ;
        if (r < I_SQ) { transpose_item8<0>(F.in(I_WOUT), 1024, 1024, (unsigned char*)(F.ws + WS_WOUT), scr, r, F.lane); return; } r -= I_SQ;
        if (r < NEX * I_EGU) { const int e = r / I_EGU, rr = r % I_EGU; const float* W = e < NE ? F.in(I_WEGU) + (size_t)e * 1024 * 512 : F.in(I_WSGU);
            transpose_item8<2>(W, 1024, 512, (unsigned char*)(F.ws + WS_WGU) + (size_t)e * 512 * 1024, scr, rr, F.lane); return; } r -= NEX * I_EGU;
        { const int e = r / I_EDN, rr = r % I_EDN; const float* W = e < NE ? F.in(I_WEDN) + (size_t)e * 256 * 1024 : F.in(I_WSDN);
            transpose_item8<0>(W, 256, 1024, (unsigned char*)(F.ws + WS_WDN) + (size_t)e * 1024 * 256, scr, rr, F.lane, WDN_SCALE); }
    };
    const int NMODW = 96 * NWAVES; const bool bal = NGW >= 2 * NMODW, modwg = bal && F.vcu < 96;
    for (int it = gw + (modwg ? NGW : 0); it < NITEMS; it += NGW) do_item(it);
    if (bal && !modwg && gw - NMODW < NMODW) do_item(gw - NMODW);
    {
        const float* wr = F.in(I_WR); bf16* wh = (bf16*)(F.ws + WS_WRH); bf16* wl = (bf16*)(F.ws + WS_WRL);
        for (int idx = F.vcu * NTHREADS + F.tid; idx < 64 * 1024; idx += F.G * NTHREADS) { const int e = idx >> 10, k = idx & 1023; const float w = wr[k * 64 + e];
            const unsigned h = cvt_pk_bf16(w, 0.f) & 0xffffu; const float r = w - bf_lo(h); wh[idx] = (bf16)h; wl[idx] = (bf16)(cvt_pk_bf16(r, 0.f) & 0xffffu); }
    }
    {
        const int* pos = (const int*)F.in(I_POS); float* rope = (float*)(F.ws + WS_ROPE);
        for (int idx = F.vcu * NTHREADS + F.tid; idx < T * 8; idx += F.G * NTHREADS) {
            const int tok = idx >> 3, i = idx & 7;
            const unsigned fb = i == 0 ? 1065353216u : i == 1 ? 1044812719u : i == 2 ? 1025116360u : i == 3 ? 1005516622u : i == 4 ? 985226530u : i == 5 ? 965724408u : i == 6 ? 945754309u : 925697960u;
            const float ang = (float)pos[tok] * __builtin_bit_cast(float, fb);
            double rv = (double)ang * 0.15915494309189535; rv -= floor(rv);
            const float fr_ = (float)rv;
            rope[tok * 16 + i] = __builtin_amdgcn_cosf(fr_); rope[tok * 16 + 8 + i] = __builtin_amdgcn_sinf(fr_);
        }
    }
}

__device__ __forceinline__ void phase1(Frame& F) {
    const float* mod = (const float*)(F.ws + WS_MOD); const float* gn = F.in(I_N1G); unsigned char* H = (unsigned char*)F.out;
    const int gw = F.vcu * NWAVES + F.wave, NGW = F.G * NWAVES, lane = F.lane;
    const float* X = F.in(I_X);
    f32x4 gg[4], sh[4]; int bcur = -1;
    f32x4 va[4][4], vb[4][4];
#define P1_LOAD(V, k_) do { _Pragma("unroll") for (int u = 0; u < 4; ++u) { const int m = gw + ((k_) + u) * NGW; if (m < T) { const f32x4* xr = (const f32x4*)(X + (size_t)m * D) + lane; \
            _Pragma("unroll") for (int j = 0; j < 4; ++j) V[u][j] = __builtin_nontemporal_load(xr + 64 * j); } } } while (0)
#define P1_PROC(V, k_) do { _Pragma("unroll") for (int u = 0; u < 4; ++u) { const int m = gw + ((k_) + u) * NGW; if (m < T) { const int b = m >> 14; \
            if (b != bcur) { bcur = b; _Pragma("unroll") for (int j = 0; j < 4; ++j) { const int col = 4 * lane + 256 * j; \
                const f32x4 g = *(const f32x4*)(gn + col), sc = *(const f32x4*)(mod + b * 6144 + 1024 + col); gg[j] = g * (sc + 1.f); sh[j] = *(const f32x4*)(mod + b * 6144 + col); } } \
            float s = 0.f; _Pragma("unroll") for (int j = 0; j < 4; ++j) s += (V[u][j].x * V[u][j].x + V[u][j].y * V[u][j].y) + (V[u][j].z * V[u][j].z + V[u][j].w * V[u][j].w); \
            const float rstd = __builtin_amdgcn_rsqf(wave_sum(s) * (1.f / D) + EPS); \
            unsigned* o4 = (unsigned*)(H + (size_t)m * D) + lane;            \
            _Pragma("unroll") for (int j = 0; j < 4; ++j) { const f32x4 y = V[u][j] * rstd * gg[j] + sh[j]; \
                int w = 0; w = __builtin_amdgcn_cvt_pk_fp8_f32(y.x, y.y, w, false); w = __builtin_amdgcn_cvt_pk_fp8_f32(y.z, y.w, w, true); o4[64 * j] = (unsigned)w; } } } } while (0)
    P1_LOAD(va, 0);
    for (int k = 0; gw + k * NGW < T; k += 8) {
        P1_LOAD(vb, k + 4);
        P1_PROC(va, k);
        P1_LOAD(va, k + 8);
        P1_PROC(vb, k + 4);
    }
#undef P1_LOAD
#undef P1_PROC
}

struct EpiIn {
    static constexpr bool PERM = true;
    static constexpr float SI = 1.f / WIN_SCALE;
    bf16 *U, *Q, *Kb, *V, *GC, *GA; const float* rope; const float* qg; const float* kg; LAS unsigned char* scr;
    __device__ __forceinline__ void operator()(const f32x4 (&acc)[2][2][4][2], const pg8::Unit& u, int wr, int wc, int fr, int fq) const {
        asm volatile("" : "+v"(fr), "+v"(fq));
        const int pn = u.pn, row0 = u.pm * 256 + wr * 64 + fr;
        if (pn < 8) {
#pragma unroll
            for (int ai = 0; ai < 2; ++ai)
#pragma unroll
                for (int m = 0; m < 4; ++m) { const int row = row0 + ai * 128 + m * 16; float r[8];
#pragma unroll
                    for (int n = 0; n < 2; ++n)
#pragma unroll
                        for (int i = 0; i < 4; ++i) r[4 * n + i] = (acc[ai][0][m][n][i] * SI) * sigmoidf_(acc[ai][1][m][n][i] * SI);
                    u32x4 w; w.x = cvt_pk_bf16(r[0], r[1]); w.y = cvt_pk_bf16(r[2], r[3]); w.z = cvt_pk_bf16(r[4], r[5]); w.w = cvt_pk_bf16(r[6], r[7]);
                    *(u32x4*)(U + (size_t)row * D + pn * 128 + wc * 32 + fq * 8) = w; }
        } else if (pn < 16) {
            const bool isq = pn < 12; const int g = 4 * ((pn - 8) & 3) + wc, h = g >> 1, mp = g & 1;
            const float* gp = isq ? qg : kg; float gn[2][8];
#pragma unroll
            for (int bj = 0; bj < 2; ++bj)
#pragma unroll
                for (int e = 0; e < 8; ++e) gn[bj][e] = gp[qk_dim(bj, fq, e)] * (isq ? C2 * QSC * 2.f : 1.f);
            bf16* dst = isq ? Q : Kb;
#pragma unroll
            for (int ai = 0; ai < 2; ++ai)
#pragma unroll
                for (int m = 0; m < 4; ++m) { const int row = row0 + ai * 128 + m * 16, b = row >> 14, s = row & (SEQ - 1);
                    float v[2][8]; float ss = 0.f;
#pragma unroll
                    for (int bj = 0; bj < 2; ++bj)
#pragma unroll
                        for (int n = 0; n < 2; ++n)
#pragma unroll
                            for (int i = 0; i < 4; ++i) { const float t = acc[ai][bj][m][n][i] * SI; v[bj][4 * n + i] = t; ss += t * t; }
                    ss += __shfl_xor(ss, 16); ss += __shfl_xor(ss, 32);
                    const float rstd = __builtin_amdgcn_rsqf(ss * (1.f / 64.f) + EPS);
#pragma unroll
                    for (int bj = 0; bj < 2; ++bj)
#pragma unroll
                        for (int e = 0; e < 8; ++e) v[bj][e] = v[bj][e] * rstd * gn[bj][e];
                    if (fq == 0) { const f32x4* rp = (const f32x4*)(rope + (size_t)row * 16); const f32x4 c0 = rp[0], c1 = rp[1], s0 = rp[2], s1 = rp[3];
#pragma unroll
                        for (int e = 0; e < 8; ++e) { const float cs = e < 4 ? c0[e & 3] : c1[e & 3], sn = e < 4 ? s0[e & 3] : s1[e & 3]; const float x1 = v[0][e], x2 = v[1][e];
                            v[0][e] = x1 * cs - x2 * sn; v[1][e] = x2 * cs + x1 * sn; } }
                    { f32x16 lo16, hi16;
#pragma unroll
                      for (int i = 0; i < 16; ++i) { const unsigned x = __builtin_bit_cast(unsigned, v[i >> 3][i & 7]); const auto pr = __builtin_amdgcn_permlane16_swap(x, x, false, false);
                          lo16[i] = __builtin_bit_cast(float, (unsigned)pr[0]); hi16[i] = __builtin_bit_cast(float, (unsigned)pr[1]); }
                      typedef unsigned u32x6_t __attribute__((ext_vector_type(6)));
                      const u32x6_t pk = __builtin_amdgcn_cvt_scalef32_2xpk16_fp6_f32(lo16, hi16, 1.0f);
                      unsigned char* rowp = (unsigned char*)dst + ((size_t)((b * 8 + h) * 2 + mp) * SEQ + s) * 64;
                      const int sw = isq ? 0 : ((s >> 2) & 3);
                      if ((fq & 1) == 0) *(u32x4*)(rowp + ((fq ^ sw) << 4)) = (u32x4){pk[0], pk[1], pk[2], pk[3]};
                      else *(u32x2*)(rowp + ((fq ^ sw) << 4)) = (u32x2){pk[4], pk[5]}; } }
        } else if (pn < 20) {
            LAS unsigned char* wsb = scr + (wr * 4 + wc) * 2048; const int lane_ = fr + 16 * fq;
#pragma unroll
            for (int ai = 0; ai < 2; ++ai)
#pragma unroll
                for (int bj = 0; bj < 2; ++bj) {
#pragma unroll
                    for (int m = 0; m < 4; ++m) { const int kk = 16 * m + fr;
                        const int p = 32 * ((kk >> 2) & 1) + 16 * (kk >> 5) + (kk & 3) + 4 * ((kk & 31) >> 3);
#pragma unroll
                        for (int n = 0; n < 2; ++n) { const unsigned d01 = (unsigned)__builtin_amdgcn_cvt_pk_fp8_f32(acc[ai][bj][m][n][0] * SI, acc[ai][bj][m][n][1] * SI, 0, false);
                            const unsigned d23 = (unsigned)__builtin_amdgcn_cvt_pk_fp8_f32(acc[ai][bj][m][n][2] * SI, acc[ai][bj][m][n][3] * SI, 0, false);
#pragma unroll
                            for (int i = 0; i < 4; ++i) { const int e = 4 * n + i; const unsigned byte = ((i < 2 ? d01 : d23) >> (8 * (i & 1)));
                                const int sw = (2 * fq + (e >> 2)) & 3;
                                wsb[(fq * 8 + e) * 64 + ((((p >> 4) ^ sw) << 4) | (p & 15))] = (unsigned char)byte; } } }
                    LDS_WAIT(); asm volatile("" ::: "memory");
                    const u32x4 t0 = *(const LAS u32x4*)(wsb + lane_ * 32), t1 = *(const LAS u32x4*)(wsb + lane_ * 32 + 16);
                    const int row = u.pm * 256 + ai * 128 + wr * 64, b = row >> 14, s = row & (SEQ - 1), h = 2 * (pn - 16) + bj;
                    unsigned char* tp = (unsigned char*)V + (((size_t)(b * 8 + h) * 256 + (s >> 6)) * 128 + wc * 32) * 64 + lane_ * 32;
                    *(u32x4*)tp = t0; *(u32x4*)(tp + 16) = t1;
                    LDS_WAIT(); asm volatile("" ::: "memory"); }
        } else {
            unsigned char* dst = (unsigned char*)(pn < 24 ? GC : GA); const int colt = ((pn - 20) & 3) * 256;
#pragma unroll
            for (int ai = 0; ai < 2; ++ai)
#pragma unroll
                for (int m = 0; m < 4; ++m) { const int row = row0 + ai * 128 + m * 16;
#pragma unroll
                    for (int bj = 0; bj < 2; ++bj) { float r[8];
#pragma unroll
                        for (int n = 0; n < 2; ++n)
#pragma unroll
                            for (int i = 0; i < 4; ++i) r[4 * n + i] = sigmoidf_(acc[ai][bj][m][n][i] * SI) * 255.f;
                        unsigned w0 = __builtin_amdgcn_cvt_pk_u8_f32(r[0], 0u, 0u), w1 = __builtin_amdgcn_cvt_pk_u8_f32(r[4], 0u, 0u);
                        w0 = __builtin_amdgcn_cvt_pk_u8_f32(r[1], 1u, w0); w0 = __builtin_amdgcn_cvt_pk_u8_f32(r[2], 2u, w0); w0 = __builtin_amdgcn_cvt_pk_u8_f32(r[3], 3u, w0);
                        w1 = __builtin_amdgcn_cvt_pk_u8_f32(r[5], 1u, w1); w1 = __builtin_amdgcn_cvt_pk_u8_f32(r[6], 2u, w1); w1 = __builtin_amdgcn_cvt_pk_u8_f32(r[7], 3u, w1);
                        *(u32x2*)(dst + (size_t)row * D + colt + bj * 128 + wc * 32 + fq * 8) = (u32x2){w0, w1}; } }
        }
    }
};

__device__ __forceinline__ void phase3(Frame& F) {
    const bf16* U = (const bf16*)(F.ws + WS_U); bf16* CV = (bf16*)F.out;
    const int ch = 2 * F.tid;
    float wa[31], wb[31];
#pragma unroll
    for (int j = 0; j < 31; ++j) { const f32x2 w = *(const f32x2*)(F.in(I_CDW) + j * 1024 + ch); wa[j] = w.x; wb[j] = w.y; }
    const f32x2 cb = *(const f32x2*)(F.in(I_CDWB) + ch);
    LAS float* tile = (LAS float*)F.lds;
    for (int unit = F.vcu; unit < T / 128; unit += F.G) {
        const int t0 = unit * 128, s0 = t0 & (SEQ - 1);
        float xa[46], xb[46];
#pragma unroll
        for (int k = 0; k < 30; ++k) { unsigned v = 0u; if (s0 - 30 + k >= 0) v = *(const unsigned*)(U + (size_t)(t0 - 30 + k) * D + ch); xa[k] = bf_lo(v); xb[k] = bf_hi(v); }
        for (int blk = 0; blk < 8; ++blk) {
#pragma unroll
            for (int k = 0; k < 16; ++k) { const unsigned v = *(const unsigned*)(U + (size_t)(t0 + blk * 16 + k) * D + ch); xa[30 + k] = bf_lo(v); xb[30 + k] = bf_hi(v); }
            LAS float* tl = tile + (blk & 1) * 16384;
#pragma unroll
            for (int i = 0; i < 16; ++i) { float a = cb.x, b = cb.y;
#pragma unroll
                for (int j = 0; j < 31; ++j) { a += xa[i + j] * wa[j]; b += xb[i + j] * wb[j]; }
                *(LAS f32x2*)(tl + i * 1024 + ch) = (f32x2){a, b}; }
#pragma unroll
            for (int k = 0; k < 30; ++k) { xa[k] = xa[k + 16]; xb[k] = xb[k + 16]; }
            __syncthreads();
            {
                f32x4 v[2][4]; float sm[2], s2[2], rstd[2];
#pragma unroll
                for (int h = 0; h < 2; ++h) { const LAS float* rowp = tl + (h * 8 + F.wave) * 1024;
#pragma unroll
                    for (int jj = 0; jj < 2; ++jj) { v[h][2 * jj] = *(const LAS f32x4*)(rowp + 512 * jj + 8 * F.lane); v[h][2 * jj + 1] = *(const LAS f32x4*)(rowp + 512 * jj + 8 * F.lane + 4); } }
#pragma unroll
                for (int h = 0; h < 2; ++h) { float s = 0.f;
#pragma unroll
                    for (int q = 0; q < 4; ++q) s += (v[h][q].x + v[h][q].y) + (v[h][q].z + v[h][q].w);
                    sm[h] = s; }
#pragma unroll
                for (int h = 0; h < 2; ++h) sm[h] = wave_sum(sm[h]) * (1.f / D);
#pragma unroll
                for (int h = 0; h < 2; ++h) { float t = 0.f;
#pragma unroll
                    for (int q = 0; q < 4; ++q) { v[h][q] = v[h][q] - sm[h]; t += (v[h][q].x * v[h][q].x + v[h][q].y * v[h][q].y) + (v[h][q].z * v[h][q].z + v[h][q].w * v[h][q].w); }
                    s2[h] = t; }
#pragma unroll
                for (int h = 0; h < 2; ++h) rstd[h] = __builtin_amdgcn_rsqf(wave_sum(s2[h]) * (1.f / D) + EPS);
#pragma unroll
                for (int jj = 0; jj < 2; ++jj) { const int col = 512 * jj + 8 * F.lane;
                    const f32x4 g0 = *(const f32x4*)(F.in(I_CLNG) + col), g1 = *(const f32x4*)(F.in(I_CLNG) + col + 4), b0 = *(const f32x4*)(F.in(I_CLNB) + col), b1 = *(const f32x4*)(F.in(I_CLNB) + col + 4);
#pragma unroll
                    for (int h = 0; h < 2; ++h) { float r[8];
                        const f32x4 y0 = v[h][2 * jj] * rstd[h] * g0 + b0, y1 = v[h][2 * jj + 1] * rstd[h] * g1 + b1;
#pragma unroll
                        for (int i = 0; i < 4; ++i) { r[i] = y0[i] * sigmoidf_(y0[i]); r[4 + i] = y1[i] * sigmoidf_(y1[i]); }
                        int d0 = 0, d1 = 0;
                        d0 = __builtin_amdgcn_cvt_pk_fp8_f32(r[0], r[1], d0, false); d0 = __builtin_amdgcn_cvt_pk_fp8_f32(r[2], r[3], d0, true);
                        d1 = __builtin_amdgcn_cvt_pk_fp8_f32(r[4], r[5], d1, false); d1 = __builtin_amdgcn_cvt_pk_fp8_f32(r[6], r[7], d1, true);
                        unsigned char* op = (unsigned char*)CV + (size_t)(t0 + blk * 16 + h * 8 + F.wave) * D;
                        *(u32x2*)(op + col) = (u32x2){(unsigned)d0, (unsigned)d1}; } }
            }
        }
        __syncthreads();
    }
}

__device__ __forceinline__ float ub(unsigned w, int k) { return (float)((w >> (8 * k)) & 0xffu); }
struct EpiPw2 {
    static constexpr bool PERM = true;
    bf16* O; const unsigned char* GC; const float* bias;
    __device__ __forceinline__ void operator()(const f32x4 (&acc)[2][2][4][2], const pg8::Unit& u, int wr, int wc, int fr, int fq) const {
        const int row0 = u.pm * 256 + wr * 64 + fr, col0 = u.pn * 256 + wc * 32 + fq * 8;
#pragma unroll
        for (int ai = 0; ai < 2; ++ai)
#pragma unroll
            for (int m = 0; m < 4; ++m) { const int row = row0 + ai * 128 + m * 16;
#pragma unroll
                for (int bj = 0; bj < 2; ++bj) { const int col = col0 + bj * 128; const u32x2 gv = *(const u32x2*)(GC + (size_t)row * D + col);
                    const f32x4 b0 = *(const f32x4*)(bias + col), b1 = *(const f32x4*)(bias + col + 4); float r[8];
#pragma unroll
                    for (int i = 0; i < 4; ++i) { r[i] = (acc[ai][bj][m][0][i] * (1.f / WIN_SCALE) + b0[i]) * (1.f / 255.f); r[4 + i] = (acc[ai][bj][m][1][i] * (1.f / WIN_SCALE) + b1[i]) * (1.f / 255.f); }
                    r[0] *= ub(gv.x, 0); r[1] *= ub(gv.x, 1); r[2] *= ub(gv.x, 2); r[3] *= ub(gv.x, 3); r[4] *= ub(gv.y, 0); r[5] *= ub(gv.y, 1); r[6] *= ub(gv.y, 2); r[7] *= ub(gv.y, 3);
                    u32x4 w; w.x = cvt_pk_bf16(r[0], r[1]); w.y = cvt_pk_bf16(r[2], r[3]); w.z = cvt_pk_bf16(r[4], r[5]); w.w = cvt_pk_bf16(r[6], r[7]);
                    *(u32x4*)(O + (size_t)row * D + col) = w; } }
    }
};

namespace att {
constexpr int SLOT = 32768, NSLOT = 3, XOFF = NSLOT * SLOT;
typedef int i32x8 __attribute__((ext_vector_type(8)));
__device__ __forceinline__ int crow(int r, int hi) { return (r & 3) + 8 * (r >> 2) + 4 * hi; }
__device__ __forceinline__ s16x4 vtr(const LAS char* p) { typedef short v4i16_t __attribute__((ext_vector_type(4))); return __builtin_bit_cast(s16x4, __builtin_amdgcn_ds_read_tr16_b64_v4i16((LAS v4i16_t*)p)); }
#define BUF_DMA16(m0v, voff, srd, soff) asm volatile("s_mov_b32 m0, %0\n\ts_nop 0\n\tbuffer_load_dwordx4 %1, %2, %3 offen lds" :: "s"(m0v), "v"(voff), "s"(srd), "s"(soff) : "m0", "memory")
#define ATT_SB() __builtin_amdgcn_sched_barrier(0)
#ifndef VLA
#define VLA 4
#endif
struct DmaSet { unsigned m0[2], so[2]; };
__device__ __forceinline__ f32x16 zacc() { return (f32x16){0.f, 0.f, 0.f, 0.f, 0.f, 0.f, 0.f, 0.f, 0.f, 0.f, 0.f, 0.f, 0.f, 0.f, 0.f, 0.f}; }
__device__ __forceinline__ f32x16 mfma8(i32x8 a, i32x8 b, f32x16 c) { return __builtin_amdgcn_mfma_scale_f32_32x32x64_f8f6f4(a, b, c, 2, 2, 0, 0x7f7f7f7f, 0, 0x76767676); }
#define ATT_KFRAG(kp, blk) ({ const u32x4 lo_ = *(const LAS u32x4*)((kp) + (blk) * 2048 + kc0), hi_ = *(const LAS u32x4*)((kp) + (blk) * 2048 + kc1); \
        (i32x8){(int)lo_.x, (int)lo_.y, (int)lo_.z, (int)lo_.w, (int)hi_.x, (int)hi_.y, (int)hi_.z, (int)hi_.w}; })
template <bool MASK>
__device__ __forceinline__ void shift_mask(f32x16& c0, f32x16& c1, int kb, int qrow, float negM, bool shift) {
    if (shift) {
#pragma unroll
        for (int r = 0; r < 16; ++r) { c0[r] += negM; c1[r] += negM; } }
    if (MASK) {
#pragma unroll
        for (int r = 0; r < 16; ++r) { const int kv = kb + (r & 3) + 8 * (r >> 2); if (kv > qrow) c0[r] = -INFINITY; if (kv + 32 > qrow) c1[r] = -INFINITY; } }
}
#define ATT_VFRAG(dst, i) do { const s16x4 lo_ = vtr(vp + ((i) & 3) * 4096 + ((i) >> 2) * 1024), hh_ = vtr(vp + ((i) & 3) * 4096 + ((i) >> 2) * 1024 + 512); \
        dst = (bf16x8){lo_[0], lo_[1], lo_[2], lo_[3], hh_[0], hh_[1], hh_[2], hh_[3]}; } while (0)
__device__ __forceinline__ int exp2_bf8x4(float a, float b, float c, float d) {
    typedef unsigned short us2_t __attribute__((ext_vector_type(2)));
    const us2_t lo = __builtin_amdgcn_cvt_pknorm_u16(a, b), hi = __builtin_amdgcn_cvt_pknorm_u16(c, d);
    return (int)__builtin_amdgcn_perm(__builtin_bit_cast(unsigned, hi), __builtin_bit_cast(unsigned, lo), 0x07050301u);
}
__device__ __forceinline__ f32x16 mfma_pv(i32x8 p, i32x8 v, f32x16 c) { return __builtin_amdgcn_mfma_scale_f32_32x32x64_f8f6f4(p, v, c, 1, 0, 0, 0, 0, 0); }
__device__ __forceinline__ f32x4 mfma_sum(i32x8 p, i32x8 sel, f32x4 c) { return __builtin_amdgcn_mfma_scale_f32_16x16x128_f8f6f4(p, sel, c, 1, 0, 0, 0, 0, 0); }
template <bool SECOND>
__device__ __forceinline__ void mask16(f32x16& c, int kb, int qrow) {
    int d = qrow - kb; asm volatile("" : "+v"(d));
#pragma unroll
    for (int r = 0; r < 16; ++r) { if ((r & 3) + 8 * (r >> 2) + (SECOND ? 32 : 0) > d) c[r] = -1e30f; }
}
__device__ __forceinline__ void att_step(bool MASK, f32x16 (&o)[4], i32x8 (&kf)[2], const i32x8& qf, const f32x16& cinit, f32x4& lacc, const i32x8& ones, const i32x8& pfp, i32x8& pfc,
                                         const LAS char* vp, const LAS char* kpn, int kc0, int kc1, int kb, int qrow,
                                         const DmaSet& dm, unsigned vdma, __amdgpu_buffer_rsrc_t srdK, __amdgpu_buffer_rsrc_t srdV) {
    i32x8 vf[4]; f32x16 c0, c1;
    vf[0] = ATT_KFRAG(vp, 0); vf[1] = ATT_KFRAG(vp, 1);
    c0 = mfma8(kf[0], qf, cinit);
    vf[2] = ATT_KFRAG(vp, 2); vf[3] = ATT_KFRAG(vp, 3);
    c1 = mfma8(kf[1], qf, cinit);
    ATT_SB();
#pragma unroll
    for (int i = 0; i < 4; ++i) {
        o[i] = mfma_pv(pfp, vf[i], o[i]);
        if (i == 0) BUF_DMA16(dm.m0[0], vdma, srdK, dm.so[0]);
        if (i == 1) kf[0] = ATT_KFRAG(kpn, 0);
        if (i == 2) kf[1] = ATT_KFRAG(kpn, 1);
        if (MASK && i == 0) mask16<false>(c0, kb, qrow);
        if (MASK && i == 2) mask16<true>(c1, kb, qrow);
        { const f32x16& C = i < 2 ? c0 : c1; const int e = 8 * (i & 1);
          int w0 = exp2_bf8x4(C[e], C[e + 1], C[e + 2], C[e + 3]), w1 = exp2_bf8x4(C[e + 4], C[e + 5], C[e + 6], C[e + 7]);
          asm volatile("" : "+v"(w0), "+v"(w1)); pfc[2 * i] = w0; pfc[2 * i + 1] = w1; }
        if (i == 3) BUF_DMA16(dm.m0[1], vdma, srdV, dm.so[1]);
        ATT_SB();
    }
    lacc = mfma_sum(pfp, ones, lacc);
}
__device__ __forceinline__ void att_drain(f32x16 (&o)[4], const i32x8& pf, f32x4& lacc, const i32x8& ones, const LAS char* vp, int kc0, int kc1) {
#pragma unroll
    for (int i = 0; i < 4; ++i) { const i32x8 f = ATT_KFRAG(vp, i); o[i] = mfma_pv(pf, f, o[i]); }
    lacc = mfma_sum(pf, ones, lacc);
}

__device__ __forceinline__ void phase5(Frame& F, unsigned char* MGout) {
    const unsigned char* GA = (const unsigned char*)(F.ws + WS_GA); bf16* MG = (bf16*)(F.ws + WS_U);
    const int lane = F.lane, r32 = lane & 31, hi = lane >> 5, wid = F.wave, rg = wid & 3, mp = wid >> 2;
    float lam;
    {
        const float q1 = F.in(I_LQ1)[lane], k1 = F.in(I_LK1)[lane], q2 = F.in(I_LQ2)[lane], k2 = F.in(I_LK2)[lane];
        lam = __expf(wave_sum(q1 * k1)) - __expf(wave_sum(q2 * k2)) + LAMBDA_INIT;
    }
    f32x16 cinit;
    { float pb = PBIAS * (1.f / 256.f); asm volatile("" : "+v"(pb));
#pragma unroll
      for (int r = 0; r < 16; ++r) cinit[r] = pb; }
    const int one4 = (lane & 15) == ((lane >> 4) & 1) ? 0x38383838 : 0;
    const i32x8 ones = {one4, one4, one4, one4, one4, one4, one4, one4};
    LAS char* ring = (LAS char*)F.lds;
    const unsigned ring0 = (unsigned)(size_t)ring;
    const int voff = r32 * 64;
    const int ksw = (r32 >> 2) & 3;
    const int koff = r32 * 64 + mp * 4096, kc0 = ((2 * hi) ^ ksw) << 4, kc1 = ((2 * hi + 1) ^ ksw) << 4;
    const __amdgpu_buffer_rsrc_t srdK = __builtin_amdgcn_make_buffer_rsrc((void*)(F.ws + WS_K), (short)0, 64 << 20, 0x00020000);
    const __amdgpu_buffer_rsrc_t srdV = __builtin_amdgcn_make_buffer_rsrc((void*)(F.ws + WS_V), (short)0, 64 << 20, 0x00020000);
    const __amdgpu_buffer_rsrc_t srdQ = __builtin_amdgcn_make_buffer_rsrc((void*)(F.ws + WS_Q), (short)0, 64 << 20, 0x00020000);
    const unsigned vdma = (unsigned)(wid * 1024 + lane * 16);
    const unsigned vdmk = (unsigned)((wid & 3) * 1024 + lane * 16);
    const unsigned vq = (unsigned)(r32 * 64 + hi * 32);
    if (wid >= 4) __builtin_amdgcn_s_setprio(1);
#ifndef DBG_ATT2
#define DBG_ATT2 0
#endif
    for (int p_ = F.vcu; p_ < (DBG_ATT2 ? 2048 : 1024); p_ += F.G) {
        const int p = p_ & 1023; unsigned char* const MGo = (DBG_ATT2 && p_ < 1024) ? (unsigned char*)F.out : MGout;
        const int bh = p >> 6, j = p & 63;
        for (int half = 0; half < 2; ++half) {
            const int qt = half == 0 ? j : 127 - j;
            const int NT = 2 * (qt + 1);
            const unsigned kxoff = (unsigned)(bh * 2 + (wid >> 2)) * (SEQ * 64u), voffg = (unsigned)bh * (256u * 8192u);
#define ATT_ISSUE_K(tk_, dst_) do { const unsigned tk__ = (unsigned)((tk_) < NT ? (tk_) : NT - 1) * 4096u; BUF_DMA16(ring0 + (dst_) + wid * 1024, vdmk, srdK, kxoff + tk__); } while (0)
#define ATT_ISSUE_V(tv_, dst_) do { const unsigned tv__ = voffg + (unsigned)((tv_) < NT ? (tv_) : NT - 1) * 8192u; BUF_DMA16(ring0 + (dst_) + wid * 1024, vdma, srdV, tv__); } while (0)
            u32x4 q0, q1;
            { const unsigned qs = ((unsigned)(bh * 2 + mp) * SEQ + (unsigned)(qt * 128 + rg * 32)) * 64u;
              asm volatile("buffer_load_dwordx4 %0, %2, %3, %4 offen\n\tbuffer_load_dwordx4 %1, %2, %3, %4 offen offset:16"
                           : "=&v"(q0), "=&v"(q1) : "v"(vq), "s"(srdQ), "s"(qs) : "memory"); }
            ATT_ISSUE_K(0, XOFF); ATT_ISSUE_K(1, XOFF + 16384);
            ATT_ISSUE_K(2, 0); ATT_ISSUE_V(0, 16384); ATT_ISSUE_K(3, 8192); ATT_ISSUE_V(1, 16384 + 8192);
            ATT_ISSUE_K(4, SLOT); ATT_ISSUE_V(2, SLOT + 16384); ATT_ISSUE_K(5, SLOT + 8192); ATT_ISSUE_V(3, SLOT + 16384 + 8192);
            asm volatile("s_waitcnt vmcnt(8)\n\ts_barrier" : "+v"(q0), "+v"(q1) :: "memory");
            const i32x8 qf = {(int)q0.x, (int)q0.y, (int)q0.z, (int)q0.w, (int)q1.x, (int)q1.y, (int)q1.z, (int)q1.w};
            f32x16 o[4];
#pragma unroll
            for (int vb = 0; vb < 4; ++vb)
#pragma unroll
                for (int r = 0; r < 16; ++r) o[vb][r] = 0.f;
            f32x4 lacc = {0.f, 0.f, 0.f, 0.f};
            const int qrow = qt * 128 + rg * 32 + r32;
            i32x8 kf[2], pfA, pfB;
            { const LAS char* kp0 = ring + XOFF + koff; f32x16 c0, c1;
              kf[0] = ATT_KFRAG(kp0, 0); kf[1] = ATT_KFRAG(kp0, 1);
              c0 = mfma8(kf[0], qf, cinit); c1 = mfma8(kf[1], qf, cinit);
              if (NT == 2) { mask16<false>(c0, 4 * hi, qrow); mask16<true>(c1, 4 * hi, qrow); }
#pragma unroll
              for (int d = 0; d < 8; ++d) { const f32x16& C = d < 4 ? c0 : c1; const int e = 4 * (d & 3); pfA[d] = exp2_bf8x4(C[e], C[e + 1], C[e + 2], C[e + 3]); } }
            { const LAS char* kp1 = ring + XOFF + 16384 + koff; kf[0] = ATT_KFRAG(kp1, 0); kf[1] = ATT_KFRAG(kp1, 1); }
            unsigned sl_use = 0, sl_mid = SLOT, sl_new = 2 * SLOT;
#define ATT_STEP(MASKED, PFC, PFP, t_, SUB, BAR) do { if (BAR) asm volatile("s_waitcnt vmcnt(4) lgkmcnt(0)\n\ts_barrier" ::: "memory"); \
                DmaSet dm; { const unsigned tk__ = (unsigned)(((t_) + 5) < NT ? ((t_) + 5) : NT - 1) * 4096u, tv__ = voffg + (unsigned)(((t_) + 3) < NT ? ((t_) + 3) : NT - 1) * 8192u, d__ = ring0 + sl_new + (SUB) * 8192u + wid * 1024; \
                    dm.m0[0] = d__; dm.m0[1] = d__ + 16384u; dm.so[0] = kxoff + tk__ - (unsigned)(wid >> 2) * 4096u; dm.so[1] = tv__; }   \
                { const LAS char* vp = ring + sl_use + 16384 + (SUB) * 8192 + voff; const LAS char* kpn = ring + sl_use + (SUB) * 8192 + koff; \
                  att_step(MASKED, o, kf, qf, cinit, lacc, ones, PFP, PFC, vp, kpn, kc0, kc1, 64 * (t_) + 4 * hi, qrow, dm, vdma, srdK, srdV); } } while (0)
            int t = 1;
            for (; t + 1 < NT; t += 2) { ATT_STEP(false, pfB, pfA, t, 0, true); ATT_STEP((t + 1 >= NT - 2), pfA, pfB, t + 1, 1, false);
                const unsigned t__ = sl_use; sl_use = sl_mid; sl_mid = sl_new; sl_new = t__; }
            ATT_STEP(true, pfB, pfA, NT - 1, 0, true);
            const size_t eidx = ((size_t)(bh >> 3) * SEQ + qt * 128 + (F.tid >> 2)) * D + (bh & 7) * 128 + (F.tid & 3) * 32;
            u32x4 gaP[2], mcP[4];
#pragma unroll
            for (int c8 = 0; c8 < 4; ++c8) { if (c8 < 2) gaP[c8] = *(const u32x4*)(GA + eidx + c8 * 16); mcP[c8] = *(const u32x4*)(MG + eidx + c8 * 8); }
            f32x4 sgP[8];
            { const float* sgp = F.in(I_SUBG) + (F.tid & 3) * 32; asm volatile("" : "+v"(sgp));
#pragma unroll
              for (int c4 = 0; c4 < 8; ++c4) sgP[c4] = *(const __attribute__((address_space(1))) f32x4*)(sgp + c4 * 4); }
            att_drain(o, pfB, lacc, ones, ring + sl_use + 16384 + 8192 + voff, kc0, kc1);
#undef ATT_STEP
#undef ATT_ISSUE_K
#undef ATT_ISSUE_V
            float rl[16];
            { int hi_e = hi; asm volatile("" : "+v"(hi_e));
#pragma unroll
              for (int r = 0; r < 16; ++r) rl[r] = __builtin_amdgcn_rcpf(__shfl(lacc[r & 3], 16 * (2 * ((r >> 2) & 1) + hi_e) + (r >> 3))); }
            asm volatile("s_waitcnt vmcnt(14) lgkmcnt(0)\n\ts_barrier" ::: "memory");
            { LAS float* xch = (LAS float*)ring + mp * 16384 + rg * 4096; const float sc_ = mp == 0 ? 1.f : lam;
#pragma unroll
              for (int vb = 0; vb < 4; ++vb)
#pragma unroll
                  for (int r = 0; r < 16; ++r) xch[(vb * 16 + r) * 64 + lane] = o[vb][r] * rl[r] * sc_; }
            asm volatile("s_waitcnt lgkmcnt(0)\n\ts_barrier" ::: "memory");
            {
                const int b = bh >> 3, h = bh & 7, q = F.tid >> 2, vb = F.tid & 3, q5 = q & 31;
                const int rr = (q5 & 3) + 4 * (q5 >> 3), hh = (q5 >> 2) & 1;
                const LAS float* src = (const LAS float*)ring + (q >> 5) * 4096 + (vb * 16 + rr) * 64 + hh * 32;
                f32x4 dv[8]; float ssq = 0.f;
#pragma unroll
                for (int c4 = 0; c4 < 8; ++c4) { const f32x4 d = *(const LAS f32x4*)(src + c4 * 4) - *(const LAS f32x4*)(src + 16384 + c4 * 4); dv[c4] = d; ssq += (d.x * d.x + d.y * d.y) + (d.z * d.z + d.w * d.w); }
                ssq += dppf<0xB1>(ssq); ssq += dppf<0x4E>(ssq);
                const float rs = __builtin_amdgcn_rsqf(ssq * (1.f / 128.f) + EPS) * ((1.f - LAMBDA_INIT) * (1.f / 255.f));
                const size_t idx = eidx; (void)b; (void)h;
#pragma unroll
                for (int c16 = 0; c16 < 2; ++c16) { u32x4 w;
#pragma unroll
                    for (int hf = 0; hf < 2; ++hf) { const int c8 = 2 * c16 + hf;
                        const f32x4 y0 = dv[2 * c8] * rs, y1 = dv[2 * c8 + 1] * rs;
                        const f32x4 g0 = sgP[2 * c8], g1 = sgP[2 * c8 + 1];
                        const unsigned gx = c8 == 0 ? gaP[0].x : c8 == 1 ? gaP[0].z : c8 == 2 ? gaP[1].x : gaP[1].z, gy = c8 == 0 ? gaP[0].y : c8 == 1 ? gaP[0].w : c8 == 2 ? gaP[1].y : gaP[1].w; const u32x4 mc = mcP[c8];
                        float r[8];
                        r[0] = y0[0] * g0[0] * ub(gx, 0) + bf_lo(mc.x); r[1] = y0[1] * g0[1] * ub(gx, 1) + bf_hi(mc.x);
                        r[2] = y0[2] * g0[2] * ub(gx, 2) + bf_lo(mc.y); r[3] = y0[3] * g0[3] * ub(gx, 3) + bf_hi(mc.y);
                        r[4] = y1[0] * g1[0] * ub(gy, 0) + bf_lo(mc.z); r[5] = y1[1] * g1[1] * ub(gy, 1) + bf_hi(mc.z);
                        r[6] = y1[2] * g1[2] * ub(gy, 2) + bf_lo(mc.w); r[7] = y1[3] * g1[3] * ub(gy, 3) + bf_hi(mc.w);
                        int d0 = 0, d1 = 0;
                        d0 = __builtin_amdgcn_cvt_pk_fp8_f32(r[0] * MG_SCALE, r[1] * MG_SCALE, d0, false); d0 = __builtin_amdgcn_cvt_pk_fp8_f32(r[2] * MG_SCALE, r[3] * MG_SCALE, d0, true);
                        d1 = __builtin_amdgcn_cvt_pk_fp8_f32(r[4] * MG_SCALE, r[5] * MG_SCALE, d1, false); d1 = __builtin_amdgcn_cvt_pk_fp8_f32(r[6] * MG_SCALE, r[7] * MG_SCALE, d1, true);
                        if (hf == 0) { w.x = (unsigned)d0; w.y = (unsigned)d1; } else { w.z = (unsigned)d0; w.w = (unsigned)d1; } }
                    *(u32x4*)(MGo + idx + c16 * 16) = w; }
            }
            asm volatile("s_waitcnt lgkmcnt(0)\n\ts_barrier" ::: "memory");
        }
    }
    __builtin_amdgcn_s_setprio(0);
}
}

struct EpiOut {
    static constexpr bool PERM = true;
    const float* X; bf16* O; const float* mod;
    __device__ __forceinline__ void operator()(const f32x4 (&acc)[2][2][4][2], const pg8::Unit& u, int wr, int wc, int fr, int fq) const {
        const int row0 = u.pm * 256 + wr * 64 + fr, col0 = u.pn * 256 + wc * 32 + fq * 8;
#pragma unroll
        for (int ai = 0; ai < 2; ++ai)
#pragma unroll
            for (int m = 0; m < 4; ++m) { const int row = row0 + ai * 128 + m * 16, b = row >> 14;
#pragma unroll
                for (int bj = 0; bj < 2; ++bj) { const int col = col0 + bj * 128;
                    const f32x4 g0 = *(const f32x4*)(mod + b * 6144 + 2048 + col) * (1.f / (WIN_SCALE * MG_SCALE)), g1 = *(const f32x4*)(mod + b * 6144 + 2048 + col + 4) * (1.f / (WIN_SCALE * MG_SCALE));
                    const f32x4 x0 = __builtin_nontemporal_load((const f32x4*)(X + (size_t)row * D + col)), x1 = __builtin_nontemporal_load((const f32x4*)(X + (size_t)row * D + col + 4));
                    const f32x4 r0 = x0 + g0 * acc[ai][bj][m][0], r1 = x1 + g1 * acc[ai][bj][m][1];
                    *(u32x4*)(O + (size_t)row * D + col) = (u32x4){cvt_pk_bf16(r0.x, r0.y), cvt_pk_bf16(r0.z, r0.w), cvt_pk_bf16(r1.x, r1.y), cvt_pk_bf16(r1.z, r1.w)}; } }
    }
};

__device__ __forceinline__ void phase7(Frame& F) {
    const bf16* X1 = (const bf16*)(F.ws + WS_X1); const float* mod = (const float*)(F.ws + WS_MOD); const float* gn = F.in(I_N2G); bf16* H2 = (bf16*)(F.ws + WS_U);
    constexpr int PITCH = 272;
    LAS char* Ahi = (LAS char*)F.lds;
    LAS char* Alo = Ahi + 128 * PITCH;
    LAS char* Whi = Alo + 128 * PITCH;
    LAS char* Wlo = Whi + 64 * PITCH;
    LAS float* RS = (LAS float*)(F.lds + 104448);
    LAS int* CW = (LAS int*)(F.lds + 104960);
    LAS unsigned char* RK = (LAS unsigned char*)(F.lds + 105472);
    LAS float* LG = (LAS float*)F.lds;
    const int tid = F.tid, lane = F.lane, wid = F.wave, r32 = lane & 31, hi = lane >> 5;
    const bf16* WRH = (const bf16*)(F.ws + WS_WRH); const bf16* WRL = (const bf16*)(F.ws + WS_WRL);
    for (int chunk = F.vcu; chunk < T / 128; chunk += F.G) {
        const int t0 = chunk * 128, b = t0 >> 14;
        for (int i4 = 0; i4 < 16; i4 += 4) {
            u32x4 xw[4][2]; float ss[4];
#pragma unroll
            for (int u = 0; u < 4; ++u) { const bf16* xr = X1 + (size_t)(t0 + wid * 16 + i4 + u) * D + 8 * lane;
#pragma unroll
                for (int j = 0; j < 2; ++j) xw[u][j] = *(const u32x4*)(xr + 512 * j); }
#pragma unroll
            for (int u = 0; u < 4; ++u) { float s = 0.f;
#pragma unroll
                for (int j = 0; j < 2; ++j) { const u32x4 x = xw[u][j];
                    s += (bf_lo(x.x) * bf_lo(x.x) + bf_hi(x.x) * bf_hi(x.x)) + (bf_lo(x.y) * bf_lo(x.y) + bf_hi(x.y) * bf_hi(x.y)) + (bf_lo(x.z) * bf_lo(x.z) + bf_hi(x.z) * bf_hi(x.z)) + (bf_lo(x.w) * bf_lo(x.w) + bf_hi(x.w) * bf_hi(x.w)); }
                ss[u] = s; }
#pragma unroll
            for (int u = 0; u < 4; ++u) ss[u] = wave_sum(ss[u]);
#pragma unroll
            for (int u = 0; u < 4; ++u) { const int m = t0 + wid * 16 + i4 + u; const float rstd = __builtin_amdgcn_rsqf(ss[u] * (1.f / D) + EPS);
                if (lane == 0) RS[wid * 16 + i4 + u] = rstd;
                unsigned char* o8 = (unsigned char*)H2 + (size_t)m * D + 8 * lane;
#pragma unroll
                for (int j = 0; j < 2; ++j) { const int col = 8 * lane + 512 * j; const u32x4 x = xw[u][j];
                    const f32x4 g0 = *(const f32x4*)(gn + col), sc0 = *(const f32x4*)(mod + b * 6144 + 4096 + col), sh0 = *(const f32x4*)(mod + b * 6144 + 3072 + col);
                    const f32x4 g1 = *(const f32x4*)(gn + col + 4), sc1 = *(const f32x4*)(mod + b * 6144 + 4096 + col + 4), sh1 = *(const f32x4*)(mod + b * 6144 + 3072 + col + 4);
                    const f32x4 y0 = (f32x4){bf_lo(x.x), bf_hi(x.x), bf_lo(x.y), bf_hi(x.y)} * rstd * g0 * (sc0 + 1.f) + sh0, y1 = (f32x4){bf_lo(x.z), bf_hi(x.z), bf_lo(x.w), bf_hi(x.w)} * rstd * g1 * (sc1 + 1.f) + sh1;
                    int d0 = 0, d1 = 0;
                    d0 = __builtin_amdgcn_cvt_pk_fp8_f32(y0.x, y0.y, d0, false); d0 = __builtin_amdgcn_cvt_pk_fp8_f32(y0.z, y0.w, d0, true);
                    d1 = __builtin_amdgcn_cvt_pk_fp8_f32(y1.x, y1.y, d1, false); d1 = __builtin_amdgcn_cvt_pk_fp8_f32(y1.z, y1.w, d1, true);
                    *(u32x2*)(o8 + 512 * j) = (u32x2){(unsigned)d0, (unsigned)d1}; } } }
        __syncthreads();
        f32x16 c;
#pragma unroll
        for (int r = 0; r < 16; ++r) c[r] = 0.f;
        const int tb = wid & 3, eb = wid >> 2;
        const int cq = (lane & 15) * 8, rsub = lane >> 4;
        f32x4 pg[2], psc[2], psh[2]; u32x4 xv[4]; u32x4 wv[4];
#define P7_FETCH(ks_) do { const int col = (ks_) * 128 + cq; \
            _Pragma("unroll") for (int q = 0; q < 2; ++q) { pg[q] = *(const f32x4*)(gn + col + 4 * q); psc[q] = *(const f32x4*)(mod + b * 6144 + 4096 + col + 4 * q); psh[q] = *(const f32x4*)(mod + b * 6144 + 3072 + col + 4 * q); } \
            _Pragma("unroll") for (int i = 0; i < 4; ++i) xv[i] = *(const u32x4*)(X1 + (size_t)(t0 + wid * 16 + 4 * i + rsub) * D + col); \
            _Pragma("unroll") for (int q = 0; q < 2; ++q) { const int cc = tid + 512 * q, e = cc >> 4, kc = cc & 15; \
                wv[2 * q] = *(const u32x4*)(WRH + e * 1024 + (ks_) * 128 + kc * 8); } } while (0)
        P7_FETCH(0);
        for (int ks = 0; ks < 8; ++ks) {
            {
#pragma unroll
              for (int i = 0; i < 4; ++i) { const int row = wid * 16 + 4 * i + rsub; const float rstd = RS[row]; const u32x4 x = xv[i];
                  const f32x4 y0 = (f32x4){bf_lo(x.x), bf_hi(x.x), bf_lo(x.y), bf_hi(x.y)} * rstd * pg[0] * (psc[0] + 1.f) + psh[0], y1 = (f32x4){bf_lo(x.z), bf_hi(x.z), bf_lo(x.w), bf_hi(x.w)} * rstd * pg[1] * (psc[1] + 1.f) + psh[1];
                  const unsigned h0 = cvt_pk_bf16(y0.x, y0.y), h1 = cvt_pk_bf16(y0.z, y0.w), h2 = cvt_pk_bf16(y1.x, y1.y), h3 = cvt_pk_bf16(y1.z, y1.w);
                  *(LAS u32x4*)(Ahi + row * PITCH + cq * 2) = (u32x4){h0, h1, h2, h3};
                  }
#pragma unroll
              for (int q = 0; q < 2; ++q) { const int cc = tid + 512 * q, e = cc >> 4, kc = cc & 15;
                  *(LAS u32x4*)(Whi + e * PITCH + kc * 16) = wv[2 * q]; } }
            __syncthreads();
            if (ks + 1 < 8) P7_FETCH(ks + 1);
#pragma unroll
            for (int st = 0; st < 8; ++st) { const int ao = (tb * 32 + r32) * PITCH + (2 * st + hi) * 16, bo = (eb * 32 + r32) * PITCH + (2 * st + hi) * 16;
                const bf16x8 ah = *(const LAS bf16x8*)(Ahi + ao), bh = *(const LAS bf16x8*)(Whi + bo);
                c = __builtin_amdgcn_mfma_f32_32x32x16_bf16(ah, bh, c, 0, 0, 0); }
            __syncthreads();
        }
#undef P7_FETCH
#pragma unroll
        for (int r = 0; r < 16; ++r) LG[(tb * 32 + att::crow(r, hi)) * 65 + eb * 32 + r32] = c[r];
        __syncthreads();
        unsigned long long chosen = 0ull; int ek[8]; float sk[8];
        if (tid < 128) {
            LAS float* L = LG + tid * 65;
            float gs[8];
#pragma unroll
            for (int g = 0; g < 8; ++g) { float m1 = -INFINITY, m2 = -INFINITY;
#pragma unroll
                for (int jx = 0; jx < 8; ++jx) { const float sc = sigmoidf_(L[g * 8 + jx]); const float ch = sc + F.in(I_RB)[g * 8 + jx]; L[g * 8 + jx] = ch;
                    if (ch > m1) { m2 = m1; m1 = ch; } else if (ch > m2) m2 = ch; }
                gs[g] = m1 + m2; }
            unsigned gm = 0u;
#pragma unroll
            for (int it = 0; it < 4; ++it) { float best = -INFINITY; int bi = 0;
#pragma unroll
                for (int g = 0; g < 8; ++g) { const bool ok = !((gm >> g) & 1u) && gs[g] > best; best = ok ? gs[g] : best; bi = ok ? g : bi; }
                gm |= 1u << bi; }
            int gsel[4]; float cand[32];
            { unsigned m = gm;
#pragma unroll
              for (int sx = 0; sx < 4; ++sx) { const int g = __builtin_ctz(m); m &= m - 1u; gsel[sx] = g;
#pragma unroll
                  for (int jx = 0; jx < 8; ++jx) cand[sx * 8 + jx] = L[g * 8 + jx]; } }
            float ssum = 0.f;
#pragma unroll
            for (int it = 0; it < 8; ++it) { float best = -INFINITY; int bi = 0;
#pragma unroll
                for (int i = 0; i < 32; ++i) { const bool ok = cand[i] > best; best = ok ? cand[i] : best; bi = ok ? i : bi; }
#pragma unroll
                for (int i = 0; i < 32; ++i) cand[i] = (i == bi) ? -INFINITY : cand[i];
                const int sx = bi >> 3; const int g = sx == 0 ? gsel[0] : sx == 1 ? gsel[1] : sx == 2 ? gsel[2] : gsel[3]; const int e = g * 8 + (bi & 7);
                chosen |= 1ull << e; ek[it] = e; const float sc = best - F.in(I_RB)[e]; sk[it] = sc; ssum += sc; }
            const float inv = 2.5f / ssum;
#pragma unroll
            for (int it = 0; it < 8; ++it) sk[it] *= inv;
        }
        if (wid < 2) {
            for (int e = 0; e < 64; ++e) { const bool f = (chosen >> e) & 1ull; const unsigned long long bm = __ballot(f);
                const int rk = __popcll(bm & ((1ull << lane) - 1ull));
                if (f) RK[tid * 64 + e] = (unsigned char)rk;
                if (lane == 0) CW[wid * 64 + e] = __popcll(bm); }
        }
        __syncthreads();
        if (tid < 128) {
            int* tke = (int*)(F.ws + WS_TKE) + (size_t)(t0 + tid) * 8; int* tkr = (int*)(F.ws + WS_TKR) + (size_t)(t0 + tid) * 8; float* tkw = (float*)(F.ws + WS_TKW) + (size_t)(t0 + tid) * 8;
#pragma unroll
            for (int it = 0; it < 8; ++it) { const int e = ek[it]; tke[it] = e; tkr[it] = (int)RK[tid * 64 + e] + (wid == 1 ? CW[e] : 0); tkw[it] = sk[it]; }
        }
        if (tid < 64) ((int*)(F.ws + WS_CNT))[chunk * 64 + tid] = CW[tid] + CW[64 + tid];
        __syncthreads();
    }
}

__device__ __forceinline__ void phase8(Frame& F) {
    const int* CNT = (const int*)(F.ws + WS_CNT); int* TOK = (int*)(F.ws + WS_TOK); float* WGT = (float*)(F.ws + WS_WGT); int* POS = (int*)(F.ws + WS_POS);
    LAS int* part = (LAS int*)F.lds;
    LAS int* tot = part + 1024;
    LAS int* below = tot + 64;
    LAS int* ebase = below + 64;
    const int tid = F.tid;
    for (int chunk = F.vcu; chunk < T / 128; chunk += F.G) {
        { const int e = tid & 63, pr = tid >> 6; int s = 0, sb = 0;
          for (int c = pr * 32; c < pr * 32 + 32; ++c) { const int v = CNT[c * 64 + e]; s += v; sb += c < chunk ? v : 0; }
          part[(pr * 2 + 0) * 64 + e] = s; part[(pr * 2 + 1) * 64 + e] = sb; }
        __syncthreads();
        if (tid < 64) { int s = 0, sb = 0;
#pragma unroll
            for (int pr = 0; pr < 8; ++pr) { s += part[(pr * 2 + 0) * 64 + tid]; sb += part[(pr * 2 + 1) * 64 + tid]; }
            tot[tid] = s; below[tid] = sb; }
        __syncthreads();
        if (tid == 0) { int a = 0; for (int e = 0; e < 64; ++e) { ebase[e] = a; a += (tot[e] + 255) & ~255; } ebase[64] = a; }
        __syncthreads();
        if (tid < 128) { const int tokn = chunk * 128 + tid;
            const int* tke = (const int*)(F.ws + WS_TKE) + (size_t)tokn * 8; const int* tkr = (const int*)(F.ws + WS_TKR) + (size_t)tokn * 8; const float* tkw = (const float*)(F.ws + WS_TKW) + (size_t)tokn * 8;
#pragma unroll
            for (int k = 0; k < 8; ++k) { const int e = tke[k]; const int pos = ebase[e] + below[e] + tkr[k]; TOK[pos] = tokn; WGT[pos] = tkw[k]; POS[tokn * 8 + k] = pos; } }
        const int RTOT = ebase[64];
        if (chunk < 64) { const int e = chunk; for (int p = ebase[e] + tot[e] + tid; p < ebase[e + 1]; p += NTHREADS) { TOK[p] = -1; WGT[p] = 0.f; } }
        { const int tokn = chunk * 128 + (tid & 127); if (tid < 128) { TOK[RTOT + tokn] = tokn; WGT[RTOT + tokn] = 1.f; } }
        if (chunk == 0) { int* TE = (int*)(F.ws + WS_TE); const int NTR = RTOT >> 8;
            for (int pm = tid; pm < NTR + 128; pm += NTHREADS) { int e = 64; if (pm < NTR) { e = 0; for (int x = 1; x < 64; ++x) e = (pm * 256 >= ebase[x]) ? x : e; } TE[pm] = e; }
            if (tid == 0) ((int*)(F.ws + WS_META))[0] = NTR; }
        __syncthreads();
    }
}

struct SchedMoe {
    int G, c, nunits, pm0, csh, colbase, bmul; const int* te; const int* tok;
    __device__ __forceinline__ bool next(int i, pg8::Unit& u) const {
        int pm, ct;
        if ((G & 7) == 0) { const int x = c & 7, w = c >> 3, W = G >> 3, nrows = nunits >> csh, nloc = (nrows + 7) >> 3;
            const long Lx = (long)i * W + w; const int pl = (int)(Lx >> csh), pr = x * nloc + pl; if (pl >= nloc || pr >= nrows) return false;
            pm = pm0 + pr; ct = colbase + (int)(Lx & ((1 << csh) - 1)); }
        else { const long L = (long)i * G + c; if (L >= nunits) return false; pm = pm0 + (int)(L >> csh); ct = colbase + (int)(L & ((1 << csh) - 1)); }
        u.pm = pm; u.pn = bmul * te[pm] + ct; return true; }
};
template <int MODE> struct EpiNull {
    static constexpr bool PERM = true;
    float* sink;
    __device__ __forceinline__ void operator()(const f32x4 (&acc)[2][2][4][2], const pg8::Unit& u, int wr, int wc, int fr, int fq) const {
        float s = 0.f;
        if (MODE == 1) {
#pragma unroll
            for (int ai = 0; ai < 2; ++ai)
#pragma unroll
                for (int bj = 0; bj < 2; ++bj)
#pragma unroll
                    for (int m = 0; m < 4; ++m)
#pragma unroll
                        for (int n = 0; n < 2; ++n) s += (acc[ai][bj][m][n][0] + acc[ai][bj][m][n][1]) + (acc[ai][bj][m][n][2] + acc[ai][bj][m][n][3]);
        } else s = acc[0][0][0][0][0] + acc[1][1][3][1][3];
        if (s == 12345.678f) sink[0] = s;
    }
};
struct EpiGU {
    static constexpr bool PERM = true;
    unsigned char* ACT; const float* WGT;
    __device__ __forceinline__ void operator()(const f32x4 (&acc)[2][2][4][2], const pg8::Unit& u, int wr, int wc, int fr, int fq) const {
        const int row0 = u.pm * 256 + wr * 64 + fr, ct = u.pn & 1;
#pragma unroll
        for (int ai = 0; ai < 2; ++ai)
#pragma unroll
            for (int m = 0; m < 4; ++m) { const int row = row0 + ai * 128 + m * 16; const float w = WGT[row] * ACT_SCALE; float r[8];
#pragma unroll
                for (int n = 0; n < 2; ++n)
#pragma unroll
                    for (int i = 0; i < 4; ++i) { const float g = acc[ai][0][m][n][i] * (1.f / WIN_SCALE); r[4 * n + i] = g * sigmoidf_(g) * (acc[ai][1][m][n][i] * (1.f / WIN_SCALE)) * w; }
                int d0 = 0, d1 = 0;
                d0 = __builtin_amdgcn_cvt_pk_fp8_f32(r[0], r[1], d0, false); d0 = __builtin_amdgcn_cvt_pk_fp8_f32(r[2], r[3], d0, true);
                d1 = __builtin_amdgcn_cvt_pk_fp8_f32(r[4], r[5], d1, false); d1 = __builtin_amdgcn_cvt_pk_fp8_f32(r[6], r[7], d1, true);
                *(u32x2*)(ACT + (size_t)row * 256 + ct * 128 + wc * 32 + fq * 8) = (u32x2){(unsigned)d0, (unsigned)d1}; }
    }
};
constexpr float Y_SCALE = 16.f;
struct EpiDown {
    static constexpr bool PERM = true;
    static constexpr float YD = Y_SCALE / (ACT_SCALE * WDN_SCALE);
    unsigned char* Y;
    __device__ __forceinline__ void operator()(const f32x4 (&acc)[2][2][4][2], const pg8::Unit& u, int wr, int wc, int fr, int fq) const {
        const int row0 = u.pm * 256 + wr * 64 + fr, col0 = (u.pn & 3) * 256 + (wc * 4 + fq) * 16;
#pragma unroll
        for (int ai = 0; ai < 2; ++ai)
#pragma unroll
            for (int m = 0; m < 4; ++m) { const int row = row0 + ai * 128 + m * 16; u32x4 w;
#pragma unroll
                for (int bj = 0; bj < 2; ++bj) { int d0 = 0, d1 = 0;
                    d0 = __builtin_amdgcn_cvt_pk_fp8_f32(acc[ai][bj][m][0][0] * YD, acc[ai][bj][m][0][1] * YD, d0, false); d0 = __builtin_amdgcn_cvt_pk_fp8_f32(acc[ai][bj][m][0][2] * YD, acc[ai][bj][m][0][3] * YD, d0, true);
                    d1 = __builtin_amdgcn_cvt_pk_fp8_f32(acc[ai][bj][m][1][0] * YD, acc[ai][bj][m][1][1] * YD, d1, false); d1 = __builtin_amdgcn_cvt_pk_fp8_f32(acc[ai][bj][m][1][2] * YD, acc[ai][bj][m][1][3] * YD, d1, true);
                    if (bj == 0) { w.x = (unsigned)d0; w.y = (unsigned)d1; } else { w.z = (unsigned)d0; w.w = (unsigned)d1; } }
                *(u32x4*)(Y + (size_t)row * 1024 + col0) = w; }
    }
};
struct EpiComb {
    static constexpr bool PERM = true;
    float* O; const unsigned char* Y; const int* POS; const float* mod; int rtiles; const bf16* X1;
    __device__ __forceinline__ void operator()(const f32x4 (&acc)[2][2][4][2], const pg8::Unit& u, int wr, int wc, int fr, int fq) const {
        const int row0 = (u.pm - rtiles) * 256 + wr * 64 + fr, ct = u.pn & 3, col0 = ct * 256 + wc * 32 + fq * 8;
#pragma unroll
        for (int ai = 0; ai < 2; ++ai)
#pragma unroll
            for (int m = 0; m < 4; ++m) { const int row = row0 + ai * 128 + m * 16, b = row >> 14;
                const i32x4 p0 = *(const i32x4*)(POS + (size_t)row * 8), p1 = *(const i32x4*)(POS + (size_t)row * 8 + 4);
                f32x2 t[8] = {{0.f, 0.f}, {0.f, 0.f}, {0.f, 0.f}, {0.f, 0.f}, {0.f, 0.f}, {0.f, 0.f}, {0.f, 0.f}, {0.f, 0.f}};
#pragma unroll
                for (int k = 0; k < 8; ++k) { const int pos = k < 4 ? p0[k & 3] : p1[k & 3]; const u32x4 y = *(const u32x4*)(Y + (size_t)pos * 1024 + ct * 256 + (wc * 4 + fq) * 16);
                    t[0] += __builtin_amdgcn_cvt_pk_f32_fp8((int)y.x, false); t[1] += __builtin_amdgcn_cvt_pk_f32_fp8((int)y.x, true);
                    t[2] += __builtin_amdgcn_cvt_pk_f32_fp8((int)y.y, false); t[3] += __builtin_amdgcn_cvt_pk_f32_fp8((int)y.y, true);
                    t[4] += __builtin_amdgcn_cvt_pk_f32_fp8((int)y.z, false); t[5] += __builtin_amdgcn_cvt_pk_f32_fp8((int)y.z, true);
                    t[6] += __builtin_amdgcn_cvt_pk_f32_fp8((int)y.w, false); t[7] += __builtin_amdgcn_cvt_pk_f32_fp8((int)y.w, true); }
#pragma unroll
                for (int bj = 0; bj < 2; ++bj) {
                    const int col = col0 + bj * 128; float* op = O + (size_t)row * D + col; const u32x4 xb = *(const u32x4*)(X1 + (size_t)row * D + col);
#pragma unroll
                    for (int n = 0; n < 2; ++n) { const f32x4 g = *(const f32x4*)(mod + b * 6144 + 5120 + col + 4 * n);
                        const f32x4 xv = n == 0 ? (f32x4){bf_lo(xb.x), bf_hi(xb.x), bf_lo(xb.y), bf_hi(xb.y)} : (f32x4){bf_lo(xb.z), bf_hi(xb.z), bf_lo(xb.w), bf_hi(xb.w)};
                        const f32x4 sv = acc[ai][bj][m][n] * (1.f / (ACT_SCALE * WDN_SCALE)) + (f32x4){t[bj * 4 + 2 * n].x, t[bj * 4 + 2 * n].y, t[bj * 4 + 2 * n + 1].x, t[bj * 4 + 2 * n + 1].y} * (1.f / Y_SCALE);
                        *(f32x4*)(op + 4 * n) = xv + g * sv; } } }
    }
};

constexpr int NPHASE = 12;
__global__ void __launch_bounds__(NTHREADS, 2) fwd_kernel(Args args) {
    extern __shared__ __attribute__((aligned(16))) unsigned char lds[];
    Frame F;
    F.lds = (LAS unsigned char*)lds;
    F.tid = threadIdx.x; F.lane = F.tid & 63; F.wave = __builtin_amdgcn_readfirstlane(F.tid >> 6);
    F.G = gridDim.x; { const int bx = blockIdx.x; F.vcu = (F.G % 8 == 0) ? (bx % 8) * (F.G / 8) + bx / 8 : bx; }
    F.ws = args.ws; F.out = args.out;
    F.ka = (const __attribute__((address_space(4))) unsigned char*)__builtin_amdgcn_kernarg_segment_ptr();
    volatile LAS unsigned* MISC = (volatile LAS unsigned*)(F.lds + MISC_OFF);
    if (F.tid < 64) MISC[F.tid] = 0u;
    __syncthreads();
    const int lo = args.ph_lo, hi = args.ph_hi;
    unsigned* barw = (unsigned*)(F.ws + WS_CTL) + CW_BAR;
    XcdBarrier bar; bar.bar = barw; bar.x = 0; bar.st = nullptr;
    if (hi - lo > 1) bar = xcd_barrier_post(barw, MISC + 8);
#ifndef ONLY_PHASE
#define ONLY_PHASE -1
#endif
#define HASP(k) (ONLY_PHASE < 0 || ONLY_PHASE == (k) || (ONLY_PHASE == 100 && (k) == 10) || (ONLY_PHASE == 101 && (k) == 11))
#define IN(k) (HASP(k) && lo <= (k) && (k) < hi)
#ifndef DBG_REP
#define DBG_REP -1
#endif
#ifndef DBG_REPN
#define DBG_REPN 2
#endif
#define REPS(k) for (int rep_ = 0; rep_ < ((DBG_REP == (k)) ? DBG_REPN : 1); (void)({ asm volatile("" ::: "memory"); 0; }), ++rep_)
#define SEAM(k) do { if (IN(k) && IN((k) + 1)) xcd_barrier(bar); } while (0)
    bf16* const H = (bf16*)F.out;

    if (IN(0)) { REPS(0) phase0(F); } SEAM(0);
    if (IN(1)) { REPS(1) phase1(F); } SEAM(1);
    if (IN(2)) REPS(2) {
        pg8::Gemm g{H, (const bf16*)(F.ws + WS_WIN), T, NIN, D / 2}; pg8::StaticOrder S; S.init(T, NIN, F.G, (int)blockIdx.x);
        EpiIn E{(bf16*)(F.ws + WS_U), (bf16*)(F.ws + WS_Q), (bf16*)(F.ws + WS_K), (bf16*)(F.ws + WS_V), (bf16*)(F.ws + WS_GC), (bf16*)(F.ws + WS_GA), (const float*)(F.ws + WS_ROPE), F.in(I_QNG), F.in(I_KNG), F.lds + EPI_SCR};
        pg8::gemm_phase<EpiIn, pg8::StaticOrder, true, true, false, true>(F.lds, g, S, E);
    } SEAM(2);
    if (IN(3)) { REPS(3) phase3(F); } SEAM(3);
    if (IN(4)) REPS(4) {
        pg8::Gemm g{H, (const bf16*)(F.ws + WS_WPW2), T, D, D / 2}; pg8::StaticOrder S; S.init(T, D, F.G, (int)blockIdx.x);
        EpiPw2 E{(bf16*)(F.ws + WS_U), (const unsigned char*)(F.ws + WS_GC), F.in(I_BPW2)};
        pg8::gemm_phase<EpiPw2, pg8::StaticOrder, true, true, false, true>(F.lds, g, S, E);
    } SEAM(4);
#ifndef DBG_ATTVAR
#define DBG_ATTVAR 0
#endif
    if (IN(5)) { att::phase5(F, F.ws + WS_GC); } SEAM(5);
    if (IN(6)) REPS(6) {
        pg8::Gemm g{(const bf16*)(F.ws + WS_GC), (const bf16*)(F.ws + WS_WOUT), T, D, D / 2}; pg8::StaticOrder S; S.init(T, D, F.G, (int)blockIdx.x);
        EpiOut E{F.in(I_X), (bf16*)(F.ws + WS_X1), (const float*)(F.ws + WS_MOD)};
        pg8::gemm_phase<EpiOut, pg8::StaticOrder, true, true, false, true>(F.lds, g, S, E);
    } SEAM(6);
    if (IN(7)) { REPS(7) phase7(F); } SEAM(7);
    if (IN(8)) { REPS(8) phase8(F); } SEAM(8);
    const int* TE = (const int*)(F.ws + WS_TE); const int* TOK = (const int*)(F.ws + WS_TOK);
    if (IN(9)) REPS(9) {
        const int NTR = ((const int*)(F.ws + WS_META))[0];
        pg8::Gemm g{(const bf16*)(F.ws + WS_U), (const bf16*)(F.ws + WS_WGU), 0, 0, D / 2};
        SchedMoe S{F.G, (int)blockIdx.x, 2 * (NTR + 128), 0, 1, 0, 2, TE, TOK};
        EpiGU E{(unsigned char*)(F.ws + WS_ACT), (const float*)(F.ws + WS_WGT)};
        pg8::gemm_phase<EpiGU, SchedMoe, true, true, true, true>(F.lds, g, S, E);
    } SEAM(9);
    if (IN(10)) REPS(10) { const int NTR = ((const int*)(F.ws + WS_META))[0];
        pg8::Gemm g{(const bf16*)(F.ws + WS_ACT), (const bf16*)(F.ws + WS_WDN), 0, 0, ED / 2};
        SchedMoe S{F.G, (int)blockIdx.x, 4 * NTR, 0, 2, 0, 4, TE, TOK};
        EpiDown E{(unsigned char*)(F.ws + WS_Y)};
#ifndef DBG_P10VAR
#define DBG_P10VAR 0
#endif
        if (DBG_P10VAR == 1) { EpiNull<0> E0{(float*)(F.ws + WS_META) + 8}; pg8::gemm_phase<EpiNull<0>, SchedMoe, true, true, false>(F.lds, g, S, E0); }
        if (DBG_P10VAR == 2) { EpiNull<1> E0{(float*)(F.ws + WS_META) + 8}; pg8::gemm_phase<EpiNull<1>, SchedMoe, true, true, false>(F.lds, g, S, E0); }
        pg8::gemm_phase<EpiDown, SchedMoe, true, true, false, true>(F.lds, g, S, E);
    } SEAM(10);
    if (IN(11)) { const int NTR = ((const int*)(F.ws + WS_META))[0];
        pg8::Gemm g{(const bf16*)(F.ws + WS_ACT), (const bf16*)(F.ws + WS_WDN), 0, 0, ED / 2};
        SchedMoe S{F.G, (int)blockIdx.x, 512, NTR, 2, 0, 4, TE, TOK};
        EpiComb E{F.out, (const unsigned char*)(F.ws + WS_Y), (const int*)(F.ws + WS_POS), (const float*)(F.ws + WS_MOD), NTR, (const bf16*)(F.ws + WS_X1)};
        pg8::gemm_phase<EpiComb, SchedMoe, true, true, false, true>(F.lds, g, S, E);
    }
#undef IN
#undef SEAM

}

#ifndef DBG_A6
#define DBG_A6 WS_U
#endif
#ifndef DBG_SKIP
#define DBG_SKIP 0
#endif
#ifndef DBG_NPH
#define DBG_NPH NPHASE
#endif
#ifndef N_LAUNCH_MODE
#define N_LAUNCH_MODE 1
#endif
extern "C" void kernel_launch(void* const* d_in, const int* in_sizes, int n_in, void* d_out, int out_size, void* d_ws, size_t ws_size, hipStream_t stream) {
    static int grid = 0;
    if (grid == 0) {
        if (n_in != 28 || out_size != T * D || ws_size < WS_END) { fprintf(stderr, "kernel_launch: unexpected problem (n_in %d out %d ws %zu)\n", n_in, out_size, ws_size); grid = -1; return; }
        int dev = 0, cus = 0, per_cu = 0;
        if (hipGetDevice(&dev) != hipSuccess || hipDeviceGetAttribute(&cus, hipDeviceAttributeMultiprocessorCount, dev) != hipSuccess) { grid = -1; return; }
        if (hipFuncSetAttribute((const void*)fwd_kernel, hipFuncAttributeMaxDynamicSharedMemorySize, LDS_BYTES) != hipSuccess) { grid = -1; return; }
        if (hipOccupancyMaxActiveBlocksPerMultiprocessor(&per_cu, (const void*)fwd_kernel, NTHREADS, LDS_BYTES) != hipSuccess || per_cu < 1) { fprintf(stderr, "kernel_launch: occupancy query says %d\n", per_cu); }
        (void)hipGetLastError();
        grid = cus;
    }
    if (grid < 0) return;
    (void)hipMemsetAsync((char*)d_ws + WS_CTL, 0, CTL_ZERO_BYTES, stream);
    Args a{};
    for (int i = 0; i < 28; ++i) a.in[i] = d_in[i];
    a.out = (float*)d_out; a.ws = (unsigned char*)d_ws;
    if (N_LAUNCH_MODE == 1) { a.ph_lo = 0; a.ph_hi = NPHASE; hipLaunchKernelGGL(fwd_kernel, dim3(grid), dim3(NTHREADS), LDS_BYTES, stream, a); }
    else { for (int p = 0; p < DBG_NPH; ++p) { if ((DBG_SKIP >> p) & 1) continue; a.ph_lo = p; a.ph_hi = p + 1; hipLaunchKernelGGL(fwd_kernel, dim3(grid), dim3(NTHREADS), LDS_BYTES, stream, a); } }
}
```
